# Optimizing an MI355X kernel written in HIP

```python
import math
import jax
import jax.numpy as jnp
from jax import lax
import numpy as np

D_MODEL = 1024
BATCH = 4
SEQ = 8192
DEPTH = 1

CHUNK = 64
Q_BLOCK = 128
ATTN_WIDTH = 1024
SSM_WIDTH = 1024
MIX_WIDTH = ATTN_WIDTH + SSM_WIDTH
HEAD_DIM = 64
V_HEAD_DIM = 2 * HEAD_DIM
ATTN_HEADS = ATTN_WIDTH // V_HEAD_DIM
SSM_GROUP = 16
SSM_GROUPS = SSM_WIDTH // SSM_GROUP
SSM_STATE = 64
ROPE_THETA = 10000.0
NORM_EPS = 1e-6
MASK_VALUE = -1e30
IN_SPLITS = (ATTN_WIDTH, 2 * ATTN_WIDTH, 3 * ATTN_WIDTH, 4 * ATTN_WIDTH, 4 * ATTN_WIDTH + SSM_WIDTH)
IN_COLS = 4 * ATTN_WIDTH + 2 * SSM_WIDTH

kernel_name = "hybrid_diffattn_s5_adaln_layer"


def rms_norm(x, g):
    xf = x.astype(jnp.float32)
    y = xf * lax.rsqrt(jnp.mean(xf * xf, axis=-1, keepdims=True) + NORM_EPS)
    return (y * g.astype(jnp.float32)).astype(x.dtype)


def rope(x, cos, sin):
    half = x.shape[-1] // 2
    x1, x2 = x[..., :half], x[..., half:]
    return jnp.concatenate([x1 * cos - x2 * sin, x2 * cos + x1 * sin], axis=-1)


def diff_attention(q, k, v, lam):
    b_, h_, _, s_, d = q.shape
    nblk = s_ // Q_BLOCK
    scale = d ** -0.5
    qb = q.reshape(b_, h_, 2, nblk, Q_BLOCK, d).transpose(3, 0, 1, 2, 4, 5)
    k_chunk = jnp.arange(s_) // CHUNK

    def one_block(args):
        i, qi = args
        s = jnp.einsum('bhmqd,bhmkd->bhmqk', qi, k).astype(jnp.float32) * scale
        q_chunk = (i * Q_BLOCK + jnp.arange(Q_BLOCK)) // CHUNK
        allowed = k_chunk[None, :] <= q_chunk[:, None]
        s = jnp.where(allowed, s, MASK_VALUE)
        p = jax.nn.softmax(s, axis=-1)
        w = p[:, :, 0] - lam * p[:, :, 1]
        return jnp.einsum('bhqk,bhkv->bhqv', w.astype(v.dtype), v)

    out = lax.map(one_block, (jnp.arange(nblk), qb))
    return out.transpose(1, 0, 3, 2, 4).reshape(b_, s_, h_, v.shape[-1])


def _complex_affine_combine(e1, e2):
    a1r, a1i, b1r, b1i = e1
    a2r, a2i, b2r, b2i = e2
    ar = a2r * a1r - a2i * a1i
    ai = a2r * a1i + a2i * a1r
    br = a2r * b1r - a2i * b1i + b2r
    bi = a2r * b1i + a2i * b1r + b2i
    return (ar, ai, br, bi)


def s5_ssm(u, a_re, a_im, log_dt, b_re, b_im, c_re, c_im, d_skip):
    b_, s_, w_ = u.shape
    n_chunks = s_ // CHUNK
    f32 = jnp.float32
    uf = u.astype(f32)
    uc = uf.reshape(b_, n_chunks, CHUNK, SSM_GROUPS, SSM_GROUP).transpose(1, 0, 2, 3, 4)
    dt = jnp.exp(log_dt.astype(f32))[:, None]
    ar, ai = a_re.astype(f32), a_im.astype(f32)
    mag = jnp.exp(ar * dt)
    abar_re, abar_im = mag * jnp.cos(ai * dt), mag * jnp.sin(ai * dt)
    nr, ni = abar_re - 1.0, abar_im
    den = ar * ar + ai * ai
    f_re = (nr * ar + ni * ai) / den
    f_im = (ni * ar - nr * ai) / den
    br_, bi_ = b_re.astype(f32), b_im.astype(f32)
    bb_re = f_re[..., None] * br_ - f_im[..., None] * bi_
    bb_im = f_re[..., None] * bi_ + f_im[..., None] * br_
    cr, ci = c_re.astype(f32), c_im.astype(f32)
    a_seq_re = jnp.broadcast_to(abar_re[None, None], (1, CHUNK, SSM_GROUPS, SSM_STATE))
    a_seq_im = jnp.broadcast_to(abar_im[None, None], (1, CHUNK, SSM_GROUPS, SSM_STATE))

    def chunk_step(carry, u_c):
        prev_re, prev_im = carry
        bu_re = jnp.einsum('bcgh,gph->bcgp', u_c, bb_re)
        bu_im = jnp.einsum('bcgh,gph->bcgp', u_c, bb_im)
        acum_re, acum_im, h_re, h_im = lax.associative_scan(
            _complex_affine_combine, (a_seq_re, a_seq_im, bu_re, bu_im), axis=1)
        h_re = h_re + acum_re * prev_re[:, None] - acum_im * prev_im[:, None]
        h_im = h_im + acum_re * prev_im[:, None] + acum_im * prev_re[:, None]
        y = jnp.einsum('bcgp,ghp->bcgh', h_re, cr) - jnp.einsum('bcgp,ghp->bcgh', h_im, ci)
        return (h_re[:, -1], h_im[:, -1]), y

    init = (jnp.zeros((b_, SSM_GROUPS, SSM_STATE), f32), jnp.zeros((b_, SSM_GROUPS, SSM_STATE), f32))
    _, ys = lax.scan(chunk_step, init, uc)
    y = ys.transpose(1, 0, 2, 3, 4).reshape(b_, s_, w_)
    y = y + d_skip.astype(f32) * uf
    return y.astype(u.dtype)


def setup_inputs(seed: int = 0) -> dict:
    key = jax.random.key(seed)
    ks = jax.random.split(key, 24)
    f32 = jnp.float32

    def nrm(k, shape, scale):
        return jax.random.normal(k, shape, f32) * scale

    n_idx = jnp.arange(SSM_STATE, dtype=f32)
    gps = (DEPTH, SSM_GROUPS, SSM_STATE)
    return {
        "x": nrm(ks[0], (BATCH, SEQ, D_MODEL), 1.0),
        "c": nrm(ks[1], (BATCH, D_MODEL), 1.0),
        "w_ada": nrm(ks[2], (DEPTH, D_MODEL, 3 * D_MODEL), 0.5 * D_MODEL ** -0.5),
        "b_ada": nrm(ks[3], (DEPTH, 3 * D_MODEL), 0.02),
        "norm_g": 1.0 + nrm(ks[4], (DEPTH, D_MODEL), 0.02),
        "w_in": nrm(ks[5], (DEPTH, D_MODEL, IN_COLS), D_MODEL ** -0.5),
        "q_norm_g": 1.0 + nrm(ks[6], (DEPTH, HEAD_DIM), 0.02),
        "k_norm_g": 1.0 + nrm(ks[7], (DEPTH, HEAD_DIM), 0.02),
        "lam_q1": nrm(ks[8], (DEPTH, HEAD_DIM), 0.1),
        "lam_k1": nrm(ks[9], (DEPTH, HEAD_DIM), 0.1),
        "lam_q2": nrm(ks[10], (DEPTH, HEAD_DIM), 0.1),
        "lam_k2": nrm(ks[11], (DEPTH, HEAD_DIM), 0.1),
        "head_norm_g": 1.0 + nrm(ks[12], (DEPTH, V_HEAD_DIM), 0.02),
        "ssm_a_re": -0.5 + nrm(ks[13], gps, 0.01),
        "ssm_a_im": math.pi * n_idx + nrm(ks[14], gps, 0.01),
        "ssm_log_dt": jax.random.uniform(ks[15], (DEPTH, SSM_GROUPS), f32, math.log(1e-3), math.log(1e-1)),
        "ssm_b_re": nrm(ks[16], (DEPTH, SSM_GROUPS, SSM_STATE, SSM_GROUP), (2 * SSM_GROUP) ** -0.5),
        "ssm_b_im": nrm(ks[17], (DEPTH, SSM_GROUPS, SSM_STATE, SSM_GROUP), (2 * SSM_GROUP) ** -0.5),
        "ssm_c_re": nrm(ks[18], (DEPTH, SSM_GROUPS, SSM_GROUP, SSM_STATE), SSM_STATE ** -0.5),
        "ssm_c_im": nrm(ks[19], (DEPTH, SSM_GROUPS, SSM_GROUP, SSM_STATE), SSM_STATE ** -0.5),
        "ssm_d": nrm(ks[20], (DEPTH, SSM_WIDTH), 1.0),
        "w_glu": nrm(ks[21], (DEPTH, SSM_WIDTH, SSM_WIDTH), SSM_WIDTH ** -0.5),
        "b_glu": nrm(ks[22], (DEPTH, SSM_WIDTH), 0.02),
        "w_out": nrm(ks[23], (DEPTH, MIX_WIDTH, D_MODEL), MIX_WIDTH ** -0.5),
    }


def reference(x, c, w_ada, b_ada, norm_g, w_in, q_norm_g, k_norm_g, lam_q1, lam_k1, lam_q2, lam_k2,
              head_norm_g, ssm_a_re, ssm_a_im, ssm_log_dt, ssm_b_re, ssm_b_im, ssm_c_re, ssm_c_im,
              ssm_d, w_glu, b_glu, w_out):
    b_, s_, _ = x.shape
    f32 = jnp.float32
    pos = jnp.arange(s_, dtype=f32)
    inv_freq = 1.0 / (ROPE_THETA ** (jnp.arange(0, HEAD_DIM, 2, dtype=f32) / HEAD_DIM))
    ang = pos[:, None] * inv_freq[None, :]
    cos, sin = jnp.cos(ang).astype(x.dtype), jnp.sin(ang).astype(x.dtype)

    for l in range(DEPTH):
        lam_init = 0.8 - 0.6 * math.exp(-0.3 * l)
        mod = jax.nn.silu(c) @ w_ada[l] + b_ada[l]
        shift, scale, gate = jnp.split(mod, 3, axis=-1)
        h = rms_norm(x, norm_g[l]) * (1.0 + scale[:, None, :]) + shift[:, None, :]
        proj = h @ w_in[l]
        q, k, v, g_attn, u, g_ssm = jnp.split(proj, IN_SPLITS, axis=-1)

        q = q.reshape(b_, s_, ATTN_HEADS, 2, HEAD_DIM).transpose(0, 2, 3, 1, 4)
        k = k.reshape(b_, s_, ATTN_HEADS, 2, HEAD_DIM).transpose(0, 2, 3, 1, 4)
        v = v.reshape(b_, s_, ATTN_HEADS, V_HEAD_DIM).transpose(0, 2, 1, 3)
        q = rope(rms_norm(q, q_norm_g[l]), cos, sin)
        k = rope(rms_norm(k, k_norm_g[l]), cos, sin)
        lam = (jnp.exp(jnp.sum(lam_q1[l].astype(f32) * lam_k1[l].astype(f32)))
               - jnp.exp(jnp.sum(lam_q2[l].astype(f32) * lam_k2[l].astype(f32))) + lam_init)
        o = diff_attention(q, k, v, lam)
        o = rms_norm(o, head_norm_g[l]) * (1.0 - lam_init)
        o = o.reshape(b_, s_, ATTN_WIDTH) * jax.nn.silu(g_attn)

        y = s5_ssm(u, ssm_a_re[l], ssm_a_im[l], ssm_log_dt[l], ssm_b_re[l], ssm_b_im[l],
                   ssm_c_re[l], ssm_c_im[l], ssm_d[l])
        z = jax.nn.gelu(y)
        z = z * jax.nn.sigmoid(z @ w_glu[l] + b_glu[l])
        z = z * jax.nn.silu(g_ssm)

        mixed = jnp.concatenate([o, z], axis=-1) @ w_out[l]
        x = x + gate[:, None, :] * mixed
    return x
```

```cpp
#include <hip/hip_runtime.h>
#include <hip/hip_cooperative_groups.h>
#include <cstdio>
#include <cstdint>
namespace cg = cooperative_groups;
__device__ __forceinline__ int lane_id() { int t = (int)threadIdx.x; asm volatile("" : "+v"(t)); return t & 63; }
namespace pg8 {
#define PG8_LAS __attribute__((address_space(3)))
typedef unsigned short bf16_t;
typedef short bf16x8 __attribute__((ext_vector_type(8)));
typedef float f32x4 __attribute__((ext_vector_type(4)));
typedef unsigned u32x4 __attribute__((ext_vector_type(4)));
constexpr int BM = 256, BK = 64, HALF = 128, HTB = HALF * BK * 2  , STAGE_BYTES = 8 * HTB, NXCD = 8, WGM = 8;

__host__ __device__ __forceinline__ int lds_byte(int r, int c) { const int st = (r >> 4) * 2 + (c >> 5), rr = r & 15, cc = c & 31, ob = rr * 64 + cc * 2; return st * 1024 + (ob ^ (((ob >> 9) & 1) << 5)); }
__host__ __device__ __forceinline__ void stage_rc(int b, int& R, int& C) { const int st = b / 1024, sb = b % 1024, swz = sb ^ (((sb >> 9) & 1) << 5); R = (st >> 1) * 16 + swz / 64; C = (st & 1) * 32 + (swz % 64) / 2; }
__host__ __device__ __forceinline__ int perm32(int rho) { const int n = rho >> 4, i = rho & 15; return 8 * (i >> 2) + 4 * n + (i & 3); }

struct Unit { int pm, pn; };
struct Gemm { const bf16_t* A; const bf16_t* Bt; int M, N, K; };

struct StaticOrder {
    int nM, nN, nwg, G, c;
    __host__ __device__ void init(int M, int N, int G_, int c_) { nM = M / BM; nN = N / BM; nwg = nM * nN; G = G_; c = c_; }
    __host__ __device__ bool next(int i, Unit& u) const {
        const long L = (long)i * G + c; if (L >= nwg) return false;
        int wgid = (int)L; { const int q = nwg / NXCD, r = nwg % NXCD, xcd = wgid % NXCD, off = wgid / NXCD; wgid = (xcd < r ? xcd * (q + 1) : r * (q + 1) + (xcd - r) * q) + off; }
        const int nig = WGM * nN, gid = wgid / nig, fm = gid * WGM, gsz = (nM - fm) < WGM ? (nM - fm) : WGM;
        u.pm = fm + ((wgid % nig) % gsz); u.pn = (wgid % nig) / gsz; return true;
    }
    __device__ __forceinline__ void a_ready(const Unit&) const {}
    __device__ __forceinline__ void done(const Unit&) const {}
};

__device__ __forceinline__ unsigned cvt_pk_bf16(float lo, float hi) { unsigned r; asm volatile("v_cvt_pk_bf16_f32 %0, %1, %2" : "=v"(r) : "v"(lo), "v"(hi)); return r; }
typedef float f32x2 __attribute__((ext_vector_type(2)));
__device__ __forceinline__ float sigmoid_f(float x) { return __builtin_amdgcn_rcpf(1.0f + __expf(-x)); }
__device__ __forceinline__ float silu_f(float x) { return x * sigmoid_f(x); }
__device__ __forceinline__ float gelu_tanh_f(float y) { const float t = y * y; const float p = __builtin_fmaf(t, -0.10294324f, -2.3022082f);
    return y * __builtin_amdgcn_rcpf(1.0f + __builtin_amdgcn_exp2f(y * p)); }
__device__ __forceinline__ float bf_lo(unsigned w) { return __builtin_bit_cast(float, w << 16); }
__device__ __forceinline__ float bf_hi(unsigned w) { return __builtin_bit_cast(float, w & 0xffff0000u); }
constexpr float QSCALE = 0.125f * 1.4426950408889634f;

struct EpiProj {
    static constexpr bool PERM = true, AFTER_DRAIN = false;
    bf16_t *Q, *K, *V, *GA, *GS, *UC; const float* rope_cos; const float* rope_sin; const float* qg; const float* kg;
    __device__ __forceinline__ void operator()(const f32x4 (&acc)[2][2][4][2], const Unit& u, int wr, int wc, int fr, int fq) const {
        const int tt = u.pn >> 2, p4 = u.pn & 3;
        const int row0 = u.pm * BM + wr * 64 + fr;
        if (tt < 2) {
            const float* gw = (tt == 0) ? qg : kg; bf16_t* dst = (tt == 0) ? Q : K; const float sc = (tt == 0) ? QSCALE : 1.0f;
            f32x4 gv[2][2];
#pragma unroll
            for (int bj = 0; bj < 2; ++bj)
#pragma unroll
                for (int n = 0; n < 2; ++n) gv[bj][n] = *(const f32x4*)(gw + bj * 32 + 8 * fq + 4 * n) * sc;
            const int hm = p4 * 4 + wc;
#pragma unroll
            for (int ai = 0; ai < 2; ++ai)
#pragma unroll
                for (int m = 0; m < 4; ++m) {
                    const int row = row0 + ai * HALF + m * 16; const int s = row & 8191;
                    f32x4 v[2][2]; float ss = 0.f;
#pragma unroll
                    for (int bj = 0; bj < 2; ++bj)
#pragma unroll
                        for (int n = 0; n < 2; ++n) { v[bj][n] = acc[ai][bj][m][n]; const f32x4 q = v[bj][n] * v[bj][n]; ss += (q[0] + q[1]) + (q[2] + q[3]); }
                    ss += __shfl_xor(ss, 16); ss += __shfl_xor(ss, 32);
                    const float rs = __builtin_amdgcn_rsqf(ss * (1.0f / 64.0f) + 1e-6f);
                    u32x4 w0, w1;
                    {
                        const f32x4 c0 = *(const f32x4*)(rope_cos + s * 32 + 8 * fq), c1 = *(const f32x4*)(rope_cos + s * 32 + 8 * fq + 4);
                        const f32x4 s0 = *(const f32x4*)(rope_sin + s * 32 + 8 * fq), s1 = *(const f32x4*)(rope_sin + s * 32 + 8 * fq + 4);
                        const f32x4 a0 = v[0][0] * rs * gv[0][0], a1 = v[0][1] * rs * gv[0][1], b0 = v[1][0] * rs * gv[1][0], b1 = v[1][1] * rs * gv[1][1];
                        const f32x4 o10 = a0 * c0 - b0 * s0, o11 = a1 * c1 - b1 * s1, o20 = b0 * c0 + a0 * s0, o21 = b1 * c1 + a1 * s1;
                        w0.x = cvt_pk_bf16(o10[0], o10[1]); w0.y = cvt_pk_bf16(o10[2], o10[3]); w0.z = cvt_pk_bf16(o11[0], o11[1]); w0.w = cvt_pk_bf16(o11[2], o11[3]);
                        w1.x = cvt_pk_bf16(o20[0], o20[1]); w1.y = cvt_pk_bf16(o20[2], o20[3]); w1.z = cvt_pk_bf16(o21[0], o21[1]); w1.w = cvt_pk_bf16(o21[2], o21[3]);
                    }
                    bf16_t* rp = dst + (size_t)row * 1024 + hm * 64 + 8 * fq;
                    *(u32x4*)(rp) = w0; *(u32x4*)(rp + 32) = w1;
                }
        } else {
#pragma unroll
            for (int ai = 0; ai < 2; ++ai)
#pragma unroll
                for (int m = 0; m < 4; ++m) {
                    const int row = row0 + ai * HALF + m * 16;
#pragma unroll
                    for (int bj = 0; bj < 2; ++bj) {
                        f32x4 v0 = acc[ai][bj][m][0], v1 = acc[ai][bj][m][1];
                        const int col = p4 * 256 + bj * HALF + wc * 32 + 8 * fq;
                        if (tt == 3 || tt == 5) {
#pragma unroll
                            for (int e = 0; e < 4; ++e) { v0[e] = silu_f(v0[e]); v1[e] = silu_f(v1[e]); }
                        }
                        u32x4 w; w.x = cvt_pk_bf16(v0[0], v0[1]); w.y = cvt_pk_bf16(v0[2], v0[3]); w.z = cvt_pk_bf16(v1[0], v1[1]); w.w = cvt_pk_bf16(v1[2], v1[3]);
                        if (tt == 4) {
                            const int b = row >> 13, s = row & 8191, g = col >> 4;
                            *(u32x4*)(UC + ((size_t)(b * 64 + g) * 8192 + s) * 16 + (col & 15)) = w;
                        } else if (tt == 2) {
                            const int b = row >> 13, s = row & 8191, hh = col >> 7, d0 = col & 127;
                            const int sp = (s & ~15) | (s & 3) | (((s >> 3) & 1) << 2) | (((s >> 2) & 1) << 3);
                            bf16_t* vt = V + ((size_t)((b * 8 + hh) * 128 + d0)) * 8192 + sp;
                            vt[0 * 8192] = (bf16_t)(w.x & 0xffffu); vt[1 * 8192] = (bf16_t)(w.x >> 16); vt[2 * 8192] = (bf16_t)(w.y & 0xffffu); vt[3 * 8192] = (bf16_t)(w.y >> 16);
                            vt[4 * 8192] = (bf16_t)(w.z & 0xffffu); vt[5 * 8192] = (bf16_t)(w.z >> 16); vt[6 * 8192] = (bf16_t)(w.w & 0xffffu); vt[7 * 8192] = (bf16_t)(w.w >> 16);
                        } else {
                            bf16_t* base = (tt == 3) ? GA : GS;
                            *(u32x4*)(base + (size_t)row * 1024 + col) = w;
                        }
                    }
                }
        }
    }
};

struct EpiGlu {
    static constexpr bool PERM = true, AFTER_DRAIN = false;
    const bf16_t* GY; const bf16_t* GS; const float* bias; bf16_t* MIX;
    __device__ __forceinline__ void operator()(const f32x4 (&acc)[2][2][4][2], const Unit& u, int wr, int wc, int fr, int fq) const {
        const int row0 = u.pm * BM + wr * 64 + fr, col0 = u.pn * BM + wc * 32 + 8 * fq;
        f32x4 bv[2][2];
#pragma unroll
        for (int bj = 0; bj < 2; ++bj)
#pragma unroll
            for (int n = 0; n < 2; ++n) bv[bj][n] = *(const f32x4*)(bias + col0 + bj * HALF + 4 * n);
#pragma unroll
        for (int ai = 0; ai < 2; ++ai)
#pragma unroll
            for (int m = 0; m < 4; ++m) {
                const int row = row0 + ai * HALF + m * 16;
#pragma unroll
                for (int bj = 0; bj < 2; ++bj) {
                    const int col = col0 + bj * HALF;
                    const u32x4 gy = *(const u32x4*)(GY + (size_t)row * 1024 + col), gs = *(const u32x4*)(GS + (size_t)row * 1024 + col);
                    const f32x4 v0 = acc[ai][bj][m][0] + bv[bj][0], v1 = acc[ai][bj][m][1] + bv[bj][1];
                    u32x4 w;
                    w.x = cvt_pk_bf16(bf_lo(gy.x) * sigmoid_f(v0[0]) * bf_lo(gs.x), bf_hi(gy.x) * sigmoid_f(v0[1]) * bf_hi(gs.x));
                    w.y = cvt_pk_bf16(bf_lo(gy.y) * sigmoid_f(v0[2]) * bf_lo(gs.y), bf_hi(gy.y) * sigmoid_f(v0[3]) * bf_hi(gs.y));
                    w.z = cvt_pk_bf16(bf_lo(gy.z) * sigmoid_f(v1[0]) * bf_lo(gs.z), bf_hi(gy.z) * sigmoid_f(v1[1]) * bf_hi(gs.z));
                    w.w = cvt_pk_bf16(bf_lo(gy.w) * sigmoid_f(v1[2]) * bf_lo(gs.w), bf_hi(gy.w) * sigmoid_f(v1[3]) * bf_hi(gs.w));
                    *(u32x4*)(MIX + (size_t)row * 2048 + 1024 + col) = w;
                }
            }
    }
};

struct EpiOut {
    static constexpr bool PERM = true, AFTER_DRAIN = false;
    const float* x; const float* mod; float* out;
    __device__ __forceinline__ void operator()(const f32x4 (&acc)[2][2][4][2], const Unit& u, int wr, int wc, int fr, int fq) const {
        const int row0 = u.pm * BM + wr * 64 + fr, col0 = u.pn * BM + wc * 32 + 8 * fq;
        const int b = (u.pm * BM) >> 13;
        f32x4 gv[2][2];
#pragma unroll
        for (int bj = 0; bj < 2; ++bj)
#pragma unroll
            for (int n = 0; n < 2; ++n) gv[bj][n] = *(const f32x4*)(mod + b * 3072 + 2048 + col0 + bj * HALF + 4 * n);
#pragma unroll
        for (int ai = 0; ai < 2; ++ai)
#pragma unroll
            for (int mh = 0; mh < 2; ++mh) {
                f32x4 xv[2][2][2];
#pragma unroll
                for (int mm = 0; mm < 2; ++mm) { const size_t off = (size_t)(row0 + ai * HALF + (2 * mh + mm) * 16) * 1024 + col0;
#pragma unroll
                    for (int bj = 0; bj < 2; ++bj)
#pragma unroll
                        for (int n = 0; n < 2; ++n) xv[mm][bj][n] = *(const f32x4*)(x + off + bj * HALF + 4 * n); }
                asm volatile("" ::: "memory");
#pragma unroll
                for (int mm = 0; mm < 2; ++mm) { const size_t off = (size_t)(row0 + ai * HALF + (2 * mh + mm) * 16) * 1024 + col0;
#pragma unroll
                    for (int bj = 0; bj < 2; ++bj)
#pragma unroll
                        for (int n = 0; n < 2; ++n) *(f32x4*)(out + off + bj * HALF + 4 * n) = xv[mm][bj][n] + gv[bj][n] * acc[ai][bj][2 * mh + mm][n]; }
                asm volatile("" ::: "memory");
            }
    }
};
template <class Epi, class Sched, bool ALIGN_EPI = false, bool SP2 = false>
__device__ __forceinline__ void gemm_phase(PG8_LAS unsigned char* lds, const Gemm g, const Sched& S, const Epi& E, const int wid) {
    const int lane = lane_id(), tid = wid * 64 + lane, wr = wid >> 2, wc = wid & 3, fr = lane & 15, fq = lane >> 4;
    const int K = g.K, nt = K / BK;
    unsigned voffA[2], voffB[2];
#pragma unroll
    for (int i = 0; i < 2; ++i) { int R, C; stage_rc(tid * 16 + i * 8192, R, C); const int Rb = Epi::PERM ? ((R & ~31) + perm32(R & 31)) : R;
        voffA[i] = (unsigned)(R * K + C) * 2u; voffB[i] = (unsigned)(Rb * K + C) * 2u; }
    const size_t kstep = (size_t)(BK * 2);
    const size_t hstep = (size_t)HALF * K * 2;
    const size_t tstep = 2 * hstep;
    const unsigned ldsw = (unsigned)wid * 1024u;
    const int aoff = lds_byte(wr * 64 + fr, fq * 8), boff = lds_byte(wc * 32 + fr, fq * 8);
#define PG8_SA(b, h) (((b) * 2 + (h)) * HTB)
#define PG8_SB(b, h) ((4 + (b) * 2 + (h)) * HTB)
#define PG8_STAGE(bufoff, gbase, voff) do { _Pragma("unroll") for (int _i = 0; _i < 2; ++_i) \
        __builtin_amdgcn_global_load_lds((const unsigned*)((const char*)(gbase) + (voff)[_i]), (PG8_LAS unsigned*)(lds + (bufoff) + ldsw + _i * 8192), 16, 0, 0); } while (0)
#define PG8_LDA(dst, b, h) do { _Pragma("unroll") for (int m = 0; m < 4; ++m) _Pragma("unroll") for (int k = 0; k < 2; ++k) dst[m][k] = *(const PG8_LAS bf16x8*)(lds + PG8_SA(b, h) + aoff + m * 2048 + k * 1024); } while (0)
#define PG8_LDB(dst, b, h) do { _Pragma("unroll") for (int n = 0; n < 2; ++n) _Pragma("unroll") for (int k = 0; k < 2; ++k) dst[n][k] = *(const PG8_LAS bf16x8*)(lds + PG8_SB(b, h) + boff + n * 2048 + k * 1024); } while (0)
#define PG8_MMA(ai, bj, At, Bt) do { __builtin_amdgcn_s_setprio(1); _Pragma("unroll") for (int m = 0; m < 4; ++m) _Pragma("unroll") for (int n = 0; n < 2; ++n) _Pragma("unroll") for (int k = 0; k < 2; ++k) \
        acc[ai][bj][m][n] = __builtin_amdgcn_mfma_f32_16x16x32_bf16(Bt[n][k], At[m][k], acc[ai][bj][m][n], 0, 0, 0); __builtin_amdgcn_s_setprio(0); } while (0)
#define PG8_WAIT_V(n) asm volatile("s_waitcnt vmcnt(" #n ")" ::: "memory")
#define PG8_WAIT_L(n) asm volatile("s_waitcnt lgkmcnt(" #n ")" ::: "memory")
#define PG8_BAR __builtin_amdgcn_s_barrier()
#define PG8_SCHED __builtin_amdgcn_sched_barrier(0)
    Unit cur, nxt; int ui = 0;
    if (!S.next(0, cur)) return;
    f32x4 acc[2][2][4][2];
#pragma unroll
    for (int a = 0; a < 2; ++a)
#pragma unroll
        for (int b = 0; b < 2; ++b)
#pragma unroll
            for (int m = 0; m < 4; ++m)
#pragma unroll
                for (int n = 0; n < 2; ++n) acc[a][b][m][n] = (f32x4){0.f, 0.f, 0.f, 0.f};
    bf16x8 At[4][2], B0[2][2], B1[2][2];
    const char* cA = (const char*)g.A + (size_t)cur.pm * tstep; const char* cB = (const char*)g.Bt + (size_t)cur.pn * tstep;
    S.a_ready(cur);
    if constexpr (SP2) {
        PG8_STAGE(PG8_SB(0, 0), cB, voffB); PG8_STAGE(PG8_SB(0, 1), cB + hstep, voffB); PG8_STAGE(PG8_SA(0, 0), cA, voffA); PG8_STAGE(PG8_SA(0, 1), cA + hstep, voffA);
        if (wr == 1) PG8_BAR;
        PG8_WAIT_V(2); PG8_BAR;
        PG8_STAGE(PG8_SB(1, 0), cB + kstep, voffB); PG8_STAGE(PG8_SA(1, 0), cA + kstep, voffA); PG8_STAGE(PG8_SB(1, 1), cB + hstep + kstep, voffB);
        PG8_WAIT_V(6); PG8_BAR;
    } else {
        PG8_STAGE(PG8_SB(0, 0), cB, voffB); PG8_STAGE(PG8_SA(0, 0), cA, voffA); PG8_STAGE(PG8_SB(0, 1), cB + hstep, voffB); PG8_STAGE(PG8_SA(0, 1), cA + hstep, voffA);
        if (wr == 1) PG8_BAR;
        PG8_WAIT_V(4); PG8_BAR;
        PG8_STAGE(PG8_SB(1, 0), cB + kstep, voffB); PG8_STAGE(PG8_SA(1, 0), cA + kstep, voffA); PG8_STAGE(PG8_SB(1, 1), cB + hstep + kstep, voffB);
        PG8_WAIT_V(6); PG8_BAR;
    }
    for (;;) {
        const bool has_next = S.next(ui + 1, nxt);
        const char* nA = has_next ? (const char*)g.A + (size_t)nxt.pm * tstep : cA; const char* nB = has_next ? (const char*)g.Bt + (size_t)nxt.pn * tstep : cB;
        for (int t = 0; t < nt; t += 2) {
            const bool last = (t == nt - 2);
            const char* a1 = cA + (size_t)(t + 1) * kstep;
            const char* a2 = last ? nA : cA + (size_t)(t + 2) * kstep; const char* b2 = last ? nB : cB + (size_t)(t + 2) * kstep;
            const char* a3 = a2 + kstep; const char* b3 = b2 + kstep;
            if (last && has_next) S.a_ready(nxt);
            if constexpr (SP2) {
            PG8_LDB(B0, 0, 0); PG8_LDB(B1, 0, 1); PG8_SCHED; PG8_LDA(At, 0, 0); PG8_STAGE(PG8_SA(1, 1), a1 + hstep, voffA);
            PG8_WAIT_V(8); PG8_WAIT_L(0); PG8_BAR; PG8_MMA(0, 0, At, B0); PG8_MMA(0, 1, At, B1); PG8_BAR; PG8_SCHED;
            PG8_LDA(At, 0, 1); PG8_STAGE(PG8_SB(0, 0), b2, voffB); PG8_STAGE(PG8_SB(0, 1), b2 + hstep, voffB); PG8_STAGE(PG8_SA(0, 0), a2, voffA);
            PG8_WAIT_V(8); PG8_WAIT_L(0); PG8_BAR; PG8_MMA(1, 0, At, B0); PG8_MMA(1, 1, At, B1); PG8_BAR; PG8_SCHED;
            PG8_LDB(B0, 1, 0); PG8_LDB(B1, 1, 1); PG8_SCHED; PG8_LDA(At, 1, 0); PG8_STAGE(PG8_SA(0, 1), a2 + hstep, voffA);
            PG8_WAIT_V(8); PG8_WAIT_L(0); PG8_BAR; PG8_MMA(0, 0, At, B0); PG8_MMA(0, 1, At, B1); PG8_BAR; PG8_SCHED;
            PG8_LDA(At, 1, 1); PG8_STAGE(PG8_SB(1, 0), b3, voffB); PG8_STAGE(PG8_SB(1, 1), b3 + hstep, voffB); PG8_STAGE(PG8_SA(1, 0), a3, voffA);
            PG8_WAIT_V(8); PG8_WAIT_L(0); PG8_BAR; PG8_MMA(1, 0, At, B0); PG8_MMA(1, 1, At, B1); PG8_BAR; PG8_SCHED;
            } else {
            PG8_LDB(B0, 0, 0); PG8_SCHED; PG8_LDA(At, 0, 0); PG8_STAGE(PG8_SA(1, 1), a1 + hstep, voffA);
            PG8_WAIT_L(8); PG8_BAR; PG8_WAIT_L(0); PG8_MMA(0, 0, At, B0); PG8_BAR; PG8_SCHED;
            PG8_LDB(B1, 0, 1); PG8_STAGE(PG8_SB(0, 0), b2, voffB);
            PG8_BAR; PG8_WAIT_L(0); PG8_MMA(0, 1, At, B1); PG8_BAR;
            PG8_LDA(At, 0, 1); PG8_STAGE(PG8_SA(0, 0), a2, voffA);
            PG8_BAR; PG8_WAIT_L(0); PG8_MMA(1, 0, At, B0); PG8_BAR; PG8_SCHED;
            PG8_STAGE(PG8_SB(0, 1), b2 + hstep, voffB);
            PG8_WAIT_V(6); PG8_BAR; PG8_MMA(1, 1, At, B1); PG8_BAR;
            PG8_LDB(B0, 1, 0); PG8_SCHED; PG8_LDA(At, 1, 0); PG8_STAGE(PG8_SA(0, 1), a2 + hstep, voffA);
            PG8_WAIT_L(8); PG8_BAR; PG8_WAIT_L(0); PG8_MMA(0, 0, At, B0); PG8_BAR; PG8_SCHED;
            PG8_LDB(B1, 1, 1); PG8_STAGE(PG8_SB(1, 0), b3, voffB);
            PG8_BAR; PG8_WAIT_L(0); PG8_MMA(0, 1, At, B1); PG8_BAR;
            PG8_LDA(At, 1, 1); PG8_STAGE(PG8_SA(1, 0), a3, voffA);
            PG8_BAR; PG8_WAIT_L(0); PG8_MMA(1, 0, At, B0); PG8_BAR; PG8_SCHED;
            PG8_STAGE(PG8_SB(1, 1), b3 + hstep, voffB);
            PG8_WAIT_V(6); PG8_BAR; PG8_MMA(1, 1, At, B1); PG8_BAR;
            }
        }
        if constexpr (ALIGN_EPI) { if (wr == 0) PG8_BAR; }
        if constexpr (!Epi::AFTER_DRAIN) { E(acc, cur, wr, wc, fr, fq); S.done(cur); }
        if (!has_next) break;
#pragma unroll
        for (int a = 0; a < 2; ++a)
#pragma unroll
            for (int b = 0; b < 2; ++b)
#pragma unroll
                for (int m = 0; m < 4; ++m)
#pragma unroll
                    for (int n = 0; n < 2; ++n) acc[a][b][m][n] = (f32x4){0.f, 0.f, 0.f, 0.f};
        cur = nxt; cA = nA; cB = nB; ++ui;
        if constexpr (ALIGN_EPI) { if (wr == 1) PG8_BAR; }
    }
    PG8_WAIT_V(0);
    if constexpr (!ALIGN_EPI) { if (wr == 0) PG8_BAR; }
    PG8_BAR;
    if constexpr (Epi::AFTER_DRAIN) { E.fused(acc, cur, wr, wc, fr, fq, lds, wid, lane); S.done(cur); }
#undef PG8_SA
#undef PG8_SB
#undef PG8_STAGE
#undef PG8_LDA
#undef PG8_LDB
#undef PG8_MMA
#undef PG8_WAIT_V
#undef PG8_WAIT_L
#undef PG8_BAR
#undef PG8_SCHED
}
}
#include <hip/hip_bf16.h>
#include <cmath>
namespace attn_body {
using bf16=__hip_bfloat16;
using bf16x8=__attribute__((ext_vector_type(8)))short;
using s16x4=__attribute__((ext_vector_type(4)))short;
using f32x16=__attribute__((ext_vector_type(16)))float;
using u32x4=__attribute__((ext_vector_type(4)))unsigned;
constexpr int BATCH=4,NHEAD=16,SEQ=8192,D=64,DM=NHEAD*D,OP=2048;
constexpr int NW=8,QBLK=32,QB=QBLK*NW,KVBLK=64,NQB=SEQ/QB;
constexpr int ATTN_PITCH=DM, ATTN_UNIT_ROWS=QB;
__device__ __forceinline__ int crow(int r,int hi){return (r&3)+8*(r>>2)+4*hi;}
#define SBAR() __builtin_amdgcn_sched_barrier(0)
__device__ __forceinline__ void cmask(f32x16&p0,f32x16&p1,int jb,int qrel,int hi){
  const float NEG=-INFINITY; (void)hi;
  if(jb>(qrel>>6)){
  #pragma unroll
  for(int r=0;r<16;++r){p0[r]=NEG;p1[r]=NEG;}}
}

constexpr int NSLOT=3, SLOTB=8192, SLOTV=16384;
constexpr int LDS_K=0, LDS_V=NSLOT*SLOTB, LDS_WS=LDS_V+NSLOT*SLOTV, LDS_OST=LDS_WS+NW*64*4, LDS_BYTES=LDS_OST+NW*4096;
constexpr float C2=0.125f*1.4426950408889634f;
__device__ __forceinline__ void glds16(const void*gsrc,unsigned lds_dst){unsigned keep;
  asm volatile("s_mov_b32 %0, m0\n\ts_mov_b32 m0, %2\n\ts_nop 0\n\tglobal_load_lds_dwordx4 %1, off\n\ts_mov_b32 m0, %0":"=&s"(keep):"v"(gsrc),"s"(lds_dst):"memory");}
__device__ __forceinline__ float max3f(float a,float b,float c){float r;asm("v_max3_f32 %0, %1, %2, %3":"=v"(r):"v"(a),"v"(b),"v"(c));return r;}
__device__ __forceinline__ float max2f(float a,float b){float r;asm("v_max_f32_e32 %0, %1, %2":"=v"(r):"v"(a),"v"(b));return r;}
__device__ __forceinline__ float fadd_s(float a,float b){float r;asm("v_add_f32_e32 %0, %1, %2":"=v"(r):"v"(a),"v"(b));return r;}
__device__ __forceinline__ float fsub_s(float a,float b){float r;asm("v_sub_f32_e32 %0, %1, %2":"=v"(r):"v"(a),"v"(b));return r;}
typedef float f32x2_t __attribute__((ext_vector_type(2))); typedef __bf16 bf16x2_t __attribute__((ext_vector_type(2)));
__device__ __forceinline__ unsigned cvtpk_s(float lo,float hi){f32x2_t v={lo,hi};bf16x2_t b=__builtin_convertvector(v,bf16x2_t);return __builtin_bit_cast(unsigned,b);}
#define WAIT_BAR(N) asm volatile("s_waitcnt vmcnt(" #N ") lgkmcnt(0)\n\ts_barrier":::"memory")

__device__ __forceinline__ void qkt(f32x16&p0,f32x16&p1,const char*Kslot,const bf16x8*qr,int r32,int hi){
  const f32x16 zero16={};
  const char*kb=Kslot+hi*1024+r32*16;
  #pragma unroll
  for(int d0=0;d0<4;++d0){
    const bf16x8 b0=*reinterpret_cast<const bf16x8*>(kb+d0*2048);
    const bf16x8 b1=*reinterpret_cast<const bf16x8*>(kb+d0*2048+512);
    if(d0==0){p0=__builtin_amdgcn_mfma_f32_32x32x16_bf16(b0,qr[0],zero16,0,0,0);p1=__builtin_amdgcn_mfma_f32_32x32x16_bf16(b1,qr[0],zero16,0,0,0);}
    else{p0=__builtin_amdgcn_mfma_f32_32x32x16_bf16(b0,qr[d0],p0,0,0,0);p1=__builtin_amdgcn_mfma_f32_32x32x16_bf16(b1,qr[d0],p1,0,0,0);}}
}
typedef __attribute__((address_space(3))) const char* lds_cptr;
typedef short v4i16_t __attribute__((ext_vector_type(4)));
__device__ __forceinline__ void kload8(bf16x8*kf,lds_cptr kp){
  kf[0]=*(const __attribute__((address_space(3))) bf16x8*)(kp);      kf[1]=*(const __attribute__((address_space(3))) bf16x8*)(kp+512);
  kf[2]=*(const __attribute__((address_space(3))) bf16x8*)(kp+2048); kf[3]=*(const __attribute__((address_space(3))) bf16x8*)(kp+2560);
  kf[4]=*(const __attribute__((address_space(3))) bf16x8*)(kp+4096); kf[5]=*(const __attribute__((address_space(3))) bf16x8*)(kp+4608);
  kf[6]=*(const __attribute__((address_space(3))) bf16x8*)(kp+6144); kf[7]=*(const __attribute__((address_space(3))) bf16x8*)(kp+6656);
}
__device__ __forceinline__ void kload2(bf16x8*kf,lds_cptr kp,int j){ kf[2*j]=*(const __attribute__((address_space(3))) bf16x8*)(kp+j*2048); kf[2*j+1]=*(const __attribute__((address_space(3))) bf16x8*)(kp+j*2048+512); }
__device__ __forceinline__ s16x4 vtr(lds_cptr p){ return __builtin_bit_cast(s16x4,__builtin_amdgcn_ds_read_tr16_b64_v4i16((__attribute__((address_space(3))) v4i16_t*)p)); }
__device__ __forceinline__ float rowmax(const f32x16&p0,const f32x16&p1){
  float a=max3f(p0[0],p0[1],p1[0]),b=max3f(p0[2],p0[3],p1[1]);a=max3f(a,p1[2],p1[3]);
  #pragma unroll
  for(int r=4;r<16;r+=4){a=max3f(a,p0[r],p0[r+1]);b=max3f(b,p0[r+2],p0[r+3]);a=max3f(a,p1[r],p1[r+1]);b=max3f(b,p1[r+2],p1[r+3]);}
  const float m=max2f(a,b);
  auto rr=__builtin_amdgcn_permlane32_swap(__float_as_uint(m),__float_as_uint(m),false,false);
  return max2f(__uint_as_float(rr[0]),__uint_as_float(rr[1]));
}
__device__ __forceinline__ void pv(f32x16*o,lds_cptr vb,const int(&voff)[4],bf16x8 pa0,bf16x8 pa1,bf16x8 pa2,bf16x8 pa3){
  #pragma unroll
  for(int d0=0;d0<4;++d0){
    const bf16x8 f0=*(const __attribute__((address_space(3))) bf16x8*)(vb+voff[0]+d0*4096), f1=*(const __attribute__((address_space(3))) bf16x8*)(vb+voff[1]+d0*4096);
    const bf16x8 f2=*(const __attribute__((address_space(3))) bf16x8*)(vb+voff[2]+d0*4096), f3=*(const __attribute__((address_space(3))) bf16x8*)(vb+voff[3]+d0*4096);
    o[d0]=__builtin_amdgcn_mfma_f32_32x32x16_bf16(pa0,f0,o[d0],0,0,0);
    o[d0]=__builtin_amdgcn_mfma_f32_32x32x16_bf16(pa1,f1,o[d0],0,0,0);
    o[d0]=__builtin_amdgcn_mfma_f32_32x32x16_bf16(pa2,f2,o[d0],0,0,0);
    o[d0]=__builtin_amdgcn_mfma_f32_32x32x16_bf16(pa3,f3,o[d0],0,0,0);
  }
}

#ifndef ATTN_STORE16
#define ATTN_STORE16(p,v) (*(u32x4*)(p)=(v))
#endif
template<int THRL> __device__ __forceinline__ void attn_unit(int b,int h,int qb,const bf16*__restrict__ Q,const bf16*__restrict__ K,const bf16*__restrict__ V,bf16* O,const bf16*__restrict__ GA,const float*__restrict__ hg,const float lam,char*shm,const int wid){
  const int lane=lane_id(),r32=lane&31,hi=lane>>5;
  const long rowbase=(long)b*SEQ; const int q0=qb*QB;
  const bf16*Qw=Q+(rowbase+q0+wid*QBLK)*DM+h*D;
  const bf16*Kh=K+rowbase*DM+h*D,*Vh=V+((long)(b*8+(h>>1))*128)*SEQ;
  const unsigned lds0=(unsigned)(uintptr_t)shm;
  float*wsf=(float*)(shm+LDS_WS)+wid*64;
  const bf16*ksrc=Kh+(long)lane*DM+wid*8;
  const bf16*vsrc=Vh+(long)(8*wid+(lane>>3))*SEQ+(((lane&7)^((4*(wid&1)+(lane>>4))&7))*8);
  const unsigned kdst=lds0+LDS_K+wid*1024, vdst=lds0+LDS_V+wid*1024;
  #define DMA_K(t,slot) glds16(ksrc+(long)(t)*KVBLK*DM,(unsigned)__builtin_amdgcn_readfirstlane(kdst+(slot)))
  #define DMA_V(t,slot) do{ glds16(vsrc+(long)(t)*KVBLK,(unsigned)__builtin_amdgcn_readfirstlane(vdst+2*(slot))); glds16(vsrc+64l*SEQ+(long)(t)*KVBLK,(unsigned)__builtin_amdgcn_readfirstlane(vdst+8192+2*(slot))); }while(0)
  int voff[4];
  #pragma unroll
  for(int ks=0;ks<4;++ks)voff[ks]=r32*128+(((2*ks+hi)^((r32>>1)&7))*16);
  const char*Kbase=shm+LDS_K; bf16x8 kf[8];
  const lds_cptr shm3=(lds_cptr)shm; const lds_cptr kp0=shm3+LDS_K+hi*1024+r32*16; const lds_cptr vp0=shm3+LDS_V;
  const int NT=(q0+QB)/KVBLK;
  DMA_K(0,0);DMA_V(0,0);DMA_K(1,SLOTB);
  bf16x8 qr[4];
  #pragma unroll
  for(int d0=0;d0<4;++d0)qr[d0]=*reinterpret_cast<const bf16x8*>(&Qw[(long)r32*DM+d0*16+hi*8]);
  float l_reg=0.f;f32x16 o[4];o[0]=f32x16{};o[1]=f32x16{};o[2]=f32x16{};o[3]=f32x16{};const f32x16 zero16={};
  const int qrel=wid*QBLK;
  #define CMASK(P0,P1,t) do{int jb_=(t)-(NT-4); if(jb_>=0)cmask(P0,P1,jb_,qrel,hi);}while(0)
  bool resc=false;
  #define START(P0,P1) do{ resc=false; \
    _Pragma("unroll") for(int r=0;r<16;++r)P0[r]=__builtin_amdgcn_exp2f(P0[r]); }while(0)
  #define RESC() do{ if(resc){ asm volatile("s_waitcnt lgkmcnt(0)":::"memory"); \
      _Pragma("unroll") for(int d_=0;d_<4;++d_) _Pragma("unroll") for(int r=0;r<16;++r)o[d_][r]*=wsf[crow(r,hi)]; } }while(0)
  f32x16 pA0,pA1,pB0,pB1;
  int sl_prev=0,sl_cur=0,sl_next=SLOTB;
  #define ROT() do{sl_prev=sl_cur;sl_cur=sl_next;sl_next=(sl_next==(NSLOT-1)*SLOTB)?0:sl_next+SLOTB;}while(0)
  DMA_K(2,2*SLOTB);
  WAIT_BAR(3);
  qkt(pA0,pA1,Kbase,qr,r32,hi);asm volatile("s_nop 15\n\ts_nop 7":"+v"(pA0),"+v"(pA1));CMASK(pA0,pA1,0);
  START(pA0,pA1);
  _Pragma("unroll") for(int r=0;r<16;++r)pA1[r]=__builtin_amdgcn_exp2f(pA1[r]);
  WAIT_BAR(0);
  DMA_K(3,0);DMA_V(1,SLOTB);
  ROT();
  kload8(kf,kp0+sl_cur);
  WAIT_BAR(3);
  bf16x8 vf[8]; u32x4 pw0,pw1,pw2,pw3;
  #define PKW(P,B) cvtpk_s(P[B],P[B+1])
  #define PAF(k) __builtin_bit_cast(bf16x8,pw##k)
  #define VFR(i) vf[i]
  #define PIN(x) asm volatile("":"+v"(x))
  #define MX3(a,b,c) __builtin_fmaxf(__builtin_fmaxf((a),(b)),(c))
  #define GAPA(MF,A0,A1,A2,A3,W0,W1,PW) do{ MF; sacc+=A0; sacc+=A1; sacc+=A2; sacc+=A3; PIN(sacc); W0; W1; PIN(PW); SBAR(); }while(0)
  #define EX(v) __builtin_amdgcn_exp2f(v)
  #define GAPB(MF,RL,X,B) do{ MF; RL; X[B]=EX(X[B]); X[B+1]=EX(X[B+1]); PIN(X); SBAR(); }while(0)
  #define VRD(i) do{ vf[i]=*(const __attribute__((address_space(3))) bf16x8*)(vp_+voff[(i)&3]+((i)>>2)*4096); }while(0)
  #define VRD2(i) do{ vf[i]=*(const __attribute__((address_space(3))) bf16x8*)(vp_+voff[(i)&3]+(((i)>>2)+2)*4096); }while(0)
  #define KRD(G,j) do{ if(G){ kload2(kf,kp0+sl_next,j); SBAR(); } }while(0)
  #define STEP(C0,C1,P0,P1,t,GK,GV,GL) do{ SBAR(); \
    const lds_cptr vp_=vp0+2*sl_prev; \
    VRD(0); SBAR(); float sacc=(P0[0]+P0[1]); \
    GAPA(C0=__builtin_amdgcn_mfma_f32_32x32x16_bf16(kf[0],qr[0],zero16,0,0,0), P0[2],P0[3],P0[4],P0[5],     pw0[0]=PKW(P0,0), pw0[1]=PKW(P0,2), pw0); \
    VRD(4); SBAR(); GAPA(C1=__builtin_amdgcn_mfma_f32_32x32x16_bf16(kf[1],qr[0],zero16,0,0,0), P0[6],P0[7],P0[8],P0[9],     pw0[2]=PKW(P0,4), pw0[3]=PKW(P0,6), pw0); \
    VRD(1); SBAR(); GAPA(C0=__builtin_amdgcn_mfma_f32_32x32x16_bf16(kf[2],qr[1],C0,0,0,0),   P0[10],P0[11],P0[12],P0[13], pw1[0]=PKW(P0,8), pw1[1]=PKW(P0,10), pw1); \
    VRD(5); SBAR(); GAPA(C1=__builtin_amdgcn_mfma_f32_32x32x16_bf16(kf[3],qr[1],C1,0,0,0),   P0[14],P0[15],P1[0],P1[1],   pw1[2]=PKW(P0,12),pw1[3]=PKW(P0,14), pw1); \
    VRD(2); SBAR(); GAPA(C0=__builtin_amdgcn_mfma_f32_32x32x16_bf16(kf[4],qr[2],C0,0,0,0),   P1[2],P1[3],P1[4],P1[5],     pw2[0]=PKW(P1,0), pw2[1]=PKW(P1,2), pw2); \
    VRD(6); SBAR(); GAPA(C1=__builtin_amdgcn_mfma_f32_32x32x16_bf16(kf[5],qr[2],C1,0,0,0),   P1[6],P1[7],P1[8],P1[9],     pw2[2]=PKW(P1,4), pw2[3]=PKW(P1,6), pw2); \
    VRD(3); SBAR(); GAPA(C0=__builtin_amdgcn_mfma_f32_32x32x16_bf16(kf[6],qr[3],C0,0,0,0),   P1[10],P1[11],P1[12],P1[13], pw3[0]=PKW(P1,8), pw3[1]=PKW(P1,10), pw3); \
    VRD(7); SBAR(); GAPA(C1=__builtin_amdgcn_mfma_f32_32x32x16_bf16(kf[7],qr[3],C1,0,0,0),   P1[14],P1[15],0.f,0.f,       pw3[2]=PKW(P1,12),pw3[3]=PKW(P1,14), pw3); \
    l_reg+=sacc; \
    if(GK){DMA_K((t)+3,sl_cur);} if(GV){DMA_V((t)+1,sl_next);} \
    CMASK(C0,C1,t); \
    SBAR(); \
    GAPB(o[0]=__builtin_amdgcn_mfma_f32_32x32x16_bf16(PAF(0),VFR(0),o[0],0,0,0), VRD2(0), C0,0); \
    GAPB(o[1]=__builtin_amdgcn_mfma_f32_32x32x16_bf16(PAF(0),VFR(4),o[1],0,0,0), VRD2(4), C0,2); \
    KRD(GL,0); GAPB(o[0]=__builtin_amdgcn_mfma_f32_32x32x16_bf16(PAF(1),VFR(1),o[0],0,0,0), VRD2(1), C0,4); \
    KRD(GL,1); GAPB(o[1]=__builtin_amdgcn_mfma_f32_32x32x16_bf16(PAF(1),VFR(5),o[1],0,0,0), VRD2(5), C0,6); \
    KRD(GL,2); GAPB(o[0]=__builtin_amdgcn_mfma_f32_32x32x16_bf16(PAF(2),VFR(2),o[0],0,0,0), VRD2(2), C0,8); \
    KRD(GL,3); GAPB(o[1]=__builtin_amdgcn_mfma_f32_32x32x16_bf16(PAF(2),VFR(6),o[1],0,0,0), VRD2(6), C0,10); \
    GAPB(o[0]=__builtin_amdgcn_mfma_f32_32x32x16_bf16(PAF(3),VFR(3),o[0],0,0,0), VRD2(3), C0,12); \
    GAPB(o[1]=__builtin_amdgcn_mfma_f32_32x32x16_bf16(PAF(3),VFR(7),o[1],0,0,0), VRD2(7), C0,14); \
    GAPB(o[2]=__builtin_amdgcn_mfma_f32_32x32x16_bf16(PAF(0),VFR(0),o[2],0,0,0), (void)0, C1,0); \
    GAPB(o[3]=__builtin_amdgcn_mfma_f32_32x32x16_bf16(PAF(0),VFR(4),o[3],0,0,0), (void)0, C1,2); \
    GAPB(o[2]=__builtin_amdgcn_mfma_f32_32x32x16_bf16(PAF(1),VFR(1),o[2],0,0,0), (void)0, C1,4); \
    GAPB(o[3]=__builtin_amdgcn_mfma_f32_32x32x16_bf16(PAF(1),VFR(5),o[3],0,0,0), (void)0, C1,6); \
    GAPB(o[2]=__builtin_amdgcn_mfma_f32_32x32x16_bf16(PAF(2),VFR(2),o[2],0,0,0), (void)0, C1,8); \
    GAPB(o[3]=__builtin_amdgcn_mfma_f32_32x32x16_bf16(PAF(2),VFR(6),o[3],0,0,0), (void)0, C1,10); \
    GAPB(o[2]=__builtin_amdgcn_mfma_f32_32x32x16_bf16(PAF(3),VFR(3),o[2],0,0,0), (void)0, C1,12); \
    GAPB(o[3]=__builtin_amdgcn_mfma_f32_32x32x16_bf16(PAF(3),VFR(7),o[3],0,0,0), (void)0, C1,14); \
    }while(0)
  int t=1;
  #undef CMASK
  #define CMASK(P0,P1,t) do{}while(0)
  for(;t+5<NT;t+=2){
    STEP(pB0,pB1,pA0,pA1,t,true,true,true);     WAIT_BAR(3); RESC(); ROT();
    STEP(pA0,pA1,pB0,pB1,t+1,true,true,true);   WAIT_BAR(3); RESC(); ROT();
  }
  #undef CMASK
  #define CMASK(P0,P1,t) do{int jb_=(t)-(NT-4); if(jb_>=0)cmask(P0,P1,jb_,qrel,hi);}while(0)
  #define ENDW(tt) do{ if((tt)+3<NT){WAIT_BAR(3);} else if((tt)+2<NT){WAIT_BAR(2);} else {WAIT_BAR(0);} }while(0)
  for(;t+1<NT;t+=2){
    STEP(pB0,pB1,pA0,pA1,t,(t+3<NT),(t+1<NT),(t+1<NT));       ENDW(t);   RESC(); ROT();
    STEP(pA0,pA1,pB0,pB1,t+1,(t+4<NT),(t+2<NT),(t+2<NT));     ENDW(t+1); RESC(); ROT();
  }
  STEP(pB0,pB1,pA0,pA1,NT-1,false,false,false); RESC();
  { float sacc=pB0[0]+pB0[1]; _Pragma("unroll") for(int r=2;r<16;++r)sacc+=pB0[r]; _Pragma("unroll") for(int r=0;r<16;++r)sacc+=pB1[r]; l_reg+=sacc;
    pw0=(u32x4){PKW(pB0,0),PKW(pB0,2),PKW(pB0,4),PKW(pB0,6)};pw1=(u32x4){PKW(pB0,8),PKW(pB0,10),PKW(pB0,12),PKW(pB0,14)};pw2=(u32x4){PKW(pB1,0),PKW(pB1,2),PKW(pB1,4),PKW(pB1,6)};pw3=(u32x4){PKW(pB1,8),PKW(pB1,10),PKW(pB1,12),PKW(pB1,14)};
    SBAR(); pv(o,vp0+2*sl_cur,voff,PAF(0),PAF(1),PAF(2),PAF(3)); }
  #undef PKW
  #undef PAF
  #undef VFR
  #undef PIN
  #undef MX3
  #undef GAPA
  #undef GAPB
  #undef EX
  #undef VRD
  #undef KRD
  #undef STEP
  #undef ENDW
  {auto rr=__builtin_amdgcn_permlane32_swap(__float_as_uint(l_reg),__float_as_uint(l_reg),false,false);l_reg=__uint_as_float(rr[0])+__uint_as_float(rr[1]);}
  if(hi==0)wsf[32+r32]=l_reg;asm volatile("s_waitcnt lgkmcnt(0)":::"memory");
  float rli[16];
  #pragma unroll
  for(int r=0;r<16;++r)rli[r]=__builtin_amdgcn_rcpf(wsf[32+crow(r,hi)]);
  const long grow0=rowbase+q0+wid*QBLK;
  bf16*Ow=O+grow0*(long)OP+(h>>1)*128;
  { bf16*stg=(bf16*)(shm+LDS_OST)+wid*2048;
    if((h&1)==0){
    #pragma unroll
    for(int ps=0;ps<2;++ps){
      #pragma unroll
      for(int r=0;r<16;++r){const int orow=crow(r,hi);
        #pragma unroll
        for(int d0=0;d0<2;++d0)stg[orow*64+d0*32+r32]=__float2bfloat16(o[2*ps+d0][r]*rli[r]);}
      asm volatile("s_waitcnt lgkmcnt(0)":::"memory");
      #pragma unroll
      for(int i=0;i<4;++i){const int row=i*8+(lane>>3),ch=lane&7; const u32x4 v=*(const u32x4*)(stg+row*64+ch*8); ATTN_STORE16(Ow+(long)row*OP+ps*64+ch*8,v);}
      asm volatile("s_waitcnt lgkmcnt(0)":::"memory");
    }
    }else{
    float dd[2][4][8]; const int ch=lane&7;
    #pragma unroll
    for(int ps=0;ps<2;++ps){
      #pragma unroll
      for(int r=0;r<16;++r){const int orow=crow(r,hi);
        #pragma unroll
        for(int d0=0;d0<2;++d0)stg[orow*64+d0*32+r32]=__float2bfloat16(o[2*ps+d0][r]*rli[r]);}
      asm volatile("s_waitcnt lgkmcnt(0)":::"memory");
      #pragma unroll
      for(int i=0;i<4;++i){const int row=i*8+(lane>>3); const u32x4 v=*(const u32x4*)(stg+row*64+ch*8); const u32x4 z=*(const u32x4*)(Ow+(long)row*OP+ps*64+ch*8);
        #pragma unroll
        for(int q=0;q<4;++q){ dd[ps][i][2*q]=__builtin_bit_cast(float,z[q]<<16)-lam*__builtin_bit_cast(float,v[q]<<16); dd[ps][i][2*q+1]=__builtin_bit_cast(float,z[q]&0xffff0000u)-lam*__builtin_bit_cast(float,v[q]&0xffff0000u); } }
      asm volatile("s_waitcnt lgkmcnt(0)":::"memory");
    }
    float rs[4];
    #pragma unroll
    for(int i=0;i<4;++i){ float ss=0.f;
      #pragma unroll
      for(int ps=0;ps<2;++ps)
        #pragma unroll
        for(int e=0;e<8;++e)ss+=dd[ps][i][e]*dd[ps][i][e];
      ss+=__shfl_xor(ss,1); ss+=__shfl_xor(ss,2); ss+=__shfl_xor(ss,4);
      rs[i]=__builtin_amdgcn_rsqf(ss*(1.0f/128.0f)+1e-6f); }
    #pragma unroll
    for(int ps=0;ps<2;++ps){ float hgv[8];
      #pragma unroll
      for(int e=0;e<8;++e)hgv[e]=hg[ps*64+ch*8+e];
      #pragma unroll
      for(int i=0;i<4;++i){const int row=i*8+(lane>>3); const u32x4 g=*(const u32x4*)(GA+(grow0+row)*(long)DM+(h>>1)*128+ps*64+ch*8); u32x4 w;
        #pragma unroll
        for(int q=0;q<4;++q) w[q]=cvtpk_s(dd[ps][i][2*q]*rs[i]*hgv[2*q]*__builtin_bit_cast(float,g[q]<<16), dd[ps][i][2*q+1]*rs[i]*hgv[2*q+1]*__builtin_bit_cast(float,g[q]&0xffff0000u));
        ATTN_STORE16(Ow+(long)row*OP+ps*64+ch*8,w); } }
    } }
  asm volatile("s_waitcnt lgkmcnt(0)\n\ts_barrier":::"memory");
  #undef DMA_K
  #undef DMA_V
  #undef CMASK
  #undef START
  #undef RESC
  #undef ROT
}
constexpr int ATTN_LDS_BYTES=LDS_BYTES;
struct AttnTensors { const bf16* Q; const bf16* K; const bf16* V; bf16* O; const bf16* GA; const float* hg; float lam; };
struct AttnUnit { int b, hm, qb; };
struct AttnOrder {
  int vcu, G;
  __device__ __forceinline__ AttnOrder(int grid,int v):vcu(v),G(grid){}
  __device__ __forceinline__ bool next(int i,AttnUnit&u)const{
    int head,qb; const int map=i&1,k=i>>1;
    if(G==256){ if(k>=4)return false; head=vcu>>3; const int sq=vcu&7; qb=(k==0)?sq:(k==1)?15-sq:(k==2)?16+sq:31-sq; }
    else{ const int L=k*G+vcu; if(L>=1024)return false; head=L>>5; qb=31-(L&31); }
    u.b=head>>3; u.hm=2*(head&7)+map; u.qb=qb; return true; }
};
template<class Sched,int THRL=8> __device__ __forceinline__ void attn_phase(char*lds,const AttnTensors&T,const Sched&S,const int wid){
  AttnUnit u;
  for(int i=0;S.next(i,u);++i){ attn_unit<THRL>(u.b,u.hm,u.qb,T.Q,T.K,T.V,T.O,T.GA,T.hg,T.lam,lds,wid); }
}
#undef SBAR
#undef WAIT_BAR
}
constexpr int NWAVES = 8;
constexpr int BATCH = 4, SEQ = 8192, DM = 1024, M = BATCH * SEQ, NPROJ = 6144, MIXW = 2048;
constexpr int NGRP = 64;
constexpr float NORM_EPS = 1e-6f;
constexpr float LAM_INIT = 0.2f;

constexpr size_t MiB = 1u << 20;
constexpr size_t WS_MOD = 0;
constexpr size_t WS_A16 = 256 * 1024;
constexpr size_t WS_A128 = 320 * 1024;
constexpr size_t WS_HGS = 384 * 1024;
constexpr size_t WS_MODP = 512 * 1024;
constexpr size_t WS_WIN = 2 * MiB;
constexpr size_t WS_WGLU = 14 * MiB;
constexpr size_t WS_WOUT = 16 * MiB;
constexpr size_t WS_ROPE = 20 * MiB;
constexpr size_t WS_TT = 22 * MiB;
constexpr size_t WS_WS = 30 * MiB;
constexpr size_t WS_WOT = 34 * MiB;
constexpr size_t WS_Q = 40 * MiB, WS_K = 104 * MiB, WS_V = 168 * MiB, WS_GA = 232 * MiB, WS_GS = 296 * MiB, WS_END = 488 * MiB;
constexpr size_t WS_MIX = 360 * MiB;

constexpr int RING_OFF = 0, RING_BYTES = 131072;
constexpr int LDS_BYTES = 147456;

#define GAS __attribute__((address_space(1)))
#define LAS __attribute__((address_space(3)))
typedef unsigned short bf16;
typedef unsigned v4u __attribute__((ext_vector_type(4)));
typedef unsigned v2u __attribute__((ext_vector_type(2)));
typedef float f32x4 __attribute__((ext_vector_type(4)));
typedef float f32x2v __attribute__((ext_vector_type(2)));
typedef float f32x16 __attribute__((ext_vector_type(16)));
typedef short bf16x8 __attribute__((ext_vector_type(8)));
#define LDS_WAIT() asm volatile("s_waitcnt lgkmcnt(0)" ::: "memory")
__device__ __forceinline__ unsigned f2bf(float f) { unsigned u = __builtin_bit_cast(unsigned, f); return (u + 0x7fffu + ((u >> 16) & 1u)) >> 16; }
__device__ __forceinline__ unsigned pk2(float lo, float hi) { return f2bf(lo) | (f2bf(hi) << 16); }
__device__ __forceinline__ float wave_sum(float v) {
#pragma unroll
    for (int o = 1; o < 64; o <<= 1) v += __shfl_xor(v, o);
    return v;
}

typedef GAS unsigned gu32;
#define XB_TMO      128
#define XB_XCNT(j)  (256  + 64 * (j))
#define XB_XSUB(j)  (1280 + 64 * (j))
#define XB_XGEN(j)  (2304 + 64 * (j))
#define XB_TOP      3328
#define XB_TOPGEN   3392
#define XCD_BAR_WORDS 3456
#define XB_SPIN_CAP (1u << 18)

__device__ __forceinline__ unsigned xb_ld(unsigned* p)              { return __hip_atomic_load(p, __ATOMIC_RELAXED, __HIP_MEMORY_SCOPE_AGENT); }
__device__ __forceinline__ unsigned xb_add(unsigned* p, unsigned v) { return __hip_atomic_fetch_add(p, v, __ATOMIC_RELAXED, __HIP_MEMORY_SCOPE_AGENT); }
__device__ __forceinline__ unsigned xb_xcc_id() { return (unsigned)__builtin_amdgcn_s_getreg((3 << 11) | 20) & 0xFu; }
#define XB_SPIN(cond, bar) do { unsigned _sp = 0; while (cond) { __builtin_amdgcn_s_sleep(1); \
    if ((++_sp & 255u) == 0u) { if (xb_ld(&(bar)[XB_TMO])) break; if (_sp > XB_SPIN_CAP) { atomicAdd(&(bar)[XB_TMO], 1u); break; } } } } while (0)

struct XcdBarrier {
    unsigned* bar; unsigned x;
    volatile LAS unsigned* st;
};

__device__ __forceinline__ XcdBarrier xcd_barrier_post(unsigned* bar, volatile LAS unsigned* st) {
    XcdBarrier b; b.bar = bar; b.x = xb_xcc_id(); b.st = st;
    if (threadIdx.x == 0) (void)xb_add(&bar[XB_XCNT(b.x)], 1u);
    return b;
}
__device__ __forceinline__ void xcd_barrier_complete(unsigned* bar, unsigned x, unsigned& nloc, unsigned& nx) {
    const unsigned G = gridDim.x * gridDim.y * gridDim.z;
    unsigned sum, cnt, mine, sp = 0u;
    for (;;) {
        sum = 0u; cnt = 0u; mine = 0u;
#pragma unroll
        for (unsigned j = 0; j < 16; ++j) { const unsigned c = xb_ld(&bar[XB_XCNT(j)]); sum += c; cnt += (c > 0u) ? 1u : 0u; mine = (j == x) ? c : mine; }
        if (sum == G) break;
        __builtin_amdgcn_s_sleep(1);
        if ((++sp & 255u) == 0u) { if (xb_ld(&bar[XB_TMO])) break; if (sp > XB_SPIN_CAP) { atomicAdd(&bar[XB_TMO], 1u); break; } }
    }
    nloc = mine > 0u ? mine : 1u; nx = cnt > 0u ? cnt : 1u;
}

__device__ __forceinline__ void xcd_barrier(const XcdBarrier& b) {
    asm volatile("s_waitcnt vmcnt(0)" ::: "memory");
    __syncthreads();
    if (threadIdx.x == 0) {
        unsigned* bar = b.bar;
        __builtin_amdgcn_s_waitcnt(0);
        unsigned nloc = b.st[0], nx = b.st[1];
        if (nloc == 0u) { xcd_barrier_complete(bar, b.x, nloc, nx); b.st[0] = nloc; b.st[1] = nx; }
        const unsigned old = xb_add(&bar[XB_XSUB(b.x)], 1u);
        const unsigned gen = old / nloc;
        if (old + 1u == (gen + 1u) * nloc) {
            __builtin_amdgcn_fence(__ATOMIC_RELEASE, "agent");
            asm volatile("s_waitcnt vmcnt(0)" ::: "memory");
            const unsigned og = xb_add(&bar[XB_TOP], 1u);
            const unsigned tg = og / nx;
            if (og + 1u == (tg + 1u) * nx) xb_add(&bar[XB_TOPGEN], 1u);
            else XB_SPIN(xb_ld(&bar[XB_TOPGEN]) == tg, bar);
            __builtin_amdgcn_fence(__ATOMIC_ACQUIRE, "agent");
            xb_add(&bar[XB_XGEN(b.x)], 1u);
            asm volatile("s_waitcnt vmcnt(0)" ::: "memory");
        } else {
            XB_SPIN(xb_ld(&bar[XB_XGEN(b.x)]) == gen, bar);
            __builtin_amdgcn_fence(__ATOMIC_ACQUIRE, "agent");
            asm volatile("s_waitcnt vmcnt(0)" ::: "memory");
        }
    }
    __syncthreads();
}

constexpr size_t WS_BAR = 1 * MiB;
constexpr size_t WS_SDONE = WS_BAR + 16384;
constexpr int LDS_BARST = 147456 - 16;

struct Args { const float* in[24]; float* out; unsigned char* ws; int cg_sync; int pad; };

struct Frame {
    LAS unsigned char* lds;
    int wave, vcu, G;
    const float* x; const float* c; const float* w_ada; const float* b_ada; const float* norm_g; const float* w_in; const float* qg; const float* kg;
    const float *lq1, *lk1, *lq2, *lk2; const float* hg;
    const float *a_re, *a_im, *log_dt, *b_re, *b_im, *c_re, *c_im, *dsk; const float* w_glu; const float* b_glu; const float* w_out;
    float* out;
    float* MOD; float* MODP; float* HGS; f32x2v* A16; f32x2v* A128; float* ROPE;
    bf16 *WIN, *WGLU, *WOUT, *TT, *WS, *WOT, *Q, *K, *V, *GA, *GS, *MIX, *XN, *GY, *UC;
};

__device__ __forceinline__ void p0_transpose_item(const float* W, int K, int N, bf16* WT, int k0, int src_n0, int dst_n0, LAS float* scr, int lane) {
#pragma unroll 8
    for (int i = 0; i < 32; ++i) { const int kk = 2 * i + (lane >> 5); scr[kk * 33 + (lane & 31)] = W[(size_t)(k0 + kk) * N + src_n0 + (lane & 31)]; }
    LDS_WAIT(); asm volatile("" ::: "memory");
    const int c = lane & 7;
#pragma unroll
    for (int j = 0; j < 4; ++j) { const int n = (lane >> 3) + 8 * j; const LAS float* s = scr + (8 * c) * 33 + n;
        v4u o; o.x = pk2(s[0 * 33], s[1 * 33]); o.y = pk2(s[2 * 33], s[3 * 33]); o.z = pk2(s[4 * 33], s[5 * 33]); o.w = pk2(s[6 * 33], s[7 * 33]);
        *(v4u*)(WT + (size_t)(dst_n0 + n) * K + k0 + 8 * c) = o; }
    LDS_WAIT(); asm volatile("" ::: "memory");
}
__device__ __forceinline__ int win_src_col(int n) {
    const int tt = n >> 10, w = n & 1023;
    if (tt >= 2) return n;
    const int p4 = w >> 8, bj = (w >> 7) & 1, wc = (w >> 5) & 3, j = w & 31;
    return tt * 1024 + (p4 * 4 + wc) * 64 + bj * 32 + j;
}
__device__ __forceinline__ void cpow_lambda(double ar, double ai, double dt, double j, float& re, float& im) {
    const double mag = exp(ar * dt * j);
    double rev = ai * dt * j * 0.15915494309189535; rev -= rint(rev);
    const float ang = (float)(rev * 6.283185307179586);
    re = (float)mag * cosf(ang); im = (float)mag * sinf(ang);
}

__device__ __forceinline__ void p0_ssm_tables(Frame& F, int g, int pt) {
    LAS float* Apr = (LAS float*)(F.lds);
    LAS float* Api = Apr + 17 * 64;
    LAS float* Bbr = Api + 17 * 64;
    LAS float* Bbi = Bbr + 1024;
    LAS float* Cr = Bbi + 1024;
    LAS float* Ci = Cr + 1024;
    LAS float* Kj = Ci + 1024;
    LAS float* Fr = Kj + 4096;
    LAS float* Fi = Fr + 64;
    const int tid = (F.wave * 64 + lane_id());
    const double dt = exp((double)F.log_dt[g]);
    for (int idx = tid; idx < 17 * 64; idx += 512) { const int p = idx & 63, j = idx >> 6; float re, im;
        cpow_lambda((double)F.a_re[g * 64 + p], (double)F.a_im[g * 64 + p], dt, (double)j, re, im); Apr[idx] = re; Api[idx] = im; }
    if (tid < 64) { const int p = tid; const double ar = (double)F.a_re[g * 64 + p], ai = (double)F.a_im[g * 64 + p];
        const double mag = exp(ar * dt); double rev = ai * dt * 0.15915494309189535; rev -= rint(rev); const double ang = rev * 6.283185307179586;
        const double abr = mag * (double)cosf((float)ang), abi = mag * (double)sinf((float)ang);
        const double nr = abr - 1.0, ni = abi, den = ar * ar + ai * ai;
        Fr[p] = (float)((nr * ar + ni * ai) / den); Fi[p] = (float)((ni * ar - nr * ai) / den);
        float re, im; cpow_lambda(ar, ai, dt, 16.0, re, im); F.A16[g * 64 + p] = (f32x2v){re, im};
        cpow_lambda(ar, ai, dt, 128.0, re, im); F.A128[g * 64 + p] = (f32x2v){re, im}; }
    for (int idx = tid; idx < 1024; idx += 512) { Cr[idx] = F.c_re[g * 1024 + idx]; Ci[idx] = F.c_im[g * 1024 + idx]; }
    __syncthreads();
    for (int idx = tid; idx < 1024; idx += 512) { const int p = idx >> 4; const float br = F.b_re[g * 1024 + idx], bi = F.b_im[g * 1024 + idx];
        Bbr[idx] = Fr[p] * br - Fi[p] * bi; Bbi[idx] = Fr[p] * bi + Fi[p] * br; }
    __syncthreads();
    for (int idx0 = tid; idx0 < 1024; idx0 += 512) { const int j = idx0 >> 6, ho = 4 * pt + ((idx0 >> 4) & 3), hi = idx0 & 15, idx = (j * 16 + ho) * 16 + hi; float s = 0.f;
        for (int p = 0; p < 64; ++p) { const float cr = Cr[ho * 64 + p], ci = Ci[ho * 64 + p], ar = Apr[j * 64 + p], ai = Api[j * 64 + p];
            const float car = cr * ar - ci * ai, cai = cr * ai + ci * ar; s += car * Bbr[p * 16 + hi] - cai * Bbi[p * 16 + hi]; }
        Kj[idx] = s; }
    __syncthreads();
    bf16* TTg = F.TT + (size_t)g * 65536; bf16* WSg = F.WS + (size_t)g * 32768; bf16* WOg = F.WOT + (size_t)g * 32768;
    for (int idx = tid; idx < 64 * 32; idx += 512) { const int ri = idx >> 5, t = ri >> 2, ho = 4 * pt + (ri & 3), n = t * 16 + ho, k0 = (idx & 31) * 8, s = k0 >> 4, hi0 = k0 & 15;
        const float dv = F.dsk[g * 16 + ho]; float v[8];
#pragma unroll
        for (int e = 0; e < 8; ++e) { const int hi = hi0 + e; float xv = (s <= t) ? Kj[((t - s) * 16 + ho) * 16 + hi] : 0.f; if (s == t && hi == ho) xv += dv; v[e] = xv; }
        v4u o; o.x = pk2(v[0], v[1]); o.y = pk2(v[2], v[3]); o.z = pk2(v[4], v[5]); o.w = pk2(v[6], v[7]);
        *(v4u*)(TTg + ((((n >> 5) * 16 + (k0 >> 4)) * 64) + ((k0 >> 3) & 1) * 32 + (n & 31)) * 8) = o; }
    for (int idx = tid; idx < 32 * 32; idx += 512) { const int n = 32 * pt + (idx >> 5), p = n >> 1, c = n & 1, k0 = (idx & 31) * 8, s = k0 >> 4, hi0 = k0 & 15, j = 15 - s;
        const float ar = Apr[j * 64 + p], ai = Api[j * 64 + p]; float v[8];
#pragma unroll
        for (int e = 0; e < 8; ++e) { const float br = Bbr[p * 16 + hi0 + e], bi = Bbi[p * 16 + hi0 + e]; v[e] = (c == 0) ? (ar * br - ai * bi) : (ar * bi + ai * br); }
        v4u o; o.x = pk2(v[0], v[1]); o.y = pk2(v[2], v[3]); o.z = pk2(v[4], v[5]); o.w = pk2(v[6], v[7]);
        *(v4u*)(WSg + ((((n >> 5) * 16 + (k0 >> 4)) * 64) + ((k0 >> 3) & 1) * 32 + (n & 31)) * 8) = o; }
    for (int idx = tid; idx < 64 * 16; idx += 512) { const int ri = idx >> 4, t = ri >> 2, ho = 4 * pt + (ri & 3), n = t * 16 + ho, k0 = (idx & 15) * 8, p0 = k0 >> 1, j = t + 1; float v[8];
#pragma unroll
        for (int q = 0; q < 4; ++q) { const int p = p0 + q; const float cr = Cr[ho * 64 + p], ci = Ci[ho * 64 + p], ar = Apr[j * 64 + p], ai = Api[j * 64 + p];
            v[2 * q] = cr * ar - ci * ai; v[2 * q + 1] = -(cr * ai + ci * ar); }
        v4u o; o.x = pk2(v[0], v[1]); o.y = pk2(v[2], v[3]); o.z = pk2(v[4], v[5]); o.w = pk2(v[6], v[7]);
        *(v4u*)(WOg + ((((n >> 5) * 8 + (k0 >> 4)) * 64) + ((k0 >> 3) & 1) * 32 + (n & 31)) * 8) = o; }
    __syncthreads();
}

__device__ __forceinline__ void p0_gemv(Frame& F) {
    const int gw = F.vcu * NWAVES + F.wave, NGW = F.G * NWAVES;
    for (int it = gw; it < 8 * 48; it += NGW) {
        const int kc = it / 48, cc = it % 48, kq = lane_id() >> 4, col = cc * 64 + (lane_id() & 15) * 4;
        f32x4 a0 = {0.f, 0.f, 0.f, 0.f}, a1 = a0, a2 = a0, a3 = a0;
#pragma unroll 8
        for (int kk = 0; kk < 32; ++kk) { const int k = kc * 128 + kq * 32 + kk; const f32x4 w = *(const f32x4*)(F.w_ada + (size_t)k * 3072 + col);
            a0 += w * pg8::silu_f(F.c[k]); a1 += w * pg8::silu_f(F.c[1024 + k]); a2 += w * pg8::silu_f(F.c[2048 + k]); a3 += w * pg8::silu_f(F.c[3072 + k]); }
#pragma unroll
        for (int e = 0; e < 4; ++e) { a0[e] += __shfl_xor(a0[e], 16); a0[e] += __shfl_xor(a0[e], 32); a1[e] += __shfl_xor(a1[e], 16); a1[e] += __shfl_xor(a1[e], 32);
            a2[e] += __shfl_xor(a2[e], 16); a2[e] += __shfl_xor(a2[e], 32); a3[e] += __shfl_xor(a3[e], 16); a3[e] += __shfl_xor(a3[e], 32); }
        if (kq == 0) { float* pp = F.MODP + (size_t)kc * 12288 + col; *(f32x4*)(pp) = a0; *(f32x4*)(pp + 3072) = a1; *(f32x4*)(pp + 6144) = a2; *(f32x4*)(pp + 9216) = a3; }
    }
}
__device__ __forceinline__ void p0_rest(Frame& F) {
    for (int u = F.vcu; u < 4 * NGRP; u += F.G) p0_ssm_tables(F, u >> 2, u & 3);
    __syncthreads();
    LAS float* scr = (LAS float*)(F.lds + RING_OFF + F.wave * 16384);
    const int gw = F.vcu * NWAVES + F.wave, NGW = F.G * NWAVES;
    if (F.vcu == 0 && F.wave == 0) { const int l_ = lane_id(); F.HGS[l_] = F.hg[l_] * (1.0f - LAM_INIT); F.HGS[64 + l_] = F.hg[64 + l_] * (1.0f - LAM_INIT); }
    for (int idx = (F.vcu * NWAVES + F.wave) * 64 + lane_id(); idx < 8192 * 32; idx += F.G * 512) {
        const int pos = idx >> 5, i = idx & 31;
        const float inv = 1.0f / powf(10000.0f, (float)(2 * i) / 64.0f);
        const float angf = (float)pos * inv;
        double rev = (double)angf * 0.15915494309189535; rev -= rint(rev);
        const float a = (float)(rev * 6.283185307179586);
        F.ROPE[idx] = cosf(a); F.ROPE[8192 * 32 + idx] = sinf(a);
    }
    constexpr int I_IN = 16 * 192, I_GLU = 16 * 32, I_OUT = 32 * 32;
    for (int it = gw; it < I_IN + I_GLU + I_OUT; it += NGW) {
        int r = it;
        if (r < I_IN) { const int kb = r / 192, nb = r % 192; p0_transpose_item(F.w_in, 1024, NPROJ, F.WIN, 64 * kb, win_src_col(32 * nb), 32 * nb, scr, lane_id()); continue; } r -= I_IN;
        if (r < I_GLU) { const int kb = r / 32, nb = r % 32; p0_transpose_item(F.w_glu, 1024, 1024, F.WGLU, 64 * kb, 32 * nb, 32 * nb, scr, lane_id()); continue; } r -= I_GLU;
        { const int kb = r / 32, nb = r % 32; p0_transpose_item(F.w_out, 2048, 1024, F.WOUT, 64 * kb, 32 * nb, 32 * nb, scr, lane_id()); }
    }
}

__device__ __forceinline__ void p0b_rows(Frame& F) {
    LAS float* modl = (LAS float*)(F.lds);
    for (int q = (F.wave * 64 + lane_id()); q < 3072; q += 512) { const int b = q / 768, c4 = (q % 768) * 4;
        f32x4 v = *(const f32x4*)(F.b_ada + c4);
#pragma unroll
        for (int kc = 0; kc < 8; ++kc) v += *(const f32x4*)(F.MODP + (size_t)kc * 12288 + b * 3072 + c4);
        *(LAS f32x4*)(modl + b * 3072 + c4) = v;
        if (F.vcu == 0) *(f32x4*)(F.MOD + b * 3072 + c4) = v; }
    __syncthreads();
    const int gw = F.vcu * NWAVES + F.wave, NGW = F.G * NWAVES;
    for (int blk = gw; blk < M / 16; blk += NGW) {
        const int m0 = blk * 16, b = m0 >> 13;
        f32x4 g[4], sh[4], sc[4];
#pragma unroll
        for (int j = 0; j < 4; ++j) { const int col = 4 * lane_id() + 256 * j; g[j] = *(const f32x4*)(F.norm_g + col);
            sh[j] = *(const LAS f32x4*)(modl + b * 3072 + col); sc[j] = *(const LAS f32x4*)(modl + b * 3072 + 1024 + col) + 1.0f; g[j] = g[j] * sc[j]; }
        f32x4 v[4], nx[4];
        { const f32x4* xr = (const f32x4*)(F.x + (size_t)m0 * DM) + lane_id();
#pragma unroll
          for (int j = 0; j < 4; ++j) nx[j] = xr[64 * j]; }
        for (int i = 0; i < 16; ++i) {
            const int m = m0 + i; float s = 0.f;
#pragma unroll
            for (int j = 0; j < 4; ++j) { v[j] = nx[j]; s += (v[j].x * v[j].x + v[j].y * v[j].y) + (v[j].z * v[j].z + v[j].w * v[j].w); }
            if (i + 1 < 16) { const f32x4* xr = (const f32x4*)(F.x + (size_t)(m + 1) * DM) + lane_id();
#pragma unroll
                for (int j = 0; j < 4; ++j) nx[j] = xr[64 * j]; }
            const float rstd = __builtin_amdgcn_rsqf(wave_sum(s) * (1.0f / DM) + NORM_EPS);
            unsigned long long* o8 = (unsigned long long*)(F.XN + (size_t)m * DM) + lane_id();
#pragma unroll
            for (int j = 0; j < 4; ++j) { const f32x4 h = v[j] * rstd * g[j] + sh[j];
                o8[64 * j] = (unsigned long long)pk2(h.x, h.y) | ((unsigned long long)pk2(h.z, h.w) << 32); }
        }
    }
    __syncthreads();
}

__device__ __forceinline__ int crow16(int r, int hi) { return (r & 3) + 8 * (r >> 2) + 4 * hi; }
constexpr int SSM_UB = 0, SSM_UBB = 33792, SSM_HL = 67584, SSM_HP = 100352, SSM_EX = 117760;
static_assert(SSM_EX + 4096 <= RING_BYTES, "SSM LDS map");
__device__ __forceinline__ void ssm_unit(Frame& F, int b, int g) {
    LAS float* HL = (LAS float*)(F.lds + SSM_HL);
    LAS bf16* YT = (LAS bf16*)(F.lds + SSM_HL);
    LAS bf16* HP = (LAS bf16*)(F.lds + SSM_HP);
    LAS float* EX = (LAS float*)(F.lds + SSM_EX);
    const bf16* Uc = F.UC + (size_t)(b * 64 + g) * 8192 * 16;
    const bf16* TTg = F.TT + (size_t)g * 65536; const bf16* WSg = F.WS + (size_t)g * 32768; const bf16* WOg = F.WOT + (size_t)g * 32768;
    bf16* GYb = F.GY + (size_t)b * SEQ * DM + g * 16;
    const int tid = (F.wave * 64 + lane_id()), lane = lane_id(), w = F.wave, r = lane & 31, h = lane >> 5;
    const f32x2v a16 = F.A16[g * 64 + lane], a128 = F.A128[g * 64 + lane];
    float car = 0.f, cai = 0.f;
    bf16x8 wsf[16];
    { const bf16* wf0 = WSg + (size_t)((w & 3) * 16) * 512 + lane * 8;
#pragma unroll
      for (int j = 0; j < 16; ++j) wsf[j] = *(const bf16x8*)(wf0 + j * 512); }
    v4u pre[4];
#pragma unroll
    for (int i = 0; i < 4; ++i) pre[i] = *(const v4u*)(Uc + (size_t)(tid + i * 512) * 8);
#pragma unroll
    for (int i = 0; i < 4; ++i) { const int q = tid + i * 512; *(LAS v4u*)(F.lds + SSM_UB + (q >> 5) * 528 + (q & 31) * 16) = pre[i]; }
    for (int seg = 0; seg < 8; ++seg) {
        LAS unsigned char* UB = F.lds + SSM_UB + (seg & 1) * SSM_UBB;
        if (seg + 1 < 8) {
#pragma unroll
            for (int i = 0; i < 4; ++i) pre[i] = *(const v4u*)(Uc + (size_t)(seg + 1) * 16384 + (size_t)(tid + i * 512) * 8);
        }
        __syncthreads();
        {
            const int mb = w >> 2, nb = w & 3;
            f32x16 acc0 = {}, acc1 = {};
            const bf16* wf = WSg + (size_t)(nb * 16) * 512 + lane * 8;
            const LAS unsigned char* ua = UB + (mb * 32 + r) * 528 + h * 16;
#pragma unroll
            for (int j = 0; j < 16; j += 2) {
                const bf16x8 a0 = *(const LAS bf16x8*)(ua + j * 32), a1 = *(const LAS bf16x8*)(ua + j * 32 + 32);
                acc0 = __builtin_amdgcn_mfma_f32_32x32x16_bf16(a0, wsf[j], acc0, 0, 0, 0);
                acc1 = __builtin_amdgcn_mfma_f32_32x32x16_bf16(a1, wsf[j + 1], acc1, 0, 0, 0);
            }
#pragma unroll
            for (int i = 0; i < 16; ++i) HL[(mb * 32 + crow16(i, h)) * 128 + nb * 32 + r] = acc0[i] + acc1[i];
        }
        __syncthreads();
        {
            const int c0 = w * 8; float er = 0.f, ei = 0.f;
#pragma unroll
            for (int i = 0; i < 8; ++i) { const f32x2v hl = *(const LAS f32x2v*)(HL + (c0 + i) * 128 + 2 * lane);
                const float nr = a16.x * er - a16.y * ei + hl.x, ni = a16.x * ei + a16.y * er + hl.y; er = nr; ei = ni; }
            *(LAS f32x2v*)(EX + (w * 64 + lane) * 2) = (f32x2v){er, ei};
            __syncthreads();
            float hr = car, hi_ = cai, ir = 0.f, ii = 0.f;
#pragma unroll
            for (int v = 0; v < 8; ++v) { if (v == w) { ir = hr; ii = hi_; }
                const f32x2v e = *(const LAS f32x2v*)(EX + (v * 64 + lane) * 2);
                const float nr = a128.x * hr - a128.y * hi_ + e.x, ni = a128.x * hi_ + a128.y * hr + e.y; hr = nr; hi_ = ni; }
            car = hr; cai = hi_;
            hr = ir; hi_ = ii;
#pragma unroll
            for (int i = 0; i < 8; ++i) { *(LAS unsigned*)(HP + (c0 + i) * 136 + 2 * lane) = pg8::cvt_pk_bf16(hr, hi_);
                const f32x2v hl = *(const LAS f32x2v*)(HL + (c0 + i) * 128 + 2 * lane);
                const float nr = a16.x * hr - a16.y * hi_ + hl.x, ni = a16.x * hi_ + a16.y * hr + hl.y; hr = nr; hi_ = ni; }
        }
        if (seg + 1 < 8) {
#pragma unroll
            for (int i = 0; i < 4; ++i) { const int q = tid + i * 512; *(LAS v4u*)(F.lds + SSM_UB + ((seg + 1) & 1) * SSM_UBB + (q >> 5) * 528 + (q & 31) * 16) = pre[i]; }
        }
        __syncthreads();
        {
            const bf16* tf = TTg + (size_t)(w * 16) * 512 + lane * 8; const bf16* of = WOg + (size_t)(w * 8) * 512 + lane * 8;
            const LAS unsigned char* ua = UB + r * 528 + h * 16;
            const LAS bf16* hp = HP + r * 136 + 8 * h;
            f32x16 acc0 = {}, acc1 = {};
#pragma unroll
            for (int kb = 0; kb < 16; kb += 8) {
                bf16x8 bq[8];
#pragma unroll
                for (int j = 0; j < 8; ++j) bq[j] = *(const bf16x8*)(tf + (kb + j) * 512);
                asm volatile("" ::: "memory");
#pragma unroll
                for (int j = 0; j < 8; ++j) {
                    const bf16x8 a0 = *(const LAS bf16x8*)(ua + (kb + j) * 32), a1 = *(const LAS bf16x8*)(ua + 32 * 528 + (kb + j) * 32);
                    acc0 = __builtin_amdgcn_mfma_f32_32x32x16_bf16(a0, bq[j], acc0, 0, 0, 0);
                    acc1 = __builtin_amdgcn_mfma_f32_32x32x16_bf16(a1, bq[j], acc1, 0, 0, 0); }
            }
            {
                bf16x8 bq[8];
#pragma unroll
                for (int j = 0; j < 8; ++j) bq[j] = *(const bf16x8*)(of + j * 512);
                asm volatile("" ::: "memory");
#pragma unroll
                for (int j = 0; j < 8; ++j) {
                    const bf16x8 a0 = *(const LAS bf16x8*)(hp + j * 16), a1 = *(const LAS bf16x8*)(hp + 32 * 136 + j * 16);
                    acc0 = __builtin_amdgcn_mfma_f32_32x32x16_bf16(a0, bq[j], acc0, 0, 0, 0);
                    acc1 = __builtin_amdgcn_mfma_f32_32x32x16_bf16(a1, bq[j], acc1, 0, 0, 0); }
            }
#pragma unroll
            for (int i = 0; i < 16; ++i) { const int cl = crow16(i, h);
                const unsigned pk = pg8::cvt_pk_bf16(pg8::gelu_tanh_f(acc0[i]), pg8::gelu_tanh_f(acc1[i]));
                YT[cl * 256 + 32 * w + r] = (bf16)(pk & 0xffffu); YT[(32 + cl) * 256 + 32 * w + r] = (bf16)(pk >> 16); }
        }
        __syncthreads();
#pragma unroll
        for (int i = 0; i < 4; ++i) { const int q = tid + i * 512; const v4u v = *(const LAS v4u*)(F.lds + SSM_HL + q * 16);
            *(v4u*)(GYb + (size_t)(seg * 1024 + (q >> 1)) * DM + (q & 1) * 8) = v; }
    }
    __syncthreads();
}

__global__ void __launch_bounds__(NWAVES * 64, 2) hybrid_fwd(Args args) {
    extern __shared__ __attribute__((aligned(16))) unsigned char lds[];
    cg::grid_group grid = cg::this_grid();
    Frame F;
    F.lds = (LAS unsigned char*)lds;
    F.wave = __builtin_amdgcn_readfirstlane((int)threadIdx.x >> 6);
    F.G = gridDim.x; { const int bx = blockIdx.x; F.vcu = (F.G % 8 == 0) ? (bx % 8) * (F.G / 8) + bx / 8 : bx; }
    unsigned char* ws = args.ws;
    F.x = args.in[0]; F.c = args.in[1]; F.w_ada = args.in[2]; F.b_ada = args.in[3]; F.norm_g = args.in[4]; F.w_in = args.in[5]; F.qg = args.in[6]; F.kg = args.in[7];
    F.lq1 = args.in[8]; F.lk1 = args.in[9]; F.lq2 = args.in[10]; F.lk2 = args.in[11]; F.hg = args.in[12];
    F.a_re = args.in[13]; F.a_im = args.in[14]; F.log_dt = args.in[15]; F.b_re = args.in[16]; F.b_im = args.in[17]; F.c_re = args.in[18]; F.c_im = args.in[19]; F.dsk = args.in[20];
    F.w_glu = args.in[21]; F.b_glu = args.in[22]; F.w_out = args.in[23]; F.out = args.out;
    F.MOD = (float*)(ws + WS_MOD); F.A16 = (f32x2v*)(ws + WS_A16); F.A128 = (f32x2v*)(ws + WS_A128); F.MODP = (float*)(ws + WS_MODP); F.HGS = (float*)(ws + WS_HGS); F.ROPE = (float*)(ws + WS_ROPE);
    F.WIN = (bf16*)(ws + WS_WIN); F.WGLU = (bf16*)(ws + WS_WGLU); F.WOUT = (bf16*)(ws + WS_WOUT); F.TT = (bf16*)(ws + WS_TT); F.WS = (bf16*)(ws + WS_WS); F.WOT = (bf16*)(ws + WS_WOT);
    F.Q = (bf16*)(ws + WS_Q); F.K = (bf16*)(ws + WS_K); F.V = (bf16*)(ws + WS_V); F.GA = (bf16*)(ws + WS_GA); F.GS = (bf16*)(ws + WS_GS); F.MIX = (bf16*)(ws + WS_MIX);
    F.XN = (bf16*)args.out; F.GY = (bf16*)args.out; F.UC = (bf16*)((unsigned char*)args.out + 64 * MiB);

    unsigned* barw = (unsigned*)(ws + WS_BAR);
    if (threadIdx.x < 2) ((volatile LAS unsigned*)(F.lds + LDS_BARST))[threadIdx.x] = 0u;
    __syncthreads();
    const XcdBarrier bar = xcd_barrier_post(barw, (volatile LAS unsigned*)(F.lds + LDS_BARST));
    p0_gemv(F);
    if (args.cg_sync) grid.sync();
    xcd_barrier(bar);
    p0b_rows(F);
    p0_rest(F);
    xcd_barrier(bar);
    {
        pg8::Gemm g{F.XN, F.WIN, M, NPROJ, DM}; pg8::StaticOrder S; S.init(M, NPROJ, F.G, (int)blockIdx.x);
        pg8::EpiProj E{F.Q, F.K, F.V, F.GA, F.GS, F.UC, F.ROPE, F.ROPE + 8192 * 32, F.qg, F.kg};
        pg8::gemm_phase<pg8::EpiProj, pg8::StaticOrder, true, true>(F.lds + RING_OFF, g, S, E, F.wave);
    }
    xcd_barrier(bar);
    unsigned* sdone = (unsigned*)(ws + WS_SDONE);
    for (int u = F.vcu; u < BATCH * NGRP; u += F.G) {
        ssm_unit(F, u & 3, u >> 2);
        asm volatile("s_waitcnt vmcnt(0)" ::: "memory");
        __syncthreads();
        if (threadIdx.x == 0) { __builtin_amdgcn_fence(__ATOMIC_RELEASE, "agent"); asm volatile("s_waitcnt vmcnt(0)" ::: "memory"); (void)xb_add(sdone, 1u); }
    }
    {
        const int ln_ = lane_id();
        const float s1_ = wave_sum(F.lq1[ln_] * F.lk1[ln_]), s2_ = wave_sum(F.lq2[ln_] * F.lk2[ln_]);
        const float lam_ = __expf(s1_) - __expf(s2_) + LAM_INIT;
        const attn_body::AttnTensors AT{(const attn_body::bf16*)F.Q, (const attn_body::bf16*)F.K, (const attn_body::bf16*)F.V, (attn_body::bf16*)F.MIX, (const attn_body::bf16*)F.GA, F.HGS, lam_};
        const attn_body::AttnOrder S((int)F.G, F.vcu);
        attn_body::attn_phase<attn_body::AttnOrder>((char*)lds + RING_OFF, AT, S, F.wave);
    }
    if (threadIdx.x == 0) {
        unsigned sp_ = 0u;
        while (xb_ld(sdone) < (unsigned)(BATCH * NGRP)) { __builtin_amdgcn_s_sleep(2); if (++sp_ > (1u << 22)) break; }
        __builtin_amdgcn_fence(__ATOMIC_ACQUIRE, "agent");
        asm volatile("s_waitcnt vmcnt(0)" ::: "memory");
    }
    __syncthreads();
    {
        pg8::Gemm g{F.GY, F.WGLU, M, DM, DM}; pg8::StaticOrder S; S.init(M, DM, F.G, (int)blockIdx.x);
        pg8::EpiGlu E{F.GY, F.GS, F.b_glu, F.MIX};
        pg8::gemm_phase<pg8::EpiGlu, pg8::StaticOrder, true, true>(F.lds + RING_OFF, g, S, E, F.wave);
    }
    xcd_barrier(bar);
    {
        pg8::Gemm g{F.MIX, F.WOUT, M, DM, MIXW}; pg8::StaticOrder S; S.init(M, DM, F.G, (int)blockIdx.x);
        pg8::EpiOut E{F.x, F.MOD, F.out};
        pg8::gemm_phase<pg8::EpiOut, pg8::StaticOrder, true, true>(F.lds + RING_OFF, g, S, E, F.wave);
    }
}

extern "C" void kernel_launch(void* const* d_in, const int* in_sizes, int n_in, void* d_out, int out_size, void* d_ws, size_t ws_size, hipStream_t stream) {
    static int grid = 0;
    if (grid == 0) {
        if (n_in != 24 || out_size != M * DM || ws_size < WS_END) { fprintf(stderr, "kernel_launch: unexpected shapes (n_in %d out %d ws %zu); nothing launched\n", n_in, out_size, ws_size); grid = -1; return; }
        int dev = 0, cus = 0, per_cu = 0;
        if (hipGetDevice(&dev) != hipSuccess || hipDeviceGetAttribute(&cus, hipDeviceAttributeMultiprocessorCount, dev) != hipSuccess) { grid = -1; return; }
        if (hipFuncSetAttribute((const void*)hybrid_fwd, hipFuncAttributeMaxDynamicSharedMemorySize, LDS_BYTES) != hipSuccess) { fprintf(stderr, "kernel_launch: hipFuncSetAttribute failed\n"); grid = -1; return; }
        if (hipOccupancyMaxActiveBlocksPerMultiprocessor(&per_cu, (const void*)hybrid_fwd, NWAVES * 64, LDS_BYTES) != hipSuccess || per_cu < 1) { fprintf(stderr, "kernel_launch: occupancy query says %d blocks per CU\n", per_cu); per_cu = 1; }
        (void)hipGetLastError();
        grid = cus * 1;
        fprintf(stderr, "kernel_launch: grid %d (per_cu query %d), ws %zu\n", grid, per_cu, ws_size);
    }
    if (grid < 0) return;
    if (hipMemsetAsync((char*)d_ws + WS_BAR, 0, 16384 + 256, stream) != hipSuccess) { fprintf(stderr, "kernel_launch: hipMemsetAsync of the barrier words failed; nothing launched\n"); return; }
    Args a{};
    for (int i = 0; i < 24; ++i) a.in[i] = (const float*)d_in[i];
    a.out = (float*)d_out; a.ws = (unsigned char*)d_ws;
    void* kargs[] = {&a};
    const hipError_t e = hipLaunchCooperativeKernel((const void*)hybrid_fwd, dim3(grid), dim3(NWAVES * 64), kargs, LDS_BYTES, stream);
    if (e != hipSuccess) fprintf(stderr, "kernel_launch: cooperative launch failed: %s (grid %d)\n", hipGetErrorString(e), grid);
}
```

```cpp
#include <hip/hip_runtime.h>
#include <hip/hip_cooperative_groups.h>
#include <cstdio>
#include <cstdint>
namespace cg = cooperative_groups;
__device__ __forceinline__ int lane_id() { int t = (int)threadIdx.x; asm volatile("" : "+v"(t)); return t & 63; }
namespace pg8 {
#define PG8_LAS __attribute__((address_space(3)))
typedef unsigned short bf16_t;
typedef short bf16x8 __attribute__((ext_vector_type(8)));
typedef float f32x4 __attribute__((ext_vector_type(4)));
typedef unsigned u32x4 __attribute__((ext_vector_type(4)));
constexpr int BM = 256, BK = 64, HALF = 128, HTB = HALF * BK * 2  , STAGE_BYTES = 8 * HTB, NXCD = 8, WGM = 8;

__host__ __device__ __forceinline__ int lds_byte(int r, int c) { const int st = (r >> 4) * 2 + (c >> 5), rr = r & 15, cc = c & 31, ob = rr * 64 + cc * 2; return st * 1024 + (ob ^ (((ob >> 9) & 1) << 5)); }
__host__ __device__ __forceinline__ void stage_rc(int b, int& R, int& C) { const int st = b / 1024, sb = b % 1024, swz = sb ^ (((sb >> 9) & 1) << 5); R = (st >> 1) * 16 + swz / 64; C = (st & 1) * 32 + (swz % 64) / 2; }
__host__ __device__ __forceinline__ int perm32(int rho) { const int n = rho >> 4, i = rho & 15; return 8 * (i >> 2) + 4 * n + (i & 3); }

struct Unit { int pm, pn; };
struct Gemm { const bf16_t* A; const bf16_t* Bt; int M, N, K; };

struct StaticOrder {
    int nM, nN, nwg, G, c;
    __host__ __device__ void init(int M, int N, int G_, int c_) { nM = M / BM; nN = N / BM; nwg = nM * nN; G = G_; c = c_; }
    __host__ __device__ bool next(int i, Unit& u) const {
        const long L = (long)i * G + c; if (L >= nwg) return false;
        int wgid = (int)L; { const int q = nwg / NXCD, r = nwg % NXCD, xcd = wgid % NXCD, off = wgid / NXCD; wgid = (xcd < r ? xcd * (q + 1) : r * (q + 1) + (xcd - r) * q) + off; }
        const int nig = WGM * nN, gid = wgid / nig, fm = gid * WGM, gsz = (nM - fm) < WGM ? (nM - fm) : WGM;
        u.pm = fm + ((wgid % nig) % gsz); u.pn = (wgid % nig) / gsz; return true;
    }
    __device__ __forceinline__ void a_ready(const Unit&) const {}
    __device__ __forceinline__ void done(const Unit&) const {}
};

__device__ __forceinline__ unsigned cvt_pk_bf16(float lo, float hi) { unsigned r; asm volatile("v_cvt_pk_bf16_f32 %0, %1, %2" : "=v"(r) : "v"(lo), "v"(hi)); return r; }
typedef float f32x2 __attribute__((ext_vector_type(2)));
__device__ __forceinline__ float sigmoid_f(float x) { return __builtin_amdgcn_rcpf(1.0f + __expf(-x)); }
__device__ __forceinline__ float silu_f(float x) { return x * sigmoid_f(x); }
__device__ __forceinline__ float gelu_tanh_f(float y) { const float t = y * y; const float p = __builtin_fmaf(t, -0.10294324f, -2.3022082f);
    return y * __builtin_amdgcn_rcpf(1.0f + __builtin_amdgcn_exp2f(y * p)); }
__device__ __forceinline__ float bf_lo(unsigned w) { return __builtin_bit_cast(float, w << 16); }
__device__ __forceinline__ float bf_hi(unsigned w) { return __builtin_bit_cast(float, w & 0xffff0000u); }
constexpr float QSCALE = 0.125f * 1.4426950408889634f;

struct EpiProj {
    static constexpr bool PERM = true, AFTER_DRAIN = false;
    bf16_t *Q, *K, *V, *GA, *GS, *UC; const float* rope_cos; const float* rope_sin; const float* qg; const float* kg;
    __device__ __forceinline__ void operator()(const f32x4 (&acc)[2][2][4][2], const Unit& u, int wr, int wc, int fr, int fq) const {
        const int tt = u.pn >> 2, p4 = u.pn & 3;
        const int row0 = u.pm * BM + wr * 64 + fr;
        if (tt < 2) {
            const float* gw = (tt == 0) ? qg : kg; bf16_t* dst = (tt == 0) ? Q : K; const float sc = (tt == 0) ? QSCALE : 1.0f;
            f32x4 gv[2][2];
#pragma unroll
            for (int bj = 0; bj < 2; ++bj)
#pragma unroll
                for (int n = 0; n < 2; ++n) gv[bj][n] = *(const f32x4*)(gw + bj * 32 + 8 * fq + 4 * n) * sc;
            const int hm = p4 * 4 + wc;
#pragma unroll
            for (int ai = 0; ai < 2; ++ai)
#pragma unroll
                for (int m = 0; m < 4; ++m) {
                    const int row = row0 + ai * HALF + m * 16; const int s = row & 8191;
                    f32x4 v[2][2]; float ss = 0.f;
#pragma unroll
                    for (int bj = 0; bj < 2; ++bj)
#pragma unroll
                        for (int n = 0; n < 2; ++n) { v[bj][n] = acc[ai][bj][m][n]; const f32x4 q = v[bj][n] * v[bj][n]; ss += (q[0] + q[1]) + (q[2] + q[3]); }
                    ss += __shfl_xor(ss, 16); ss += __shfl_xor(ss, 32);
                    const float rs = __builtin_amdgcn_rsqf(ss * (1.0f / 64.0f) + 1e-6f);
                    u32x4 w0, w1;
                    {
                        const f32x4 c0 = *(const f32x4*)(rope_cos + s * 32 + 8 * fq), c1 = *(const f32x4*)(rope_cos + s * 32 + 8 * fq + 4);
                        const f32x4 s0 = *(const f32x4*)(rope_sin + s * 32 + 8 * fq), s1 = *(const f32x4*)(rope_sin + s * 32 + 8 * fq + 4);
                        const f32x4 a0 = v[0][0] * rs * gv[0][0], a1 = v[0][1] * rs * gv[0][1], b0 = v[1][0] * rs * gv[1][0], b1 = v[1][1] * rs * gv[1][1];
                        const f32x4 o10 = a0 * c0 - b0 * s0, o11 = a1 * c1 - b1 * s1, o20 = b0 * c0 + a0 * s0, o21 = b1 * c1 + a1 * s1;
                        w0.x = cvt_pk_bf16(o10[0], o10[1]); w0.y = cvt_pk_bf16(o10[2], o10[3]); w0.z = cvt_pk_bf16(o11[0], o11[1]); w0.w = cvt_pk_bf16(o11[2], o11[3]);
                        w1.x = cvt_pk_bf16(o20[0], o20[1]); w1.y = cvt_pk_bf16(o20[2], o20[3]); w1.z = cvt_pk_bf16(o21[0], o21[1]); w1.w = cvt_pk_bf16(o21[2], o21[3]);
                    }
                    bf16_t* rp = dst + (size_t)row * 1024 + hm * 64 + 8 * fq;
                    *(u32x4*)(rp) = w0; *(u32x4*)(rp + 32) = w1;
                }
        } else {
#pragma unroll
            for (int ai = 0; ai < 2; ++ai)
#pragma unroll
                for (int m = 0; m < 4; ++m) {
                    const int row = row0 + ai * HALF + m * 16;
#pragma unroll
                    for (int bj = 0; bj < 2; ++bj) {
                        f32x4 v0 = acc[ai][bj][m][0], v1 = acc[ai][bj][m][1];
                        const int col = p4 * 256 + bj * HALF + wc * 32 + 8 * fq;
                        if (tt == 3 || tt == 5) {
#pragma unroll
                            for (int e = 0; e < 4; ++e) { v0[e] = silu_f(v0[e]); v1[e] = silu_f(v1[e]); }
                        }
                        u32x4 w; w.x = cvt_pk_bf16(v0[0], v0[1]); w.y = cvt_pk_bf16(v0[2], v0[3]); w.z = cvt_pk_bf16(v1[0], v1[1]); w.w = cvt_pk_bf16(v1[2], v1[3]);
                        if (tt == 4) {
                            const int b = row >> 13, s = row & 8191, g = col >> 4;
                            *(u32x4*)(UC + ((size_t)(b * 64 + g) * 8192 + s) * 16 + (col & 15)) = w;
                        } else {
                            bf16_t* base = (tt == 2) ? V : (tt == 3) ? GA : GS;
                            *(u32x4*)(base + (size_t)row * 1024 + col) = w;
                        }
                    }
                }
        }
    }
};

struct EpiGlu {
    static constexpr bool PERM = true, AFTER_DRAIN = false;
    const bf16_t* GY; const bf16_t* GS; const float* bias; bf16_t* MIX;
    __device__ __forceinline__ void operator()(const f32x4 (&acc)[2][2][4][2], const Unit& u, int wr, int wc, int fr, int fq) const {
        const int row0 = u.pm * BM + wr * 64 + fr, col0 = u.pn * BM + wc * 32 + 8 * fq;
        f32x4 bv[2][2];
#pragma unroll
        for (int bj = 0; bj < 2; ++bj)
#pragma unroll
            for (int n = 0; n < 2; ++n) bv[bj][n] = *(const f32x4*)(bias + col0 + bj * HALF + 4 * n);
#pragma unroll
        for (int ai = 0; ai < 2; ++ai)
#pragma unroll
            for (int m = 0; m < 4; ++m) {
                const int row = row0 + ai * HALF + m * 16;
#pragma unroll
                for (int bj = 0; bj < 2; ++bj) {
                    const int col = col0 + bj * HALF;
                    const u32x4 gy = *(const u32x4*)(GY + (size_t)row * 1024 + col), gs = *(const u32x4*)(GS + (size_t)row * 1024 + col);
                    const f32x4 v0 = acc[ai][bj][m][0] + bv[bj][0], v1 = acc[ai][bj][m][1] + bv[bj][1];
                    u32x4 w;
                    w.x = cvt_pk_bf16(bf_lo(gy.x) * sigmoid_f(v0[0]) * bf_lo(gs.x), bf_hi(gy.x) * sigmoid_f(v0[1]) * bf_hi(gs.x));
                    w.y = cvt_pk_bf16(bf_lo(gy.y) * sigmoid_f(v0[2]) * bf_lo(gs.y), bf_hi(gy.y) * sigmoid_f(v0[3]) * bf_hi(gs.y));
                    w.z = cvt_pk_bf16(bf_lo(gy.z) * sigmoid_f(v1[0]) * bf_lo(gs.z), bf_hi(gy.z) * sigmoid_f(v1[1]) * bf_hi(gs.z));
                    w.w = cvt_pk_bf16(bf_lo(gy.w) * sigmoid_f(v1[2]) * bf_lo(gs.w), bf_hi(gy.w) * sigmoid_f(v1[3]) * bf_hi(gs.w));
                    *(u32x4*)(MIX + (size_t)row * 2048 + 1024 + col) = w;
                }
            }
    }
};

struct EpiOut {
    static constexpr bool PERM = true, AFTER_DRAIN = false;
    const float* x; const float* mod; float* out;
    __device__ __forceinline__ void operator()(const f32x4 (&acc)[2][2][4][2], const Unit& u, int wr, int wc, int fr, int fq) const {
        const int row0 = u.pm * BM + wr * 64 + fr, col0 = u.pn * BM + wc * 32 + 8 * fq;
        const int b = (u.pm * BM) >> 13;
        f32x4 gv[2][2];
#pragma unroll
        for (int bj = 0; bj < 2; ++bj)
#pragma unroll
            for (int n = 0; n < 2; ++n) gv[bj][n] = *(const f32x4*)(mod + b * 3072 + 2048 + col0 + bj * HALF + 4 * n);
#pragma unroll
        for (int ai = 0; ai < 2; ++ai)
#pragma unroll
            for (int mh = 0; mh < 2; ++mh) {
                f32x4 xv[2][2][2];
#pragma unroll
                for (int mm = 0; mm < 2; ++mm) { const size_t off = (size_t)(row0 + ai * HALF + (2 * mh + mm) * 16) * 1024 + col0;
#pragma unroll
                    for (int bj = 0; bj < 2; ++bj)
#pragma unroll
                        for (int n = 0; n < 2; ++n) xv[mm][bj][n] = __builtin_nontemporal_load((const f32x4*)(x + off + bj * HALF + 4 * n)); }
                asm volatile("" ::: "memory");
#pragma unroll
                for (int mm = 0; mm < 2; ++mm) { const size_t off = (size_t)(row0 + ai * HALF + (2 * mh + mm) * 16) * 1024 + col0;
#pragma unroll
                    for (int bj = 0; bj < 2; ++bj)
#pragma unroll
                        for (int n = 0; n < 2; ++n) *(f32x4*)(out + off + bj * HALF + 4 * n) = xv[mm][bj][n] + gv[bj][n] * acc[ai][bj][2 * mh + mm][n]; }
                asm volatile("" ::: "memory");
            }
    }
};
template <class Epi, class Sched, bool ALIGN_EPI = false, bool SP2 = false>
__device__ __forceinline__ void gemm_phase(PG8_LAS unsigned char* lds, const Gemm g, const Sched& S, const Epi& E, const int wid) {
    const int lane = lane_id(), tid = wid * 64 + lane, wr = wid >> 2, wc = wid & 3, fr = lane & 15, fq = lane >> 4;
    const int K = g.K, nt = K / BK;
    unsigned voffA[2], voffB[2];
#pragma unroll
    for (int i = 0; i < 2; ++i) { int R, C; stage_rc(tid * 16 + i * 8192, R, C); const int Rb = Epi::PERM ? ((R & ~31) + perm32(R & 31)) : R;
        voffA[i] = (unsigned)(R * K + C) * 2u; voffB[i] = (unsigned)(Rb * K + C) * 2u; }
    const size_t kstep = (size_t)(BK * 2);
    const size_t hstep = (size_t)HALF * K * 2;
    const size_t tstep = 2 * hstep;
    const unsigned ldsw = (unsigned)wid * 1024u;
    const int aoff = lds_byte(wr * 64 + fr, fq * 8), boff = lds_byte(wc * 32 + fr, fq * 8);
#define PG8_SA(b, h) (((b) * 2 + (h)) * HTB)
#define PG8_SB(b, h) ((4 + (b) * 2 + (h)) * HTB)
#define PG8_STAGE(bufoff, gbase, voff) do { _Pragma("unroll") for (int _i = 0; _i < 2; ++_i) \
        __builtin_amdgcn_global_load_lds((const unsigned*)((const char*)(gbase) + (voff)[_i]), (PG8_LAS unsigned*)(lds + (bufoff) + ldsw + _i * 8192), 16, 0, 0); } while (0)
#define PG8_LDA(dst, b, h) do { _Pragma("unroll") for (int m = 0; m < 4; ++m) _Pragma("unroll") for (int k = 0; k < 2; ++k) dst[m][k] = *(const PG8_LAS bf16x8*)(lds + PG8_SA(b, h) + aoff + m * 2048 + k * 1024); } while (0)
#define PG8_LDB(dst, b, h) do { _Pragma("unroll") for (int n = 0; n < 2; ++n) _Pragma("unroll") for (int k = 0; k < 2; ++k) dst[n][k] = *(const PG8_LAS bf16x8*)(lds + PG8_SB(b, h) + boff + n * 2048 + k * 1024); } while (0)
#define PG8_MMA(ai, bj, At, Bt) do { __builtin_amdgcn_s_setprio(1); _Pragma("unroll") for (int m = 0; m < 4; ++m) _Pragma("unroll") for (int n = 0; n < 2; ++n) _Pragma("unroll") for (int k = 0; k < 2; ++k) \
        acc[ai][bj][m][n] = __builtin_amdgcn_mfma_f32_16x16x32_bf16(Bt[n][k], At[m][k], acc[ai][bj][m][n], 0, 0, 0); __builtin_amdgcn_s_setprio(0); } while (0)
#define PG8_WAIT_V(n) asm volatile("s_waitcnt vmcnt(" #n ")" ::: "memory")
#define PG8_WAIT_L(n) asm volatile("s_waitcnt lgkmcnt(" #n ")" ::: "memory")
#define PG8_BAR __builtin_amdgcn_s_barrier()
#define PG8_SCHED __builtin_amdgcn_sched_barrier(0)
    Unit cur, nxt; int ui = 0;
    if (!S.next(0, cur)) return;
    f32x4 acc[2][2][4][2];
#pragma unroll
    for (int a = 0; a < 2; ++a)
#pragma unroll
        for (int b = 0; b < 2; ++b)
#pragma unroll
            for (int m = 0; m < 4; ++m)
#pragma unroll
                for (int n = 0; n < 2; ++n) acc[a][b][m][n] = (f32x4){0.f, 0.f, 0.f, 0.f};
    bf16x8 At[4][2], B0[2][2], B1[2][2];
    const char* cA = (const char*)g.A + (size_t)cur.pm * tstep; const char* cB = (const char*)g.Bt + (size_t)cur.pn * tstep;
    S.a_ready(cur);
    if constexpr (SP2) {
        PG8_STAGE(PG8_SB(0, 0), cB, voffB); PG8_STAGE(PG8_SB(0, 1), cB + hstep, voffB); PG8_STAGE(PG8_SA(0, 0), cA, voffA); PG8_STAGE(PG8_SA(0, 1), cA + hstep, voffA);
        if (wr == 1) PG8_BAR;
        PG8_WAIT_V(2); PG8_BAR;
        PG8_STAGE(PG8_SB(1, 0), cB + kstep, voffB); PG8_STAGE(PG8_SA(1, 0), cA + kstep, voffA); PG8_STAGE(PG8_SB(1, 1), cB + hstep + kstep, voffB);
        PG8_WAIT_V(6); PG8_BAR;
    } else {
        PG8_STAGE(PG8_SB(0, 0), cB, voffB); PG8_STAGE(PG8_SA(0, 0), cA, voffA); PG8_STAGE(PG8_SB(0, 1), cB + hstep, voffB); PG8_STAGE(PG8_SA(0, 1), cA + hstep, voffA);
        if (wr == 1) PG8_BAR;
        PG8_WAIT_V(4); PG8_BAR;
        PG8_STAGE(PG8_SB(1, 0), cB + kstep, voffB); PG8_STAGE(PG8_SA(1, 0), cA + kstep, voffA); PG8_STAGE(PG8_SB(1, 1), cB + hstep + kstep, voffB);
        PG8_WAIT_V(6); PG8_BAR;
    }
    for (;;) {
        const bool has_next = S.next(ui + 1, nxt);
        const char* nA = has_next ? (const char*)g.A + (size_t)nxt.pm * tstep : cA; const char* nB = has_next ? (const char*)g.Bt + (size_t)nxt.pn * tstep : cB;
        for (int t = 0; t < nt; t += 2) {
            const bool last = (t == nt - 2);
            const char* a1 = cA + (size_t)(t + 1) * kstep;
            const char* a2 = last ? nA : cA + (size_t)(t + 2) * kstep; const char* b2 = last ? nB : cB + (size_t)(t + 2) * kstep;
            const char* a3 = a2 + kstep; const char* b3 = b2 + kstep;
            if (last && has_next) S.a_ready(nxt);
            if constexpr (SP2) {
            PG8_LDB(B0, 0, 0); PG8_LDB(B1, 0, 1); PG8_SCHED; PG8_LDA(At, 0, 0); PG8_STAGE(PG8_SA(1, 1), a1 + hstep, voffA);
            PG8_WAIT_V(8); PG8_WAIT_L(0); PG8_BAR; PG8_MMA(0, 0, At, B0); PG8_MMA(0, 1, At, B1); PG8_BAR; PG8_SCHED;
            PG8_LDA(At, 0, 1); PG8_STAGE(PG8_SB(0, 0), b2, voffB); PG8_STAGE(PG8_SB(0, 1), b2 + hstep, voffB); PG8_STAGE(PG8_SA(0, 0), a2, voffA);
            PG8_WAIT_V(8); PG8_WAIT_L(0); PG8_BAR; PG8_MMA(1, 0, At, B0); PG8_MMA(1, 1, At, B1); PG8_BAR; PG8_SCHED;
            PG8_LDB(B0, 1, 0); PG8_LDB(B1, 1, 1); PG8_SCHED; PG8_LDA(At, 1, 0); PG8_STAGE(PG8_SA(0, 1), a2 + hstep, voffA);
            PG8_WAIT_V(8); PG8_WAIT_L(0); PG8_BAR; PG8_MMA(0, 0, At, B0); PG8_MMA(0, 1, At, B1); PG8_BAR; PG8_SCHED;
            PG8_LDA(At, 1, 1); PG8_STAGE(PG8_SB(1, 0), b3, voffB); PG8_STAGE(PG8_SB(1, 1), b3 + hstep, voffB); PG8_STAGE(PG8_SA(1, 0), a3, voffA);
            PG8_WAIT_V(8); PG8_WAIT_L(0); PG8_BAR; PG8_MMA(1, 0, At, B0); PG8_MMA(1, 1, At, B1); PG8_BAR; PG8_SCHED;
            } else {
            PG8_LDB(B0, 0, 0); PG8_SCHED; PG8_LDA(At, 0, 0); PG8_STAGE(PG8_SA(1, 1), a1 + hstep, voffA);
            PG8_WAIT_L(8); PG8_BAR; PG8_WAIT_L(0); PG8_MMA(0, 0, At, B0); PG8_BAR; PG8_SCHED;
            PG8_LDB(B1, 0, 1); PG8_STAGE(PG8_SB(0, 0), b2, voffB);
            PG8_BAR; PG8_WAIT_L(0); PG8_MMA(0, 1, At, B1); PG8_BAR;
            PG8_LDA(At, 0, 1); PG8_STAGE(PG8_SA(0, 0), a2, voffA);
            PG8_BAR; PG8_WAIT_L(0); PG8_MMA(1, 0, At, B0); PG8_BAR; PG8_SCHED;
            PG8_STAGE(PG8_SB(0, 1), b2 + hstep, voffB);
            PG8_WAIT_V(6); PG8_BAR; PG8_MMA(1, 1, At, B1); PG8_BAR;
            PG8_LDB(B0, 1, 0); PG8_SCHED; PG8_LDA(At, 1, 0); PG8_STAGE(PG8_SA(0, 1), a2 + hstep, voffA);
            PG8_WAIT_L(8); PG8_BAR; PG8_WAIT_L(0); PG8_MMA(0, 0, At, B0); PG8_BAR; PG8_SCHED;
            PG8_LDB(B1, 1, 1); PG8_STAGE(PG8_SB(1, 0), b3, voffB);
            PG8_BAR; PG8_WAIT_L(0); PG8_MMA(0, 1, At, B1); PG8_BAR;
            PG8_LDA(At, 1, 1); PG8_STAGE(PG8_SA(1, 0), a3, voffA);
            PG8_BAR; PG8_WAIT_L(0); PG8_MMA(1, 0, At, B0); PG8_BAR; PG8_SCHED;
            PG8_STAGE(PG8_SB(1, 1), b3 + hstep, voffB);
            PG8_WAIT_V(6); PG8_BAR; PG8_MMA(1, 1, At, B1); PG8_BAR;
            }
        }
        if constexpr (ALIGN_EPI) { if (wr == 0) PG8_BAR; }
        if constexpr (!Epi::AFTER_DRAIN) { E(acc, cur, wr, wc, fr, fq); S.done(cur); }
        if (!has_next) break;
#pragma unroll
        for (int a = 0; a < 2; ++a)
#pragma unroll
            for (int b = 0; b < 2; ++b)
#pragma unroll
                for (int m = 0; m < 4; ++m)
#pragma unroll
                    for (int n = 0; n < 2; ++n) acc[a][b][m][n] = (f32x4){0.f, 0.f, 0.f, 0.f};
        cur = nxt; cA = nA; cB = nB; ++ui;
        if constexpr (ALIGN_EPI) { if (wr == 1) PG8_BAR; }
    }
    PG8_WAIT_V(0);
    if constexpr (!ALIGN_EPI) { if (wr == 0) PG8_BAR; }
    PG8_BAR;
    if constexpr (Epi::AFTER_DRAIN) { E.fused(acc, cur, wr, wc, fr, fq, lds, wid, lane); S.done(cur); }
#undef PG8_SA
#undef PG8_SB
#undef PG8_STAGE
#undef PG8_LDA
#undef PG8_LDB
#undef PG8_MMA
#undef PG8_WAIT_V
#undef PG8_WAIT_L
#undef PG8_BAR
#undef PG8_SCHED
}
}
#include <hip/hip_bf16.h>
#include <cmath>
namespace attn_body {
using bf16=__hip_bfloat16;
using bf16x8=__attribute__((ext_vector_type(8)))short;
using s16x4=__attribute__((ext_vector_type(4)))short;
using f32x16=__attribute__((ext_vector_type(16)))float;
using u32x4=__attribute__((ext_vector_type(4)))unsigned;
constexpr int BATCH=4,NHEAD=16,SEQ=8192,D=64,DM=NHEAD*D,OP=2048;
constexpr int NW=8,QBLK=32,QB=QBLK*NW,KVBLK=64,NQB=SEQ/QB;
constexpr int ATTN_PITCH=DM, ATTN_UNIT_ROWS=QB;
__device__ __forceinline__ int crow(int r,int hi){return (r&3)+8*(r>>2)+4*hi;}
#define SBAR() __builtin_amdgcn_sched_barrier(0)
__device__ __forceinline__ void cmask(f32x16&p0,f32x16&p1,int jb,int qrel,int hi){
  const float NEG=-INFINITY; (void)hi;
  if(jb>(qrel>>6)){
  #pragma unroll
  for(int r=0;r<16;++r){p0[r]=NEG;p1[r]=NEG;}}
}

constexpr int NSLOT=3, SLOTB=8192, SLOTV=16384;
constexpr int LDS_K=0, LDS_V=NSLOT*SLOTB, LDS_WS=LDS_V+NSLOT*SLOTV, LDS_OST=LDS_WS+NW*64*4, LDS_BYTES=LDS_OST+NW*4096;
constexpr float C2=0.125f*1.4426950408889634f;
__device__ __forceinline__ void glds16(const void*gsrc,unsigned lds_dst){unsigned keep;
  asm volatile("s_mov_b32 %0, m0\n\ts_mov_b32 m0, %2\n\ts_nop 0\n\tglobal_load_lds_dwordx4 %1, off\n\ts_mov_b32 m0, %0":"=&s"(keep):"v"(gsrc),"s"(lds_dst):"memory");}
__device__ __forceinline__ float max3f(float a,float b,float c){float r;asm("v_max3_f32 %0, %1, %2, %3":"=v"(r):"v"(a),"v"(b),"v"(c));return r;}
__device__ __forceinline__ float max2f(float a,float b){float r;asm("v_max_f32_e32 %0, %1, %2":"=v"(r):"v"(a),"v"(b));return r;}
__device__ __forceinline__ float fadd_s(float a,float b){float r;asm("v_add_f32_e32 %0, %1, %2":"=v"(r):"v"(a),"v"(b));return r;}
__device__ __forceinline__ float fsub_s(float a,float b){float r;asm("v_sub_f32_e32 %0, %1, %2":"=v"(r):"v"(a),"v"(b));return r;}
typedef float f32x2_t __attribute__((ext_vector_type(2))); typedef __bf16 bf16x2_t __attribute__((ext_vector_type(2)));
__device__ __forceinline__ unsigned cvtpk_s(float lo,float hi){f32x2_t v={lo,hi};bf16x2_t b=__builtin_convertvector(v,bf16x2_t);return __builtin_bit_cast(unsigned,b);}
#define WAIT_BAR(N) asm volatile("s_waitcnt vmcnt(" #N ") lgkmcnt(0)\n\ts_barrier":::"memory")

__device__ __forceinline__ void qkt(f32x16&p0,f32x16&p1,const char*Kslot,const bf16x8*qr,int r32,int hi){
  const f32x16 zero16={};
  const char*kb=Kslot+hi*1024+r32*16;
  #pragma unroll
  for(int d0=0;d0<4;++d0){
    const bf16x8 b0=*reinterpret_cast<const bf16x8*>(kb+d0*2048);
    const bf16x8 b1=*reinterpret_cast<const bf16x8*>(kb+d0*2048+512);
    if(d0==0){p0=__builtin_amdgcn_mfma_f32_32x32x16_bf16(b0,qr[0],zero16,0,0,0);p1=__builtin_amdgcn_mfma_f32_32x32x16_bf16(b1,qr[0],zero16,0,0,0);}
    else{p0=__builtin_amdgcn_mfma_f32_32x32x16_bf16(b0,qr[d0],p0,0,0,0);p1=__builtin_amdgcn_mfma_f32_32x32x16_bf16(b1,qr[d0],p1,0,0,0);}}
}
typedef __attribute__((address_space(3))) const char* lds_cptr;
typedef short v4i16_t __attribute__((ext_vector_type(4)));
__device__ __forceinline__ void kload8(bf16x8*kf,lds_cptr kp){
  kf[0]=*(const __attribute__((address_space(3))) bf16x8*)(kp);      kf[1]=*(const __attribute__((address_space(3))) bf16x8*)(kp+512);
  kf[2]=*(const __attribute__((address_space(3))) bf16x8*)(kp+2048); kf[3]=*(const __attribute__((address_space(3))) bf16x8*)(kp+2560);
  kf[4]=*(const __attribute__((address_space(3))) bf16x8*)(kp+4096); kf[5]=*(const __attribute__((address_space(3))) bf16x8*)(kp+4608);
  kf[6]=*(const __attribute__((address_space(3))) bf16x8*)(kp+6144); kf[7]=*(const __attribute__((address_space(3))) bf16x8*)(kp+6656);
}
__device__ __forceinline__ void kload2(bf16x8*kf,lds_cptr kp,int j){ kf[2*j]=*(const __attribute__((address_space(3))) bf16x8*)(kp+j*2048); kf[2*j+1]=*(const __attribute__((address_space(3))) bf16x8*)(kp+j*2048+512); }
__device__ __forceinline__ s16x4 vtr(lds_cptr p){ return __builtin_bit_cast(s16x4,__builtin_amdgcn_ds_read_tr16_b64_v4i16((__attribute__((address_space(3))) v4i16_t*)p)); }
__device__ __forceinline__ float rowmax(const f32x16&p0,const f32x16&p1){
  float a=max3f(p0[0],p0[1],p1[0]),b=max3f(p0[2],p0[3],p1[1]);a=max3f(a,p1[2],p1[3]);
  #pragma unroll
  for(int r=4;r<16;r+=4){a=max3f(a,p0[r],p0[r+1]);b=max3f(b,p0[r+2],p0[r+3]);a=max3f(a,p1[r],p1[r+1]);b=max3f(b,p1[r+2],p1[r+3]);}
  const float m=max2f(a,b);
  auto rr=__builtin_amdgcn_permlane32_swap(__float_as_uint(m),__float_as_uint(m),false,false);
  return max2f(__uint_as_float(rr[0]),__uint_as_float(rr[1]));
}
__device__ __forceinline__ void pv(f32x16*o,int vb,bf16x8 pa0,bf16x8 pa1,bf16x8 pa2,bf16x8 pa3){
  #pragma unroll
  for(int d0=0;d0<4;++d0){s16x4 lo[4],hi[4];
    #pragma unroll
    for(int ks=0;ks<4;++ks){
      asm volatile("ds_read_b64_tr_b16 %0,%1 offset:%c2":"=&v"(lo[ks]):"v"(vb),"i"(d0*4096+ks*1024):"memory");
      asm volatile("ds_read_b64_tr_b16 %0,%1 offset:%c2":"=&v"(hi[ks]):"v"(vb),"i"(d0*4096+ks*1024+512):"memory");}
    asm volatile("s_waitcnt lgkmcnt(0)":::"memory");SBAR();
    #define PK(k) (bf16x8){lo[k][0],lo[k][1],lo[k][2],lo[k][3],hi[k][0],hi[k][1],hi[k][2],hi[k][3]}
    o[d0]=__builtin_amdgcn_mfma_f32_32x32x16_bf16(pa0,PK(0),o[d0],0,0,0);
    o[d0]=__builtin_amdgcn_mfma_f32_32x32x16_bf16(pa1,PK(1),o[d0],0,0,0);
    o[d0]=__builtin_amdgcn_mfma_f32_32x32x16_bf16(pa2,PK(2),o[d0],0,0,0);
    o[d0]=__builtin_amdgcn_mfma_f32_32x32x16_bf16(pa3,PK(3),o[d0],0,0,0);
    #undef PK
  }
}

#ifndef ATTN_STORE16
#define ATTN_STORE16(p,v) (*(u32x4*)(p)=(v))
#endif
template<int THRL> __device__ __forceinline__ void attn_unit(int b,int h,int qb,const bf16*__restrict__ Q,const bf16*__restrict__ K,const bf16*__restrict__ V,bf16* O,const bf16*__restrict__ GA,const float*__restrict__ hg,const float lam,char*shm,const int wid){
  const int lane=lane_id(),r32=lane&31,hi=lane>>5;
  const long rowbase=(long)b*SEQ; const int q0=qb*QB;
  const bf16*Qw=Q+(rowbase+q0+wid*QBLK)*DM+h*D;
  const bf16*Kh=K+rowbase*DM+h*D,*Vh=V+rowbase*DM+(h>>1)*128;
  const unsigned lds0=(unsigned)(uintptr_t)shm;
  float*wsf=(float*)(shm+LDS_WS)+wid*64;
  const bf16*ksrc=Kh+(long)lane*DM+wid*8;
  const bf16*vsrc=Vh+(long)(16*(wid&3)+(lane>>2))*DM+(wid>>2)*32+(lane&3)*8;
  const unsigned kdst=lds0+LDS_K+wid*1024, vdst=lds0+LDS_V+wid*1024;
  #define DMA_K(t,slot) glds16(ksrc+(long)(t)*KVBLK*DM,(unsigned)__builtin_amdgcn_readfirstlane(kdst+(slot)))
  #define DMA_V(t,slot) do{ glds16(vsrc+(long)(t)*KVBLK*DM,(unsigned)__builtin_amdgcn_readfirstlane(vdst+2*(slot))); glds16(vsrc+64+(long)(t)*KVBLK*DM,(unsigned)__builtin_amdgcn_readfirstlane(vdst+8192+2*(slot))); }while(0)
  const int vb0=(int)(lds0+LDS_V)+((lane>>4)&1)*32+(lane&3)*8+(4*hi+((lane&15)>>2))*64;
  const char*Kbase=shm+LDS_K; bf16x8 kf[8];
  const lds_cptr shm3=(lds_cptr)shm; const lds_cptr kp0=shm3+LDS_K+hi*1024+r32*16; const lds_cptr vp0=shm3+LDS_V+((lane>>4)&1)*32+(lane&3)*8+(4*hi+((lane&15)>>2))*64;
  const int NT=(q0+QB)/KVBLK;
  DMA_K(0,0);DMA_V(0,0);DMA_K(1,SLOTB);
  bf16x8 qr[4];
  #pragma unroll
  for(int d0=0;d0<4;++d0)qr[d0]=*reinterpret_cast<const bf16x8*>(&Qw[(long)r32*DM+d0*16+hi*8]);
  float l_reg=0.f;f32x16 o[4];o[0]=f32x16{};o[1]=f32x16{};o[2]=f32x16{};o[3]=f32x16{};const f32x16 zero16={};
  const int qrel=wid*QBLK;
  #define CMASK(P0,P1,t) do{int jb_=(t)-(NT-4); if(jb_>=0)cmask(P0,P1,jb_,qrel,hi);}while(0)
  bool resc=false;
  #define START(P0,P1) do{ resc=false; \
    _Pragma("unroll") for(int r=0;r<16;++r)P0[r]=__builtin_amdgcn_exp2f(P0[r]); }while(0)
  #define RESC() do{ if(resc){ asm volatile("s_waitcnt lgkmcnt(0)":::"memory"); \
      _Pragma("unroll") for(int d_=0;d_<4;++d_) _Pragma("unroll") for(int r=0;r<16;++r)o[d_][r]*=wsf[crow(r,hi)]; } }while(0)
  f32x16 pA0,pA1,pB0,pB1;
  int sl_prev=0,sl_cur=0,sl_next=SLOTB;
  #define ROT() do{sl_prev=sl_cur;sl_cur=sl_next;sl_next=(sl_next==(NSLOT-1)*SLOTB)?0:sl_next+SLOTB;}while(0)
  DMA_K(2,2*SLOTB);
  WAIT_BAR(3);
  qkt(pA0,pA1,Kbase,qr,r32,hi);asm volatile("s_nop 15\n\ts_nop 7":"+v"(pA0),"+v"(pA1));CMASK(pA0,pA1,0);
  START(pA0,pA1);
  _Pragma("unroll") for(int r=0;r<16;++r)pA1[r]=__builtin_amdgcn_exp2f(pA1[r]);
  WAIT_BAR(0);
  DMA_K(3,0);DMA_V(1,SLOTB);
  ROT();
  kload8(kf,kp0+sl_cur);
  WAIT_BAR(3);
  s16x4 vlo[8],vhi[8]; u32x4 pw0,pw1,pw2,pw3;
  #define PKW(P,B) cvtpk_s(P[B],P[B+1])
  #define PAF(k) __builtin_bit_cast(bf16x8,pw##k)
  #define VFR(i) (bf16x8){vlo[i][0],vlo[i][1],vlo[i][2],vlo[i][3],vhi[i][0],vhi[i][1],vhi[i][2],vhi[i][3]}
  #define PIN(x) asm volatile("":"+v"(x))
  #define MX3(a,b,c) __builtin_fmaxf(__builtin_fmaxf((a),(b)),(c))
  #define GAPA(MF,A0,A1,A2,A3,W0,W1,PW) do{ MF; sacc+=A0; sacc+=A1; sacc+=A2; sacc+=A3; PIN(sacc); W0; W1; PIN(PW); SBAR(); }while(0)
  #define EX(v) __builtin_amdgcn_exp2f(v)
  #define GAPB(MF,RL,X,B) do{ MF; RL; X[B]=EX(X[B]); X[B+1]=EX(X[B+1]); PIN(X); SBAR(); }while(0)
  #define VRD(i) do{ vlo[i]=vtr(vp_+(((i)>>2)*4096+((i)&3)*1024)); vhi[i]=vtr(vp_+(((i)>>2)*4096+((i)&3)*1024+512)); }while(0)
  #define VRD2(i) do{ vlo[i]=vtr(vp_+((((i)>>2)+2)*4096+((i)&3)*1024)); vhi[i]=vtr(vp_+((((i)>>2)+2)*4096+((i)&3)*1024+512)); }while(0)
  #define KRD(G,j) do{ if(G){ kload2(kf,kp0+sl_next,j); SBAR(); } }while(0)
  #define STEP(C0,C1,P0,P1,t,GK,GV,GL) do{ SBAR(); \
    const lds_cptr vp_=vp0+2*sl_prev; \
    VRD(0); SBAR(); float sacc=(P0[0]+P0[1]); \
    GAPA(C0=__builtin_amdgcn_mfma_f32_32x32x16_bf16(kf[0],qr[0],zero16,0,0,0), P0[2],P0[3],P0[4],P0[5],     pw0[0]=PKW(P0,0), pw0[1]=PKW(P0,2), pw0); \
    VRD(4); SBAR(); GAPA(C1=__builtin_amdgcn_mfma_f32_32x32x16_bf16(kf[1],qr[0],zero16,0,0,0), P0[6],P0[7],P0[8],P0[9],     pw0[2]=PKW(P0,4), pw0[3]=PKW(P0,6), pw0); \
    VRD(1); SBAR(); GAPA(C0=__builtin_amdgcn_mfma_f32_32x32x16_bf16(kf[2],qr[1],C0,0,0,0),   P0[10],P0[11],P0[12],P0[13], pw1[0]=PKW(P0,8), pw1[1]=PKW(P0,10), pw1); \
    VRD(5); SBAR(); GAPA(C1=__builtin_amdgcn_mfma_f32_32x32x16_bf16(kf[3],qr[1],C1,0,0,0),   P0[14],P0[15],P1[0],P1[1],   pw1[2]=PKW(P0,12),pw1[3]=PKW(P0,14), pw1); \
    VRD(2); SBAR(); GAPA(C0=__builtin_amdgcn_mfma_f32_32x32x16_bf16(kf[4],qr[2],C0,0,0,0),   P1[2],P1[3],P1[4],P1[5],     pw2[0]=PKW(P1,0), pw2[1]=PKW(P1,2), pw2); \
    VRD(6); SBAR(); GAPA(C1=__builtin_amdgcn_mfma_f32_32x32x16_bf16(kf[5],qr[2],C1,0,0,0),   P1[6],P1[7],P1[8],P1[9],     pw2[2]=PKW(P1,4), pw2[3]=PKW(P1,6), pw2); \
    VRD(3); SBAR(); GAPA(C0=__builtin_amdgcn_mfma_f32_32x32x16_bf16(kf[6],qr[3],C0,0,0,0),   P1[10],P1[11],P1[12],P1[13], pw3[0]=PKW(P1,8), pw3[1]=PKW(P1,10), pw3); \
    VRD(7); SBAR(); GAPA(C1=__builtin_amdgcn_mfma_f32_32x32x16_bf16(kf[7],qr[3],C1,0,0,0),   P1[14],P1[15],0.f,0.f,       pw3[2]=PKW(P1,12),pw3[3]=PKW(P1,14), pw3); \
    l_reg+=sacc; \
    if(GK){DMA_K((t)+3,sl_cur);} if(GV){DMA_V((t)+1,sl_next);} \
    CMASK(C0,C1,t); \
    SBAR(); \
    GAPB(o[0]=__builtin_amdgcn_mfma_f32_32x32x16_bf16(PAF(0),VFR(0),o[0],0,0,0), VRD2(0), C0,0); \
    GAPB(o[1]=__builtin_amdgcn_mfma_f32_32x32x16_bf16(PAF(0),VFR(4),o[1],0,0,0), VRD2(4), C0,2); \
    KRD(GL,0); GAPB(o[0]=__builtin_amdgcn_mfma_f32_32x32x16_bf16(PAF(1),VFR(1),o[0],0,0,0), VRD2(1), C0,4); \
    KRD(GL,1); GAPB(o[1]=__builtin_amdgcn_mfma_f32_32x32x16_bf16(PAF(1),VFR(5),o[1],0,0,0), VRD2(5), C0,6); \
    KRD(GL,2); GAPB(o[0]=__builtin_amdgcn_mfma_f32_32x32x16_bf16(PAF(2),VFR(2),o[0],0,0,0), VRD2(2), C0,8); \
    KRD(GL,3); GAPB(o[1]=__builtin_amdgcn_mfma_f32_32x32x16_bf16(PAF(2),VFR(6),o[1],0,0,0), VRD2(6), C0,10); \
    GAPB(o[0]=__builtin_amdgcn_mfma_f32_32x32x16_bf16(PAF(3),VFR(3),o[0],0,0,0), VRD2(3), C0,12); \
    GAPB(o[1]=__builtin_amdgcn_mfma_f32_32x32x16_bf16(PAF(3),VFR(7),o[1],0,0,0), VRD2(7), C0,14); \
    GAPB(o[2]=__builtin_amdgcn_mfma_f32_32x32x16_bf16(PAF(0),VFR(0),o[2],0,0,0), (void)0, C1,0); \
    GAPB(o[3]=__builtin_amdgcn_mfma_f32_32x32x16_bf16(PAF(0),VFR(4),o[3],0,0,0), (void)0, C1,2); \
    GAPB(o[2]=__builtin_amdgcn_mfma_f32_32x32x16_bf16(PAF(1),VFR(1),o[2],0,0,0), (void)0, C1,4); \
    GAPB(o[3]=__builtin_amdgcn_mfma_f32_32x32x16_bf16(PAF(1),VFR(5),o[3],0,0,0), (void)0, C1,6); \
    GAPB(o[2]=__builtin_amdgcn_mfma_f32_32x32x16_bf16(PAF(2),VFR(2),o[2],0,0,0), (void)0, C1,8); \
    GAPB(o[3]=__builtin_amdgcn_mfma_f32_32x32x16_bf16(PAF(2),VFR(6),o[3],0,0,0), (void)0, C1,10); \
    GAPB(o[2]=__builtin_amdgcn_mfma_f32_32x32x16_bf16(PAF(3),VFR(3),o[2],0,0,0), (void)0, C1,12); \
    GAPB(o[3]=__builtin_amdgcn_mfma_f32_32x32x16_bf16(PAF(3),VFR(7),o[3],0,0,0), (void)0, C1,14); \
    }while(0)
  int t=1;
  #undef CMASK
  #define CMASK(P0,P1,t) do{}while(0)
  for(;t+5<NT;t+=2){
    STEP(pB0,pB1,pA0,pA1,t,true,true,true);     WAIT_BAR(3); RESC(); ROT();
    STEP(pA0,pA1,pB0,pB1,t+1,true,true,true);   WAIT_BAR(3); RESC(); ROT();
  }
  #undef CMASK
  #define CMASK(P0,P1,t) do{int jb_=(t)-(NT-4); if(jb_>=0)cmask(P0,P1,jb_,qrel,hi);}while(0)
  #define ENDW(tt) do{ if((tt)+3<NT){WAIT_BAR(3);} else if((tt)+2<NT){WAIT_BAR(2);} else {WAIT_BAR(0);} }while(0)
  for(;t+1<NT;t+=2){
    STEP(pB0,pB1,pA0,pA1,t,(t+3<NT),(t+1<NT),(t+1<NT));       ENDW(t);   RESC(); ROT();
    STEP(pA0,pA1,pB0,pB1,t+1,(t+4<NT),(t+2<NT),(t+2<NT));     ENDW(t+1); RESC(); ROT();
  }
  STEP(pB0,pB1,pA0,pA1,NT-1,false,false,false); RESC();
  { float sacc=pB0[0]+pB0[1]; _Pragma("unroll") for(int r=2;r<16;++r)sacc+=pB0[r]; _Pragma("unroll") for(int r=0;r<16;++r)sacc+=pB1[r]; l_reg+=sacc;
    pw0=(u32x4){PKW(pB0,0),PKW(pB0,2),PKW(pB0,4),PKW(pB0,6)};pw1=(u32x4){PKW(pB0,8),PKW(pB0,10),PKW(pB0,12),PKW(pB0,14)};pw2=(u32x4){PKW(pB1,0),PKW(pB1,2),PKW(pB1,4),PKW(pB1,6)};pw3=(u32x4){PKW(pB1,8),PKW(pB1,10),PKW(pB1,12),PKW(pB1,14)};
    SBAR(); pv(o,vb0+2*sl_cur,PAF(0),PAF(1),PAF(2),PAF(3)); }
  #undef PKW
  #undef PAF
  #undef VFR
  #undef PIN
  #undef MX3
  #undef GAPA
  #undef GAPB
  #undef EX
  #undef VRD
  #undef KRD
  #undef STEP
  #undef ENDW
  {auto rr=__builtin_amdgcn_permlane32_swap(__float_as_uint(l_reg),__float_as_uint(l_reg),false,false);l_reg=__uint_as_float(rr[0])+__uint_as_float(rr[1]);}
  if(hi==0)wsf[32+r32]=l_reg;asm volatile("s_waitcnt lgkmcnt(0)":::"memory");
  float rli[16];
  #pragma unroll
  for(int r=0;r<16;++r)rli[r]=__builtin_amdgcn_rcpf(wsf[32+crow(r,hi)]);
  const long grow0=rowbase+q0+wid*QBLK;
  bf16*Ow=O+grow0*(long)OP+(h>>1)*128;
  { bf16*stg=(bf16*)(shm+LDS_OST)+wid*2048;
    if((h&1)==0){
    #pragma unroll
    for(int ps=0;ps<2;++ps){
      #pragma unroll
      for(int r=0;r<16;++r){const int orow=crow(r,hi);
        #pragma unroll
        for(int d0=0;d0<2;++d0)stg[orow*64+d0*32+r32]=__float2bfloat16(o[2*ps+d0][r]*rli[r]);}
      asm volatile("s_waitcnt lgkmcnt(0)":::"memory");
      #pragma unroll
      for(int i=0;i<4;++i){const int row=i*8+(lane>>3),ch=lane&7; const u32x4 v=*(const u32x4*)(stg+row*64+ch*8); ATTN_STORE16(Ow+(long)row*OP+ps*64+ch*8,v);}
      asm volatile("s_waitcnt lgkmcnt(0)":::"memory");
    }
    }else{
    float dd[2][4][8]; const int ch=lane&7;
    #pragma unroll
    for(int ps=0;ps<2;++ps){
      #pragma unroll
      for(int r=0;r<16;++r){const int orow=crow(r,hi);
        #pragma unroll
        for(int d0=0;d0<2;++d0)stg[orow*64+d0*32+r32]=__float2bfloat16(o[2*ps+d0][r]*rli[r]);}
      asm volatile("s_waitcnt lgkmcnt(0)":::"memory");
      #pragma unroll
      for(int i=0;i<4;++i){const int row=i*8+(lane>>3); const u32x4 v=*(const u32x4*)(stg+row*64+ch*8); const u32x4 z=*(const u32x4*)(Ow+(long)row*OP+ps*64+ch*8);
        #pragma unroll
        for(int q=0;q<4;++q){ dd[ps][i][2*q]=__builtin_bit_cast(float,z[q]<<16)-lam*__builtin_bit_cast(float,v[q]<<16); dd[ps][i][2*q+1]=__builtin_bit_cast(float,z[q]&0xffff0000u)-lam*__builtin_bit_cast(float,v[q]&0xffff0000u); } }
      asm volatile("s_waitcnt lgkmcnt(0)":::"memory");
    }
    float rs[4];
    #pragma unroll
    for(int i=0;i<4;++i){ float ss=0.f;
      #pragma unroll
      for(int ps=0;ps<2;++ps)
        #pragma unroll
        for(int e=0;e<8;++e)ss+=dd[ps][i][e]*dd[ps][i][e];
      ss+=__shfl_xor(ss,1); ss+=__shfl_xor(ss,2); ss+=__shfl_xor(ss,4);
      rs[i]=__builtin_amdgcn_rsqf(ss*(1.0f/128.0f)+1e-6f); }
    #pragma unroll
    for(int ps=0;ps<2;++ps){ float hgv[8];
      #pragma unroll
      for(int e=0;e<8;++e)hgv[e]=hg[ps*64+ch*8+e];
      #pragma unroll
      for(int i=0;i<4;++i){const int row=i*8+(lane>>3); const u32x4 g=*(const u32x4*)(GA+(grow0+row)*(long)DM+(h>>1)*128+ps*64+ch*8); u32x4 w;
        #pragma unroll
        for(int q=0;q<4;++q) w[q]=cvtpk_s(dd[ps][i][2*q]*rs[i]*hgv[2*q]*__builtin_bit_cast(float,g[q]<<16), dd[ps][i][2*q+1]*rs[i]*hgv[2*q+1]*__builtin_bit_cast(float,g[q]&0xffff0000u));
        ATTN_STORE16(Ow+(long)row*OP+ps*64+ch*8,w); } }
    } }
  asm volatile("s_waitcnt lgkmcnt(0)\n\ts_barrier":::"memory");
  #undef DMA_K
  #undef DMA_V
  #undef CMASK
  #undef START
  #undef RESC
  #undef ROT
}
constexpr int ATTN_LDS_BYTES=LDS_BYTES;
struct AttnTensors { const bf16* Q; const bf16* K; const bf16* V; bf16* O; const bf16* GA; const float* hg; float lam; };
struct AttnUnit { int b, hm, qb; };
struct AttnOrder {
  int vcu, G;
  __device__ __forceinline__ AttnOrder(int grid,int v):vcu(v),G(grid){}
  __device__ __forceinline__ bool next(int i,AttnUnit&u)const{
    int head,qb; const int map=i&1,k=i>>1;
    if(G==256){ if(k>=4)return false; head=vcu>>3; const int sq=vcu&7; qb=(k==0)?sq:(k==1)?15-sq:(k==2)?16+sq:31-sq; }
    else{ const int L=k*G+vcu; if(L>=1024)return false; head=L>>5; qb=31-(L&31); }
    u.b=head>>3; u.hm=2*(head&7)+map; u.qb=qb; return true; }
};
template<class Sched,int THRL=8> __device__ __forceinline__ void attn_phase(char*lds,const AttnTensors&T,const Sched&S,const int wid){
  AttnUnit u;
  for(int i=0;S.next(i,u);++i){ attn_unit<THRL>(u.b,u.hm,u.qb,T.Q,T.K,T.V,T.O,T.GA,T.hg,T.lam,lds,wid); }
}
#undef SBAR
#undef WAIT_BAR
}
constexpr int NWAVES = 8;
constexpr int BATCH = 4, SEQ = 8192, DM = 1024, M = BATCH * SEQ, NPROJ = 6144, MIXW = 2048;
constexpr int NGRP = 64;
constexpr float NORM_EPS = 1e-6f;
constexpr float LAM_INIT = 0.2f;

constexpr size_t MiB = 1u << 20;
constexpr size_t WS_MOD = 0;
constexpr size_t WS_A16 = 256 * 1024;
constexpr size_t WS_A128 = 320 * 1024;
constexpr size_t WS_HGS = 384 * 1024;
constexpr size_t WS_MODP = 512 * 1024;
constexpr size_t WS_WIN = 2 * MiB;
constexpr size_t WS_WGLU = 14 * MiB;
constexpr size_t WS_WOUT = 16 * MiB;
constexpr size_t WS_ROPE = 20 * MiB;
constexpr size_t WS_TT = 22 * MiB;
constexpr size_t WS_WS = 30 * MiB;
constexpr size_t WS_WOT = 34 * MiB;
constexpr size_t WS_Q = 40 * MiB, WS_K = 104 * MiB, WS_V = 168 * MiB, WS_GA = 232 * MiB, WS_GS = 296 * MiB, WS_END = 488 * MiB;
constexpr size_t WS_MIX = 360 * MiB;

constexpr int RING_OFF = 0, RING_BYTES = 131072;
constexpr int LDS_BYTES = 147456;

#define GAS __attribute__((address_space(1)))
#define LAS __attribute__((address_space(3)))
typedef unsigned short bf16;
typedef unsigned v4u __attribute__((ext_vector_type(4)));
typedef unsigned v2u __attribute__((ext_vector_type(2)));
typedef float f32x4 __attribute__((ext_vector_type(4)));
typedef float f32x2v __attribute__((ext_vector_type(2)));
typedef float f32x16 __attribute__((ext_vector_type(16)));
typedef short bf16x8 __attribute__((ext_vector_type(8)));
#define LDS_WAIT() asm volatile("s_waitcnt lgkmcnt(0)" ::: "memory")
__device__ __forceinline__ unsigned f2bf(float f) { unsigned u = __builtin_bit_cast(unsigned, f); return (u + 0x7fffu + ((u >> 16) & 1u)) >> 16; }
__device__ __forceinline__ unsigned pk2(float lo, float hi) { return f2bf(lo) | (f2bf(hi) << 16); }
__device__ __forceinline__ float wave_sum(float v) {
#pragma unroll
    for (int o = 1; o < 64; o <<= 1) v += __shfl_xor(v, o);
    return v;
}

typedef GAS unsigned gu32;
#define XB_TMO      128
#define XB_XCNT(j)  (256  + 64 * (j))
#define XB_XSUB(j)  (1280 + 64 * (j))
#define XB_XGEN(j)  (2304 + 64 * (j))
#define XB_TOP      3328
#define XB_TOPGEN   3392
#define XCD_BAR_WORDS 3456
#define XB_SPIN_CAP (1u << 18)

__device__ __forceinline__ unsigned xb_ld(unsigned* p)              { return __hip_atomic_load(p, __ATOMIC_RELAXED, __HIP_MEMORY_SCOPE_AGENT); }
__device__ __forceinline__ unsigned xb_add(unsigned* p, unsigned v) { return __hip_atomic_fetch_add(p, v, __ATOMIC_RELAXED, __HIP_MEMORY_SCOPE_AGENT); }
__device__ __forceinline__ unsigned xb_xcc_id() { return (unsigned)__builtin_amdgcn_s_getreg((3 << 11) | 20) & 0xFu; }
#define XB_SPIN(cond, bar) do { unsigned _sp = 0; while (cond) { __builtin_amdgcn_s_sleep(1); \
    if ((++_sp & 255u) == 0u) { if (xb_ld(&(bar)[XB_TMO])) break; if (_sp > XB_SPIN_CAP) { atomicAdd(&(bar)[XB_TMO], 1u); break; } } } } while (0)

struct XcdBarrier {
    unsigned* bar; unsigned x;
    volatile LAS unsigned* st;
};

__device__ __forceinline__ XcdBarrier xcd_barrier_post(unsigned* bar, volatile LAS unsigned* st) {
    XcdBarrier b; b.bar = bar; b.x = xb_xcc_id(); b.st = st;
    if (threadIdx.x == 0) (void)xb_add(&bar[XB_XCNT(b.x)], 1u);
    return b;
}
__device__ __forceinline__ void xcd_barrier_complete(unsigned* bar, unsigned x, unsigned& nloc, unsigned& nx) {
    const unsigned G = gridDim.x * gridDim.y * gridDim.z;
    unsigned sum, cnt, mine, sp = 0u;
    for (;;) {
        sum = 0u; cnt = 0u; mine = 0u;
#pragma unroll
        for (unsigned j = 0; j < 16; ++j) { const unsigned c = xb_ld(&bar[XB_XCNT(j)]); sum += c; cnt += (c > 0u) ? 1u : 0u; mine = (j == x) ? c : mine; }
        if (sum == G) break;
        __builtin_amdgcn_s_sleep(1);
        if ((++sp & 255u) == 0u) { if (xb_ld(&bar[XB_TMO])) break; if (sp > XB_SPIN_CAP) { atomicAdd(&bar[XB_TMO], 1u); break; } }
    }
    nloc = mine > 0u ? mine : 1u; nx = cnt > 0u ? cnt : 1u;
}

__device__ __forceinline__ void xcd_barrier(const XcdBarrier& b) {
    asm volatile("s_waitcnt vmcnt(0)" ::: "memory");
    __syncthreads();
    if (threadIdx.x == 0) {
        unsigned* bar = b.bar;
        __builtin_amdgcn_s_waitcnt(0);
        unsigned nloc = b.st[0], nx = b.st[1];
        if (nloc == 0u) { xcd_barrier_complete(bar, b.x, nloc, nx); b.st[0] = nloc; b.st[1] = nx; }
        const unsigned old = xb_add(&bar[XB_XSUB(b.x)], 1u);
        const unsigned gen = old / nloc;
        if (old + 1u == (gen + 1u) * nloc) {
            __builtin_amdgcn_fence(__ATOMIC_RELEASE, "agent");
            asm volatile("s_waitcnt vmcnt(0)" ::: "memory");
            const unsigned og = xb_add(&bar[XB_TOP], 1u);
            const unsigned tg = og / nx;
            if (og + 1u == (tg + 1u) * nx) xb_add(&bar[XB_TOPGEN], 1u);
            else XB_SPIN(xb_ld(&bar[XB_TOPGEN]) == tg, bar);
            __builtin_amdgcn_fence(__ATOMIC_ACQUIRE, "agent");
            xb_add(&bar[XB_XGEN(b.x)], 1u);
            asm volatile("s_waitcnt vmcnt(0)" ::: "memory");
        } else {
            XB_SPIN(xb_ld(&bar[XB_XGEN(b.x)]) == gen, bar);
            __builtin_amdgcn_fence(__ATOMIC_ACQUIRE, "agent");
            asm volatile("s_waitcnt vmcnt(0)" ::: "memory");
        }
    }
    __syncthreads();
}

constexpr size_t WS_BAR = 1 * MiB;
constexpr size_t WS_SDONE = WS_BAR + 16384;
constexpr int LDS_BARST = 147456 - 16;

struct Args { const float* in[24]; float* out; unsigned char* ws; int cg_sync; int pad; };

struct Frame {
    LAS unsigned char* lds;
    int wave, vcu, G;
    const float* x; const float* c; const float* w_ada; const float* b_ada; const float* norm_g; const float* w_in; const float* qg; const float* kg;
    const float *lq1, *lk1, *lq2, *lk2; const float* hg;
    const float *a_re, *a_im, *log_dt, *b_re, *b_im, *c_re, *c_im, *dsk; const float* w_glu; const float* b_glu; const float* w_out;
    float* out;
    float* MOD; float* MODP; float* HGS; f32x2v* A16; f32x2v* A128; float* ROPE;
    bf16 *WIN, *WGLU, *WOUT, *TT, *WS, *WOT, *Q, *K, *V, *GA, *GS, *MIX, *XN, *GY, *UC;
};

__device__ __forceinline__ void p0_transpose_item(const float* W, int K, int N, bf16* WT, int k0, int src_n0, int dst_n0, LAS float* scr, int lane) {
#pragma unroll 8
    for (int i = 0; i < 32; ++i) { const int kk = 2 * i + (lane >> 5); scr[kk * 33 + (lane & 31)] = W[(size_t)(k0 + kk) * N + src_n0 + (lane & 31)]; }
    LDS_WAIT(); asm volatile("" ::: "memory");
    const int c = lane & 7;
#pragma unroll
    for (int j = 0; j < 4; ++j) { const int n = (lane >> 3) + 8 * j; const LAS float* s = scr + (8 * c) * 33 + n;
        v4u o; o.x = pk2(s[0 * 33], s[1 * 33]); o.y = pk2(s[2 * 33], s[3 * 33]); o.z = pk2(s[4 * 33], s[5 * 33]); o.w = pk2(s[6 * 33], s[7 * 33]);
        *(v4u*)(WT + (size_t)(dst_n0 + n) * K + k0 + 8 * c) = o; }
    LDS_WAIT(); asm volatile("" ::: "memory");
}
__device__ __forceinline__ int win_src_col(int n) {
    const int tt = n >> 10, w = n & 1023;
    if (tt >= 2) return n;
    const int p4 = w >> 8, bj = (w >> 7) & 1, wc = (w >> 5) & 3, j = w & 31;
    return tt * 1024 + (p4 * 4 + wc) * 64 + bj * 32 + j;
}
__device__ __forceinline__ void cpow_lambda(double ar, double ai, double dt, double j, float& re, float& im) {
    const double mag = exp(ar * dt * j);
    double rev = ai * dt * j * 0.15915494309189535; rev -= rint(rev);
    const float ang = (float)(rev * 6.283185307179586);
    re = (float)mag * cosf(ang); im = (float)mag * sinf(ang);
}

__device__ __forceinline__ void p0_ssm_tables(Frame& F, int g, int pt) {
    LAS float* Apr = (LAS float*)(F.lds);
    LAS float* Api = Apr + 17 * 64;
    LAS float* Bbr = Api + 17 * 64;
    LAS float* Bbi = Bbr + 1024;
    LAS float* Cr = Bbi + 1024;
    LAS float* Ci = Cr + 1024;
    LAS float* Kj = Ci + 1024;
    LAS float* Fr = Kj + 4096;
    LAS float* Fi = Fr + 64;
    const int tid = (F.wave * 64 + lane_id());
    const double dt = exp((double)F.log_dt[g]);
    for (int idx = tid; idx < 17 * 64; idx += 512) { const int p = idx & 63, j = idx >> 6; float re, im;
        cpow_lambda((double)F.a_re[g * 64 + p], (double)F.a_im[g * 64 + p], dt, (double)j, re, im); Apr[idx] = re; Api[idx] = im; }
    if (tid < 64) { const int p = tid; const double ar = (double)F.a_re[g * 64 + p], ai = (double)F.a_im[g * 64 + p];
        const double mag = exp(ar * dt); double rev = ai * dt * 0.15915494309189535; rev -= rint(rev); const double ang = rev * 6.283185307179586;
        const double abr = mag * (double)cosf((float)ang), abi = mag * (double)sinf((float)ang);
        const double nr = abr - 1.0, ni = abi, den = ar * ar + ai * ai;
        Fr[p] = (float)((nr * ar + ni * ai) / den); Fi[p] = (float)((ni * ar - nr * ai) / den);
        float re, im; cpow_lambda(ar, ai, dt, 16.0, re, im); F.A16[g * 64 + p] = (f32x2v){re, im};
        cpow_lambda(ar, ai, dt, 128.0, re, im); F.A128[g * 64 + p] = (f32x2v){re, im}; }
    for (int idx = tid; idx < 1024; idx += 512) { Cr[idx] = F.c_re[g * 1024 + idx]; Ci[idx] = F.c_im[g * 1024 + idx]; }
    __syncthreads();
    for (int idx = tid; idx < 1024; idx += 512) { const int p = idx >> 4; const float br = F.b_re[g * 1024 + idx], bi = F.b_im[g * 1024 + idx];
        Bbr[idx] = Fr[p] * br - Fi[p] * bi; Bbi[idx] = Fr[p] * bi + Fi[p] * br; }
    __syncthreads();
    for (int idx0 = tid; idx0 < 1024; idx0 += 512) { const int j = idx0 >> 6, ho = 4 * pt + ((idx0 >> 4) & 3), hi = idx0 & 15, idx = (j * 16 + ho) * 16 + hi; float s = 0.f;
        for (int p = 0; p < 64; ++p) { const float cr = Cr[ho * 64 + p], ci = Ci[ho * 64 + p], ar = Apr[j * 64 + p], ai = Api[j * 64 + p];
            const float car = cr * ar - ci * ai, cai = cr * ai + ci * ar; s += car * Bbr[p * 16 + hi] - cai * Bbi[p * 16 + hi]; }
        Kj[idx] = s; }
    __syncthreads();
    bf16* TTg = F.TT + (size_t)g * 65536; bf16* WSg = F.WS + (size_t)g * 32768; bf16* WOg = F.WOT + (size_t)g * 32768;
    for (int idx = tid; idx < 64 * 32; idx += 512) { const int ri = idx >> 5, t = ri >> 2, ho = 4 * pt + (ri & 3), n = t * 16 + ho, k0 = (idx & 31) * 8, s = k0 >> 4, hi0 = k0 & 15;
        const float dv = F.dsk[g * 16 + ho]; float v[8];
#pragma unroll
        for (int e = 0; e < 8; ++e) { const int hi = hi0 + e; float xv = (s <= t) ? Kj[((t - s) * 16 + ho) * 16 + hi] : 0.f; if (s == t && hi == ho) xv += dv; v[e] = xv; }
        v4u o; o.x = pk2(v[0], v[1]); o.y = pk2(v[2], v[3]); o.z = pk2(v[4], v[5]); o.w = pk2(v[6], v[7]);
        *(v4u*)(TTg + ((((n >> 5) * 16 + (k0 >> 4)) * 64) + ((k0 >> 3) & 1) * 32 + (n & 31)) * 8) = o; }
    for (int idx = tid; idx < 32 * 32; idx += 512) { const int n = 32 * pt + (idx >> 5), p = n >> 1, c = n & 1, k0 = (idx & 31) * 8, s = k0 >> 4, hi0 = k0 & 15, j = 15 - s;
        const float ar = Apr[j * 64 + p], ai = Api[j * 64 + p]; float v[8];
#pragma unroll
        for (int e = 0; e < 8; ++e) { const float br = Bbr[p * 16 + hi0 + e], bi = Bbi[p * 16 + hi0 + e]; v[e] = (c == 0) ? (ar * br - ai * bi) : (ar * bi + ai * br); }
        v4u o; o.x = pk2(v[0], v[1]); o.y = pk2(v[2], v[3]); o.z = pk2(v[4], v[5]); o.w = pk2(v[6], v[7]);
        *(v4u*)(WSg + ((((n >> 5) * 16 + (k0 >> 4)) * 64) + ((k0 >> 3) & 1) * 32 + (n & 31)) * 8) = o; }
    for (int idx = tid; idx < 64 * 16; idx += 512) { const int ri = idx >> 4, t = ri >> 2, ho = 4 * pt + (ri & 3), n = t * 16 + ho, k0 = (idx & 15) * 8, p0 = k0 >> 1, j = t + 1; float v[8];
#pragma unroll
        for (int q = 0; q < 4; ++q) { const int p = p0 + q; const float cr = Cr[ho * 64 + p], ci = Ci[ho * 64 + p], ar = Apr[j * 64 + p], ai = Api[j * 64 + p];
            v[2 * q] = cr * ar - ci * ai; v[2 * q + 1] = -(cr * ai + ci * ar); }
        v4u o; o.x = pk2(v[0], v[1]); o.y = pk2(v[2], v[3]); o.z = pk2(v[4], v[5]); o.w = pk2(v[6], v[7]);
        *(v4u*)(WOg + ((((n >> 5) * 8 + (k0 >> 4)) * 64) + ((k0 >> 3) & 1) * 32 + (n & 31)) * 8) = o; }
    __syncthreads();
}

__device__ __forceinline__ void p0_gemv(Frame& F) {
    const int gw = F.vcu * NWAVES + F.wave, NGW = F.G * NWAVES;
    for (int it = gw; it < 8 * 48; it += NGW) {
        const int kc = it / 48, cc = it % 48, kq = lane_id() >> 4, col = cc * 64 + (lane_id() & 15) * 4;
        f32x4 a0 = {0.f, 0.f, 0.f, 0.f}, a1 = a0, a2 = a0, a3 = a0;
#pragma unroll 8
        for (int kk = 0; kk < 32; ++kk) { const int k = kc * 128 + kq * 32 + kk; const f32x4 w = *(const f32x4*)(F.w_ada + (size_t)k * 3072 + col);
            a0 += w * pg8::silu_f(F.c[k]); a1 += w * pg8::silu_f(F.c[1024 + k]); a2 += w * pg8::silu_f(F.c[2048 + k]); a3 += w * pg8::silu_f(F.c[3072 + k]); }
#pragma unroll
        for (int e = 0; e < 4; ++e) { a0[e] += __shfl_xor(a0[e], 16); a0[e] += __shfl_xor(a0[e], 32); a1[e] += __shfl_xor(a1[e], 16); a1[e] += __shfl_xor(a1[e], 32);
            a2[e] += __shfl_xor(a2[e], 16); a2[e] += __shfl_xor(a2[e], 32); a3[e] += __shfl_xor(a3[e], 16); a3[e] += __shfl_xor(a3[e], 32); }
        if (kq == 0) { float* pp = F.MODP + (size_t)kc * 12288 + col; *(f32x4*)(pp) = a0; *(f32x4*)(pp + 3072) = a1; *(f32x4*)(pp + 6144) = a2; *(f32x4*)(pp + 9216) = a3; }
    }
}
__device__ __forceinline__ void p0_rest(Frame& F) {
    for (int u = F.vcu; u < 4 * NGRP; u += F.G) p0_ssm_tables(F, u >> 2, u & 3);
    __syncthreads();
    LAS float* scr = (LAS float*)(F.lds + RING_OFF + F.wave * 16384);
    const int gw = F.vcu * NWAVES + F.wave, NGW = F.G * NWAVES;
    if (F.vcu == 0 && F.wave == 0) { const int l_ = lane_id(); F.HGS[l_] = F.hg[l_] * (1.0f - LAM_INIT); F.HGS[64 + l_] = F.hg[64 + l_] * (1.0f - LAM_INIT); }
    for (int idx = (F.vcu * NWAVES + F.wave) * 64 + lane_id(); idx < 8192 * 32; idx += F.G * 512) {
        const int pos = idx >> 5, i = idx & 31;
        const float inv = 1.0f / powf(10000.0f, (float)(2 * i) / 64.0f);
        const float angf = (float)pos * inv;
        double rev = (double)angf * 0.15915494309189535; rev -= rint(rev);
        const float a = (float)(rev * 6.283185307179586);
        F.ROPE[idx] = cosf(a); F.ROPE[8192 * 32 + idx] = sinf(a);
    }
    constexpr int I_IN = 16 * 192, I_GLU = 16 * 32, I_OUT = 32 * 32;
    for (int it = gw; it < I_IN + I_GLU + I_OUT; it += NGW) {
        int r = it;
        if (r < I_IN) { const int kb = r / 192, nb = r % 192; p0_transpose_item(F.w_in, 1024, NPROJ, F.WIN, 64 * kb, win_src_col(32 * nb), 32 * nb, scr, lane_id()); continue; } r -= I_IN;
        if (r < I_GLU) { const int kb = r / 32, nb = r % 32; p0_transpose_item(F.w_glu, 1024, 1024, F.WGLU, 64 * kb, 32 * nb, 32 * nb, scr, lane_id()); continue; } r -= I_GLU;
        { const int kb = r / 32, nb = r % 32; p0_transpose_item(F.w_out, 2048, 1024, F.WOUT, 64 * kb, 32 * nb, 32 * nb, scr, lane_id()); }
    }
}

__device__ __forceinline__ void p0b_rows(Frame& F) {
    LAS float* modl = (LAS float*)(F.lds);
    for (int q = (F.wave * 64 + lane_id()); q < 3072; q += 512) { const int b = q / 768, c4 = (q % 768) * 4;
        f32x4 v = *(const f32x4*)(F.b_ada + c4);
#pragma unroll
        for (int kc = 0; kc < 8; ++kc) v += *(const f32x4*)(F.MODP + (size_t)kc * 12288 + b * 3072 + c4);
        *(LAS f32x4*)(modl + b * 3072 + c4) = v;
        if (F.vcu == 0) *(f32x4*)(F.MOD + b * 3072 + c4) = v; }
    __syncthreads();
    const int gw = F.vcu * NWAVES + F.wave, NGW = F.G * NWAVES;
    for (int blk = gw; blk < M / 16; blk += NGW) {
        const int m0 = blk * 16, b = m0 >> 13;
        f32x4 g[4], sh[4], sc[4];
#pragma unroll
        for (int j = 0; j < 4; ++j) { const int col = 4 * lane_id() + 256 * j; g[j] = *(const f32x4*)(F.norm_g + col);
            sh[j] = *(const LAS f32x4*)(modl + b * 3072 + col); sc[j] = *(const LAS f32x4*)(modl + b * 3072 + 1024 + col) + 1.0f; g[j] = g[j] * sc[j]; }
        f32x4 v[4], nx[4];
        { const f32x4* xr = (const f32x4*)(F.x + (size_t)m0 * DM) + lane_id();
#pragma unroll
          for (int j = 0; j < 4; ++j) nx[j] = __builtin_nontemporal_load(xr + 64 * j); }
        for (int i = 0; i < 16; ++i) {
            const int m = m0 + i; float s = 0.f;
#pragma unroll
            for (int j = 0; j < 4; ++j) { v[j] = nx[j]; s += (v[j].x * v[j].x + v[j].y * v[j].y) + (v[j].z * v[j].z + v[j].w * v[j].w); }
            if (i + 1 < 16) { const f32x4* xr = (const f32x4*)(F.x + (size_t)(m + 1) * DM) + lane_id();
#pragma unroll
                for (int j = 0; j < 4; ++j) nx[j] = __builtin_nontemporal_load(xr + 64 * j); }
            const float rstd = __builtin_amdgcn_rsqf(wave_sum(s) * (1.0f / DM) + NORM_EPS);
            unsigned long long* o8 = (unsigned long long*)(F.XN + (size_t)m * DM) + lane_id();
#pragma unroll
            for (int j = 0; j < 4; ++j) { const f32x4 h = v[j] * rstd * g[j] + sh[j];
                o8[64 * j] = (unsigned long long)pk2(h.x, h.y) | ((unsigned long long)pk2(h.z, h.w) << 32); }
        }
    }
    __syncthreads();
}

__device__ __forceinline__ int crow16(int r, int hi) { return (r & 3) + 8 * (r >> 2) + 4 * hi; }
constexpr int SSM_UB = 0, SSM_UBB = 33792, SSM_HL = 67584, SSM_HP = 100352, SSM_EX = 117760;
static_assert(SSM_EX + 4096 <= RING_BYTES, "SSM LDS map");
__device__ __forceinline__ void ssm_unit(Frame& F, int b, int g) {
    LAS float* HL = (LAS float*)(F.lds + SSM_HL);
    LAS bf16* YT = (LAS bf16*)(F.lds + SSM_HL);
    LAS bf16* HP = (LAS bf16*)(F.lds + SSM_HP);
    LAS float* EX = (LAS float*)(F.lds + SSM_EX);
    const bf16* Uc = F.UC + (size_t)(b * 64 + g) * 8192 * 16;
    const bf16* TTg = F.TT + (size_t)g * 65536; const bf16* WSg = F.WS + (size_t)g * 32768; const bf16* WOg = F.WOT + (size_t)g * 32768;
    bf16* GYb = F.GY + (size_t)b * SEQ * DM + g * 16;
    const int tid = (F.wave * 64 + lane_id()), lane = lane_id(), w = F.wave, r = lane & 31, h = lane >> 5;
    const f32x2v a16 = F.A16[g * 64 + lane], a128 = F.A128[g * 64 + lane];
    float car = 0.f, cai = 0.f;
    bf16x8 wsf[16];
    { const bf16* wf0 = WSg + (size_t)((w & 3) * 16) * 512 + lane * 8;
#pragma unroll
      for (int j = 0; j < 16; ++j) wsf[j] = *(const bf16x8*)(wf0 + j * 512); }
    v4u pre[4];
#pragma unroll
    for (int i = 0; i < 4; ++i) pre[i] = *(const v4u*)(Uc + (size_t)(tid + i * 512) * 8);
#pragma unroll
    for (int i = 0; i < 4; ++i) { const int q = tid + i * 512; *(LAS v4u*)(F.lds + SSM_UB + (q >> 5) * 528 + (q & 31) * 16) = pre[i]; }
    for (int seg = 0; seg < 8; ++seg) {
        LAS unsigned char* UB = F.lds + SSM_UB + (seg & 1) * SSM_UBB;
        if (seg + 1 < 8) {
#pragma unroll
            for (int i = 0; i < 4; ++i) pre[i] = *(const v4u*)(Uc + (size_t)(seg + 1) * 16384 + (size_t)(tid + i * 512) * 8);
        }
        __syncthreads();
        {
            const int mb = w >> 2, nb = w & 3;
            f32x16 acc0 = {}, acc1 = {};
            const bf16* wf = WSg + (size_t)(nb * 16) * 512 + lane * 8;
            const LAS unsigned char* ua = UB + (mb * 32 + r) * 528 + h * 16;
#pragma unroll
            for (int j = 0; j < 16; j += 2) {
                const bf16x8 a0 = *(const LAS bf16x8*)(ua + j * 32), a1 = *(const LAS bf16x8*)(ua + j * 32 + 32);
                acc0 = __builtin_amdgcn_mfma_f32_32x32x16_bf16(a0, wsf[j], acc0, 0, 0, 0);
                acc1 = __builtin_amdgcn_mfma_f32_32x32x16_bf16(a1, wsf[j + 1], acc1, 0, 0, 0);
            }
#pragma unroll
            for (int i = 0; i < 16; ++i) HL[(mb * 32 + crow16(i, h)) * 128 + nb * 32 + r] = acc0[i] + acc1[i];
        }
        __syncthreads();
        {
            const int c0 = w * 8; float er = 0.f, ei = 0.f;
#pragma unroll
            for (int i = 0; i < 8; ++i) { const f32x2v hl = *(const LAS f32x2v*)(HL + (c0 + i) * 128 + 2 * lane);
                const float nr = a16.x * er - a16.y * ei + hl.x, ni = a16.x * ei + a16.y * er + hl.y; er = nr; ei = ni; }
            *(LAS f32x2v*)(EX + (w * 64 + lane) * 2) = (f32x2v){er, ei};
            __syncthreads();
            float hr = car, hi_ = cai, ir = 0.f, ii = 0.f;
#pragma unroll
            for (int v = 0; v < 8; ++v) { if (v == w) { ir = hr; ii = hi_; }
                const f32x2v e = *(const LAS f32x2v*)(EX + (v * 64 + lane) * 2);
                const float nr = a128.x * hr - a128.y * hi_ + e.x, ni = a128.x * hi_ + a128.y * hr + e.y; hr = nr; hi_ = ni; }
            car = hr; cai = hi_;
            hr = ir; hi_ = ii;
#pragma unroll
            for (int i = 0; i < 8; ++i) { *(LAS unsigned*)(HP + (c0 + i) * 136 + 2 * lane) = pg8::cvt_pk_bf16(hr, hi_);
                const f32x2v hl = *(const LAS f32x2v*)(HL + (c0 + i) * 128 + 2 * lane);
                const float nr = a16.x * hr - a16.y * hi_ + hl.x, ni = a16.x * hi_ + a16.y * hr + hl.y; hr = nr; hi_ = ni; }
        }
        if (seg + 1 < 8) {
#pragma unroll
            for (int i = 0; i < 4; ++i) { const int q = tid + i * 512; *(LAS v4u*)(F.lds + SSM_UB + ((seg + 1) & 1) * SSM_UBB + (q >> 5) * 528 + (q & 31) * 16) = pre[i]; }
        }
        __syncthreads();
        {
            const bf16* tf = TTg + (size_t)(w * 16) * 512 + lane * 8; const bf16* of = WOg + (size_t)(w * 8) * 512 + lane * 8;
            const LAS unsigned char* ua = UB + r * 528 + h * 16;
            const LAS bf16* hp = HP + r * 136 + 8 * h;
            f32x16 acc0 = {}, acc1 = {};
#pragma unroll
            for (int kb = 0; kb < 16; kb += 8) {
                bf16x8 bq[8];
#pragma unroll
                for (int j = 0; j < 8; ++j) bq[j] = *(const bf16x8*)(tf + (kb + j) * 512);
                asm volatile("" ::: "memory");
#pragma unroll
                for (int j = 0; j < 8; ++j) {
                    const bf16x8 a0 = *(const LAS bf16x8*)(ua + (kb + j) * 32), a1 = *(const LAS bf16x8*)(ua + 32 * 528 + (kb + j) * 32);
                    acc0 = __builtin_amdgcn_mfma_f32_32x32x16_bf16(a0, bq[j], acc0, 0, 0, 0);
                    acc1 = __builtin_amdgcn_mfma_f32_32x32x16_bf16(a1, bq[j], acc1, 0, 0, 0); }
            }
            {
                bf16x8 bq[8];
#pragma unroll
                for (int j = 0; j < 8; ++j) bq[j] = *(const bf16x8*)(of + j * 512);
                asm volatile("" ::: "memory");
#pragma unroll
                for (int j = 0; j < 8; ++j) {
                    const bf16x8 a0 = *(const LAS bf16x8*)(hp + j * 16), a1 = *(const LAS bf16x8*)(hp + 32 * 136 + j * 16);
                    acc0 = __builtin_amdgcn_mfma_f32_32x32x16_bf16(a0, bq[j], acc0, 0, 0, 0);
                    acc1 = __builtin_amdgcn_mfma_f32_32x32x16_bf16(a1, bq[j], acc1, 0, 0, 0); }
            }
#pragma unroll
            for (int i = 0; i < 16; ++i) { const int cl = crow16(i, h);
                const unsigned pk = pg8::cvt_pk_bf16(pg8::gelu_tanh_f(acc0[i]), pg8::gelu_tanh_f(acc1[i]));
                YT[cl * 256 + 32 * w + r] = (bf16)(pk & 0xffffu); YT[(32 + cl) * 256 + 32 * w + r] = (bf16)(pk >> 16); }
        }
        __syncthreads();
#pragma unroll
        for (int i = 0; i < 4; ++i) { const int q = tid + i * 512; const v4u v = *(const LAS v4u*)(F.lds + SSM_HL + q * 16);
            *(v4u*)(GYb + (size_t)(seg * 1024 + (q >> 1)) * DM + (q & 1) * 8) = v; }
    }
    __syncthreads();
}

__global__ void __launch_bounds__(NWAVES * 64, 2) hybrid_fwd(Args args) {
    extern __shared__ __attribute__((aligned(16))) unsigned char lds[];
    cg::grid_group grid = cg::this_grid();
    Frame F;
    F.lds = (LAS unsigned char*)lds;
    F.wave = __builtin_amdgcn_readfirstlane((int)threadIdx.x >> 6);
    F.G = gridDim.x; { const int bx = blockIdx.x; F.vcu = (F.G % 8 == 0) ? (bx % 8) * (F.G / 8) + bx / 8 : bx; }
    unsigned char* ws = args.ws;
    F.x = args.in[0]; F.c = args.in[1]; F.w_ada = args.in[2]; F.b_ada = args.in[3]; F.norm_g = args.in[4]; F.w_in = args.in[5]; F.qg = args.in[6]; F.kg = args.in[7];
    F.lq1 = args.in[8]; F.lk1 = args.in[9]; F.lq2 = args.in[10]; F.lk2 = args.in[11]; F.hg = args.in[12];
    F.a_re = args.in[13]; F.a_im = args.in[14]; F.log_dt = args.in[15]; F.b_re = args.in[16]; F.b_im = args.in[17]; F.c_re = args.in[18]; F.c_im = args.in[19]; F.dsk = args.in[20];
    F.w_glu = args.in[21]; F.b_glu = args.in[22]; F.w_out = args.in[23]; F.out = args.out;
    F.MOD = (float*)(ws + WS_MOD); F.A16 = (f32x2v*)(ws + WS_A16); F.A128 = (f32x2v*)(ws + WS_A128); F.MODP = (float*)(ws + WS_MODP); F.HGS = (float*)(ws + WS_HGS); F.ROPE = (float*)(ws + WS_ROPE);
    F.WIN = (bf16*)(ws + WS_WIN); F.WGLU = (bf16*)(ws + WS_WGLU); F.WOUT = (bf16*)(ws + WS_WOUT); F.TT = (bf16*)(ws + WS_TT); F.WS = (bf16*)(ws + WS_WS); F.WOT = (bf16*)(ws + WS_WOT);
    F.Q = (bf16*)(ws + WS_Q); F.K = (bf16*)(ws + WS_K); F.V = (bf16*)(ws + WS_V); F.GA = (bf16*)(ws + WS_GA); F.GS = (bf16*)(ws + WS_GS); F.MIX = (bf16*)(ws + WS_MIX);
    F.XN = (bf16*)args.out; F.GY = (bf16*)args.out; F.UC = (bf16*)((unsigned char*)args.out + 64 * MiB);

    unsigned* barw = (unsigned*)(ws + WS_BAR);
    if (threadIdx.x < 2) ((volatile LAS unsigned*)(F.lds + LDS_BARST))[threadIdx.x] = 0u;
    __syncthreads();
    const XcdBarrier bar = xcd_barrier_post(barw, (volatile LAS unsigned*)(F.lds + LDS_BARST));
    p0_gemv(F);
    if (args.cg_sync) grid.sync();
    xcd_barrier(bar);
    p0b_rows(F);
    p0_rest(F);
    xcd_barrier(bar);
    {
        pg8::Gemm g{F.XN, F.WIN, M, NPROJ, DM}; pg8::StaticOrder S; S.init(M, NPROJ, F.G, (int)blockIdx.x);
        pg8::EpiProj E{F.Q, F.K, F.V, F.GA, F.GS, F.UC, F.ROPE, F.ROPE + 8192 * 32, F.qg, F.kg};
        pg8::gemm_phase<pg8::EpiProj, pg8::StaticOrder, true, true>(F.lds + RING_OFF, g, S, E, F.wave);
    }
    xcd_barrier(bar);
    unsigned* sdone = (unsigned*)(ws + WS_SDONE);
    for (int u = F.vcu; u < BATCH * NGRP; u += F.G) {
        ssm_unit(F, u & 3, u >> 2);
        asm volatile("s_waitcnt vmcnt(0)" ::: "memory");
        __syncthreads();
        if (threadIdx.x == 0) { __builtin_amdgcn_fence(__ATOMIC_RELEASE, "agent"); asm volatile("s_waitcnt vmcnt(0)" ::: "memory"); (void)xb_add(sdone, 1u); }
    }
    {
        const int ln_ = lane_id();
        const float s1_ = wave_sum(F.lq1[ln_] * F.lk1[ln_]), s2_ = wave_sum(F.lq2[ln_] * F.lk2[ln_]);
        const float lam_ = __expf(s1_) - __expf(s2_) + LAM_INIT;
        const attn_body::AttnTensors AT{(const attn_body::bf16*)F.Q, (const attn_body::bf16*)F.K, (const attn_body::bf16*)F.V, (attn_body::bf16*)F.MIX, (const attn_body::bf16*)F.GA, F.HGS, lam_};
        const attn_body::AttnOrder S((int)F.G, F.vcu);
        attn_body::attn_phase<attn_body::AttnOrder>((char*)lds + RING_OFF, AT, S, F.wave);
    }
    if (threadIdx.x == 0) {
        unsigned sp_ = 0u;
        while (xb_ld(sdone) < (unsigned)(BATCH * NGRP)) { __builtin_amdgcn_s_sleep(2); if (++sp_ > (1u << 22)) break; }
        __builtin_amdgcn_fence(__ATOMIC_ACQUIRE, "agent");
        asm volatile("s_waitcnt vmcnt(0)" ::: "memory");
    }
    __syncthreads();
    {
        pg8::Gemm g{F.GY, F.WGLU, M, DM, DM}; pg8::StaticOrder S; S.init(M, DM, F.G, (int)blockIdx.x);
        pg8::EpiGlu E{F.GY, F.GS, F.b_glu, F.MIX};
        pg8::gemm_phase<pg8::EpiGlu, pg8::StaticOrder, true, true>(F.lds + RING_OFF, g, S, E, F.wave);
    }
    xcd_barrier(bar);
    {
        pg8::Gemm g{F.MIX, F.WOUT, M, DM, MIXW}; pg8::StaticOrder S; S.init(M, DM, F.G, (int)blockIdx.x);
        pg8::EpiOut E{F.x, F.MOD, F.out};
        pg8::gemm_phase<pg8::EpiOut, pg8::StaticOrder, true, true>(F.lds + RING_OFF, g, S, E, F.wave);
    }
}

extern "C" void kernel_launch(void* const* d_in, const int* in_sizes, int n_in, void* d_out, int out_size, void* d_ws, size_t ws_size, hipStream_t stream) {
    static int grid = 0;
    if (grid == 0) {
        if (n_in != 24 || out_size != M * DM || ws_size < WS_END) { fprintf(stderr, "kernel_launch: unexpected shapes (n_in %d out %d ws %zu); nothing launched\n", n_in, out_size, ws_size); grid = -1; return; }
        int dev = 0, cus = 0, per_cu = 0;
        if (hipGetDevice(&dev) != hipSuccess || hipDeviceGetAttribute(&cus, hipDeviceAttributeMultiprocessorCount, dev) != hipSuccess) { grid = -1; return; }
        if (hipFuncSetAttribute((const void*)hybrid_fwd, hipFuncAttributeMaxDynamicSharedMemorySize, LDS_BYTES) != hipSuccess) { fprintf(stderr, "kernel_launch: hipFuncSetAttribute failed\n"); grid = -1; return; }
        if (hipOccupancyMaxActiveBlocksPerMultiprocessor(&per_cu, (const void*)hybrid_fwd, NWAVES * 64, LDS_BYTES) != hipSuccess || per_cu < 1) { fprintf(stderr, "kernel_launch: occupancy query says %d blocks per CU\n", per_cu); per_cu = 1; }
        (void)hipGetLastError();
        grid = cus * 1;
        fprintf(stderr, "kernel_launch: grid %d (per_cu query %d), ws %zu\n", grid, per_cu, ws_size);
    }
    if (grid < 0) return;
    if (hipMemsetAsync((char*)d_ws + WS_BAR, 0, 16384 + 256, stream) != hipSuccess) { fprintf(stderr, "kernel_launch: hipMemsetAsync of the barrier words failed; nothing launched\n"); return; }
    Args a{};
    for (int i = 0; i < 24; ++i) a.in[i] = (const float*)d_in[i];
    a.out = (float*)d_out; a.ws = (unsigned char*)d_ws;
    void* kargs[] = {&a};
    const hipError_t e = hipLaunchCooperativeKernel((const void*)hybrid_fwd, dim3(grid), dim3(NWAVES * 64), kargs, LDS_BYTES, stream);
    if (e != hipSuccess) fprintf(stderr, "kernel_launch: cooperative launch failed: %s (grid %d)\n", hipGetErrorString(e), grid);
}
```

```cpp
#include <hip/hip_runtime.h>
#include <hip/hip_cooperative_groups.h>
#include <cstdio>
#include <cstdint>
namespace cg = cooperative_groups;
__device__ __forceinline__ int lane_id() { int t = (int)threadIdx.x; asm volatile("" : "+v"(t)); return t & 63; }
namespace pg8 {
#define PG8_LAS __attribute__((address_space(3)))
typedef unsigned short bf16_t;
typedef short bf16x8 __attribute__((ext_vector_type(8)));
typedef float f32x4 __attribute__((ext_vector_type(4)));
typedef unsigned u32x4 __attribute__((ext_vector_type(4)));
constexpr int BM = 256, BK = 64, HALF = 128, HTB = HALF * BK * 2  , STAGE_BYTES = 8 * HTB, NXCD = 8, WGM = 8;

__host__ __device__ __forceinline__ int lds_byte(int r, int c) { const int st = (r >> 4) * 2 + (c >> 5), rr = r & 15, cc = c & 31, ob = rr * 64 + cc * 2; return st * 1024 + (ob ^ (((ob >> 9) & 1) << 5)); }
__host__ __device__ __forceinline__ void stage_rc(int b, int& R, int& C) { const int st = b / 1024, sb = b % 1024, swz = sb ^ (((sb >> 9) & 1) << 5); R = (st >> 1) * 16 + swz / 64; C = (st & 1) * 32 + (swz % 64) / 2; }
__host__ __device__ __forceinline__ int perm32(int rho) { const int n = rho >> 4, i = rho & 15; return 8 * (i >> 2) + 4 * n + (i & 3); }

struct Unit { int pm, pn; };
struct Gemm { const bf16_t* A; const bf16_t* Bt; int M, N, K; };

struct StaticOrder {
    int nM, nN, nwg, G, c;
    __host__ __device__ void init(int M, int N, int G_, int c_) { nM = M / BM; nN = N / BM; nwg = nM * nN; G = G_; c = c_; }
    __host__ __device__ bool next(int i, Unit& u) const {
        const long L = (long)i * G + c; if (L >= nwg) return false;
        int wgid = (int)L; { const int q = nwg / NXCD, r = nwg % NXCD, xcd = wgid % NXCD, off = wgid / NXCD; wgid = (xcd < r ? xcd * (q + 1) : r * (q + 1) + (xcd - r) * q) + off; }
        const int nig = WGM * nN, gid = wgid / nig, fm = gid * WGM, gsz = (nM - fm) < WGM ? (nM - fm) : WGM;
        u.pm = fm + ((wgid % nig) % gsz); u.pn = (wgid % nig) / gsz; return true;
    }
    __device__ __forceinline__ void a_ready(const Unit&) const {}
    __device__ __forceinline__ void done(const Unit&) const {}
};

__device__ __forceinline__ unsigned cvt_pk_bf16(float lo, float hi) { unsigned r; asm volatile("v_cvt_pk_bf16_f32 %0, %1, %2" : "=v"(r) : "v"(lo), "v"(hi)); return r; }
typedef float f32x2 __attribute__((ext_vector_type(2)));
__device__ __forceinline__ float sigmoid_f(float x) { return __builtin_amdgcn_rcpf(1.0f + __expf(-x)); }
__device__ __forceinline__ float silu_f(float x) { return x * sigmoid_f(x); }
__device__ __forceinline__ float gelu_tanh_f(float y) { const float t = y * y; const float p = __builtin_fmaf(t, -0.10294324f, -2.3022082f);
    return y * __builtin_amdgcn_rcpf(1.0f + __builtin_amdgcn_exp2f(y * p)); }
__device__ __forceinline__ float bf_lo(unsigned w) { return __builtin_bit_cast(float, w << 16); }
__device__ __forceinline__ float bf_hi(unsigned w) { return __builtin_bit_cast(float, w & 0xffff0000u); }
constexpr float QSCALE = 0.125f * 1.4426950408889634f;

struct EpiProj {
    static constexpr bool PERM = true, AFTER_DRAIN = false;
    bf16_t *Q, *K, *V, *GA, *GS, *UC; const float* rope_cos; const float* rope_sin; const float* qg; const float* kg;
    __device__ __forceinline__ void operator()(const f32x4 (&acc)[2][2][4][2], const Unit& u, int wr, int wc, int fr, int fq) const {
        const int tt = u.pn >> 2, p4 = u.pn & 3;
        const int row0 = u.pm * BM + wr * 64 + fr;
        if (tt < 2) {
            const float* gw = (tt == 0) ? qg : kg; bf16_t* dst = (tt == 0) ? Q : K; const float sc = (tt == 0) ? QSCALE : 1.0f;
            f32x4 gv[2][2];
#pragma unroll
            for (int bj = 0; bj < 2; ++bj)
#pragma unroll
                for (int n = 0; n < 2; ++n) gv[bj][n] = *(const f32x4*)(gw + bj * 32 + 8 * fq + 4 * n) * sc;
            const int hm = p4 * 4 + wc;
#pragma unroll
            for (int ai = 0; ai < 2; ++ai)
#pragma unroll
                for (int m = 0; m < 4; ++m) {
                    const int row = row0 + ai * HALF + m * 16; const int s = row & 8191;
                    f32x4 v[2][2]; float ss = 0.f;
#pragma unroll
                    for (int bj = 0; bj < 2; ++bj)
#pragma unroll
                        for (int n = 0; n < 2; ++n) { v[bj][n] = acc[ai][bj][m][n]; const f32x4 q = v[bj][n] * v[bj][n]; ss += (q[0] + q[1]) + (q[2] + q[3]); }
                    ss += __shfl_xor(ss, 16); ss += __shfl_xor(ss, 32);
                    const float rs = __builtin_amdgcn_rsqf(ss * (1.0f / 64.0f) + 1e-6f);
                    u32x4 w0, w1;
                    {
                        const f32x4 c0 = *(const f32x4*)(rope_cos + s * 32 + 8 * fq), c1 = *(const f32x4*)(rope_cos + s * 32 + 8 * fq + 4);
                        const f32x4 s0 = *(const f32x4*)(rope_sin + s * 32 + 8 * fq), s1 = *(const f32x4*)(rope_sin + s * 32 + 8 * fq + 4);
                        const f32x4 a0 = v[0][0] * rs * gv[0][0], a1 = v[0][1] * rs * gv[0][1], b0 = v[1][0] * rs * gv[1][0], b1 = v[1][1] * rs * gv[1][1];
                        const f32x4 o10 = a0 * c0 - b0 * s0, o11 = a1 * c1 - b1 * s1, o20 = b0 * c0 + a0 * s0, o21 = b1 * c1 + a1 * s1;
                        w0.x = cvt_pk_bf16(o10[0], o10[1]); w0.y = cvt_pk_bf16(o10[2], o10[3]); w0.z = cvt_pk_bf16(o11[0], o11[1]); w0.w = cvt_pk_bf16(o11[2], o11[3]);
                        w1.x = cvt_pk_bf16(o20[0], o20[1]); w1.y = cvt_pk_bf16(o20[2], o20[3]); w1.z = cvt_pk_bf16(o21[0], o21[1]); w1.w = cvt_pk_bf16(o21[2], o21[3]);
                    }
                    bf16_t* rp = dst + (size_t)row * 1024 + hm * 64 + 8 * fq;
                    *(u32x4*)(rp) = w0; *(u32x4*)(rp + 32) = w1;
                }
        } else {
#pragma unroll
            for (int ai = 0; ai < 2; ++ai)
#pragma unroll
                for (int m = 0; m < 4; ++m) {
                    const int row = row0 + ai * HALF + m * 16;
#pragma unroll
                    for (int bj = 0; bj < 2; ++bj) {
                        f32x4 v0 = acc[ai][bj][m][0], v1 = acc[ai][bj][m][1];
                        const int col = p4 * 256 + bj * HALF + wc * 32 + 8 * fq;
                        if (tt == 3 || tt == 5) {
#pragma unroll
                            for (int e = 0; e < 4; ++e) { v0[e] = silu_f(v0[e]); v1[e] = silu_f(v1[e]); }
                        }
                        u32x4 w; w.x = cvt_pk_bf16(v0[0], v0[1]); w.y = cvt_pk_bf16(v0[2], v0[3]); w.z = cvt_pk_bf16(v1[0], v1[1]); w.w = cvt_pk_bf16(v1[2], v1[3]);
                        if (tt == 4) {
                            const int b = row >> 13, s = row & 8191, g = col >> 4;
                            *(u32x4*)(UC + ((size_t)(b * 64 + g) * 8192 + s) * 16 + (col & 15)) = w;
                        } else {
                            bf16_t* base = (tt == 2) ? V : (tt == 3) ? GA : GS;
                            *(u32x4*)(base + (size_t)row * 1024 + col) = w;
                        }
                    }
                }
        }
    }
};

struct EpiGlu {
    static constexpr bool PERM = true, AFTER_DRAIN = false;
    const bf16_t* GY; const bf16_t* GS; const float* bias; bf16_t* MIX;
    __device__ __forceinline__ void operator()(const f32x4 (&acc)[2][2][4][2], const Unit& u, int wr, int wc, int fr, int fq) const {
        const int row0 = u.pm * BM + wr * 64 + fr, col0 = u.pn * BM + wc * 32 + 8 * fq;
        f32x4 bv[2][2];
#pragma unroll
        for (int bj = 0; bj < 2; ++bj)
#pragma unroll
            for (int n = 0; n < 2; ++n) bv[bj][n] = *(const f32x4*)(bias + col0 + bj * HALF + 4 * n);
#pragma unroll
        for (int ai = 0; ai < 2; ++ai)
#pragma unroll
            for (int m = 0; m < 4; ++m) {
                const int row = row0 + ai * HALF + m * 16;
#pragma unroll
                for (int bj = 0; bj < 2; ++bj) {
                    const int col = col0 + bj * HALF;
                    const u32x4 gy = *(const u32x4*)(GY + (size_t)row * 1024 + col), gs = *(const u32x4*)(GS + (size_t)row * 1024 + col);
                    const f32x4 v0 = acc[ai][bj][m][0] + bv[bj][0], v1 = acc[ai][bj][m][1] + bv[bj][1];
                    u32x4 w;
                    w.x = cvt_pk_bf16(bf_lo(gy.x) * sigmoid_f(v0[0]) * bf_lo(gs.x), bf_hi(gy.x) * sigmoid_f(v0[1]) * bf_hi(gs.x));
                    w.y = cvt_pk_bf16(bf_lo(gy.y) * sigmoid_f(v0[2]) * bf_lo(gs.y), bf_hi(gy.y) * sigmoid_f(v0[3]) * bf_hi(gs.y));
                    w.z = cvt_pk_bf16(bf_lo(gy.z) * sigmoid_f(v1[0]) * bf_lo(gs.z), bf_hi(gy.z) * sigmoid_f(v1[1]) * bf_hi(gs.z));
                    w.w = cvt_pk_bf16(bf_lo(gy.w) * sigmoid_f(v1[2]) * bf_lo(gs.w), bf_hi(gy.w) * sigmoid_f(v1[3]) * bf_hi(gs.w));
                    *(u32x4*)(MIX + (size_t)row * 2048 + 1024 + col) = w;
                }
            }
    }
};

struct EpiOut {
    static constexpr bool PERM = true, AFTER_DRAIN = false;
    const float* x; const float* mod; float* out;
    __device__ __forceinline__ void operator()(const f32x4 (&acc)[2][2][4][2], const Unit& u, int wr, int wc, int fr, int fq) const {
        const int row0 = u.pm * BM + wr * 64 + fr, col0 = u.pn * BM + wc * 32 + 8 * fq;
        const int b = (u.pm * BM) >> 13;
        f32x4 gv[2][2];
#pragma unroll
        for (int bj = 0; bj < 2; ++bj)
#pragma unroll
            for (int n = 0; n < 2; ++n) gv[bj][n] = *(const f32x4*)(mod + b * 3072 + 2048 + col0 + bj * HALF + 4 * n);
#pragma unroll
        for (int ai = 0; ai < 2; ++ai)
#pragma unroll
            for (int mh = 0; mh < 2; ++mh) {
                f32x4 xv[2][2][2];
#pragma unroll
                for (int mm = 0; mm < 2; ++mm) { const size_t off = (size_t)(row0 + ai * HALF + (2 * mh + mm) * 16) * 1024 + col0;
#pragma unroll
                    for (int bj = 0; bj < 2; ++bj)
#pragma unroll
                        for (int n = 0; n < 2; ++n) xv[mm][bj][n] = __builtin_nontemporal_load((const f32x4*)(x + off + bj * HALF + 4 * n)); }
                asm volatile("" ::: "memory");
#pragma unroll
                for (int mm = 0; mm < 2; ++mm) { const size_t off = (size_t)(row0 + ai * HALF + (2 * mh + mm) * 16) * 1024 + col0;
#pragma unroll
                    for (int bj = 0; bj < 2; ++bj)
#pragma unroll
                        for (int n = 0; n < 2; ++n) *(f32x4*)(out + off + bj * HALF + 4 * n) = xv[mm][bj][n] + gv[bj][n] * acc[ai][bj][2 * mh + mm][n]; }
                asm volatile("" ::: "memory");
            }
    }
};
template <class Epi, class Sched, bool ALIGN_EPI = false, bool SP2 = false>
__device__ __forceinline__ void gemm_phase(PG8_LAS unsigned char* lds, const Gemm g, const Sched& S, const Epi& E, const int wid) {
    const int lane = lane_id(), tid = wid * 64 + lane, wr = wid >> 2, wc = wid & 3, fr = lane & 15, fq = lane >> 4;
    const int K = g.K, nt = K / BK;
    unsigned voffA[2], voffB[2];
#pragma unroll
    for (int i = 0; i < 2; ++i) { int R, C; stage_rc(tid * 16 + i * 8192, R, C); const int Rb = Epi::PERM ? ((R & ~31) + perm32(R & 31)) : R;
        voffA[i] = (unsigned)(R * K + C) * 2u; voffB[i] = (unsigned)(Rb * K + C) * 2u; }
    const size_t kstep = (size_t)(BK * 2);
    const size_t hstep = (size_t)HALF * K * 2;
    const size_t tstep = 2 * hstep;
    const unsigned ldsw = (unsigned)wid * 1024u;
    const int aoff = lds_byte(wr * 64 + fr, fq * 8), boff = lds_byte(wc * 32 + fr, fq * 8);
#define PG8_SA(b, h) (((b) * 2 + (h)) * HTB)
#define PG8_SB(b, h) ((4 + (b) * 2 + (h)) * HTB)
#define PG8_STAGE(bufoff, gbase, voff) do { _Pragma("unroll") for (int _i = 0; _i < 2; ++_i) \
        __builtin_amdgcn_global_load_lds((const unsigned*)((const char*)(gbase) + (voff)[_i]), (PG8_LAS unsigned*)(lds + (bufoff) + ldsw + _i * 8192), 16, 0, 0); } while (0)
#define PG8_LDA(dst, b, h) do { _Pragma("unroll") for (int m = 0; m < 4; ++m) _Pragma("unroll") for (int k = 0; k < 2; ++k) dst[m][k] = *(const PG8_LAS bf16x8*)(lds + PG8_SA(b, h) + aoff + m * 2048 + k * 1024); } while (0)
#define PG8_LDB(dst, b, h) do { _Pragma("unroll") for (int n = 0; n < 2; ++n) _Pragma("unroll") for (int k = 0; k < 2; ++k) dst[n][k] = *(const PG8_LAS bf16x8*)(lds + PG8_SB(b, h) + boff + n * 2048 + k * 1024); } while (0)
#define PG8_MMA(ai, bj, At, Bt) do { __builtin_amdgcn_s_setprio(1); _Pragma("unroll") for (int m = 0; m < 4; ++m) _Pragma("unroll") for (int n = 0; n < 2; ++n) _Pragma("unroll") for (int k = 0; k < 2; ++k) \
        acc[ai][bj][m][n] = __builtin_amdgcn_mfma_f32_16x16x32_bf16(Bt[n][k], At[m][k], acc[ai][bj][m][n], 0, 0, 0); __builtin_amdgcn_s_setprio(0); } while (0)
#define PG8_WAIT_V(n) asm volatile("s_waitcnt vmcnt(" #n ")" ::: "memory")
#define PG8_WAIT_L(n) asm volatile("s_waitcnt lgkmcnt(" #n ")" ::: "memory")
#define PG8_BAR __builtin_amdgcn_s_barrier()
#define PG8_SCHED __builtin_amdgcn_sched_barrier(0)
    Unit cur, nxt; int ui = 0;
    if (!S.next(0, cur)) return;
    f32x4 acc[2][2][4][2];
#pragma unroll
    for (int a = 0; a < 2; ++a)
#pragma unroll
        for (int b = 0; b < 2; ++b)
#pragma unroll
            for (int m = 0; m < 4; ++m)
#pragma unroll
                for (int n = 0; n < 2; ++n) acc[a][b][m][n] = (f32x4){0.f, 0.f, 0.f, 0.f};
    bf16x8 At[4][2], B0[2][2], B1[2][2];
    const char* cA = (const char*)g.A + (size_t)cur.pm * tstep; const char* cB = (const char*)g.Bt + (size_t)cur.pn * tstep;
    S.a_ready(cur);
    if constexpr (SP2) {
        PG8_STAGE(PG8_SB(0, 0), cB, voffB); PG8_STAGE(PG8_SB(0, 1), cB + hstep, voffB); PG8_STAGE(PG8_SA(0, 0), cA, voffA); PG8_STAGE(PG8_SA(0, 1), cA + hstep, voffA);
        if (wr == 1) PG8_BAR;
        PG8_WAIT_V(2); PG8_BAR;
        PG8_STAGE(PG8_SB(1, 0), cB + kstep, voffB); PG8_STAGE(PG8_SA(1, 0), cA + kstep, voffA); PG8_STAGE(PG8_SB(1, 1), cB + hstep + kstep, voffB);
        PG8_WAIT_V(6); PG8_BAR;
    } else {
        PG8_STAGE(PG8_SB(0, 0), cB, voffB); PG8_STAGE(PG8_SA(0, 0), cA, voffA); PG8_STAGE(PG8_SB(0, 1), cB + hstep, voffB); PG8_STAGE(PG8_SA(0, 1), cA + hstep, voffA);
        if (wr == 1) PG8_BAR;
        PG8_WAIT_V(4); PG8_BAR;
        PG8_STAGE(PG8_SB(1, 0), cB + kstep, voffB); PG8_STAGE(PG8_SA(1, 0), cA + kstep, voffA); PG8_STAGE(PG8_SB(1, 1), cB + hstep + kstep, voffB);
        PG8_WAIT_V(6); PG8_BAR;
    }
    for (;;) {
        const bool has_next = S.next(ui + 1, nxt);
        const char* nA = has_next ? (const char*)g.A + (size_t)nxt.pm * tstep : cA; const char* nB = has_next ? (const char*)g.Bt + (size_t)nxt.pn * tstep : cB;
        for (int t = 0; t < nt; t += 2) {
            const bool last = (t == nt - 2);
            const char* a1 = cA + (size_t)(t + 1) * kstep;
            const char* a2 = last ? nA : cA + (size_t)(t + 2) * kstep; const char* b2 = last ? nB : cB + (size_t)(t + 2) * kstep;
            const char* a3 = a2 + kstep; const char* b3 = b2 + kstep;
            if (last && has_next) S.a_ready(nxt);
            if constexpr (SP2) {
            PG8_LDB(B0, 0, 0); PG8_LDB(B1, 0, 1); PG8_SCHED; PG8_LDA(At, 0, 0); PG8_STAGE(PG8_SA(1, 1), a1 + hstep, voffA);
            PG8_WAIT_V(8); PG8_WAIT_L(0); PG8_BAR; PG8_MMA(0, 0, At, B0); PG8_MMA(0, 1, At, B1); PG8_BAR; PG8_SCHED;
            PG8_LDA(At, 0, 1); PG8_STAGE(PG8_SB(0, 0), b2, voffB); PG8_STAGE(PG8_SB(0, 1), b2 + hstep, voffB); PG8_STAGE(PG8_SA(0, 0), a2, voffA);
            PG8_WAIT_V(8); PG8_WAIT_L(0); PG8_BAR; PG8_MMA(1, 0, At, B0); PG8_MMA(1, 1, At, B1); PG8_BAR; PG8_SCHED;
            PG8_LDB(B0, 1, 0); PG8_LDB(B1, 1, 1); PG8_SCHED; PG8_LDA(At, 1, 0); PG8_STAGE(PG8_SA(0, 1), a2 + hstep, voffA);
            PG8_WAIT_V(8); PG8_WAIT_L(0); PG8_BAR; PG8_MMA(0, 0, At, B0); PG8_MMA(0, 1, At, B1); PG8_BAR; PG8_SCHED;
            PG8_LDA(At, 1, 1); PG8_STAGE(PG8_SB(1, 0), b3, voffB); PG8_STAGE(PG8_SB(1, 1), b3 + hstep, voffB); PG8_STAGE(PG8_SA(1, 0), a3, voffA);
            PG8_WAIT_V(8); PG8_WAIT_L(0); PG8_BAR; PG8_MMA(1, 0, At, B0); PG8_MMA(1, 1, At, B1); PG8_BAR; PG8_SCHED;
            } else {
            PG8_LDB(B0, 0, 0); PG8_SCHED; PG8_LDA(At, 0, 0); PG8_STAGE(PG8_SA(1, 1), a1 + hstep, voffA);
            PG8_WAIT_L(8); PG8_BAR; PG8_WAIT_L(0); PG8_MMA(0, 0, At, B0); PG8_BAR; PG8_SCHED;
            PG8_LDB(B1, 0, 1); PG8_STAGE(PG8_SB(0, 0), b2, voffB);
            PG8_BAR; PG8_WAIT_L(0); PG8_MMA(0, 1, At, B1); PG8_BAR;
            PG8_LDA(At, 0, 1); PG8_STAGE(PG8_SA(0, 0), a2, voffA);
            PG8_BAR; PG8_WAIT_L(0); PG8_MMA(1, 0, At, B0); PG8_BAR; PG8_SCHED;
            PG8_STAGE(PG8_SB(0, 1), b2 + hstep, voffB);
            PG8_WAIT_V(6); PG8_BAR; PG8_MMA(1, 1, At, B1); PG8_BAR;
            PG8_LDB(B0, 1, 0); PG8_SCHED; PG8_LDA(At, 1, 0); PG8_STAGE(PG8_SA(0, 1), a2 + hstep, voffA);
            PG8_WAIT_L(8); PG8_BAR; PG8_WAIT_L(0); PG8_MMA(0, 0, At, B0); PG8_BAR; PG8_SCHED;
            PG8_LDB(B1, 1, 1); PG8_STAGE(PG8_SB(1, 0), b3, voffB);
            PG8_BAR; PG8_WAIT_L(0); PG8_MMA(0, 1, At, B1); PG8_BAR;
            PG8_LDA(At, 1, 1); PG8_STAGE(PG8_SA(1, 0), a3, voffA);
            PG8_BAR; PG8_WAIT_L(0); PG8_MMA(1, 0, At, B0); PG8_BAR; PG8_SCHED;
            PG8_STAGE(PG8_SB(1, 1), b3 + hstep, voffB);
            PG8_WAIT_V(6); PG8_BAR; PG8_MMA(1, 1, At, B1); PG8_BAR;
            }
        }
        if constexpr (ALIGN_EPI) { if (wr == 0) PG8_BAR; }
        if constexpr (!Epi::AFTER_DRAIN) { E(acc, cur, wr, wc, fr, fq); S.done(cur); }
        if (!has_next) break;
#pragma unroll
        for (int a = 0; a < 2; ++a)
#pragma unroll
            for (int b = 0; b < 2; ++b)
#pragma unroll
                for (int m = 0; m < 4; ++m)
#pragma unroll
                    for (int n = 0; n < 2; ++n) acc[a][b][m][n] = (f32x4){0.f, 0.f, 0.f, 0.f};
        cur = nxt; cA = nA; cB = nB; ++ui;
        if constexpr (ALIGN_EPI) { if (wr == 1) PG8_BAR; }
    }
    PG8_WAIT_V(0);
    if constexpr (!ALIGN_EPI) { if (wr == 0) PG8_BAR; }
    PG8_BAR;
    if constexpr (Epi::AFTER_DRAIN) { E.fused(acc, cur, wr, wc, fr, fq, lds, wid, lane); S.done(cur); }
#undef PG8_SA
#undef PG8_SB
#undef PG8_STAGE
#undef PG8_LDA
#undef PG8_LDB
#undef PG8_MMA
#undef PG8_WAIT_V
#undef PG8_WAIT_L
#undef PG8_BAR
#undef PG8_SCHED
}
}
#include <hip/hip_bf16.h>
#include <cmath>
namespace attn_body {
using bf16=__hip_bfloat16;
using bf16x8=__attribute__((ext_vector_type(8)))short;
using s16x4=__attribute__((ext_vector_type(4)))short;
using f32x16=__attribute__((ext_vector_type(16)))float;
using u32x4=__attribute__((ext_vector_type(4)))unsigned;
constexpr int BATCH=4,NHEAD=16,SEQ=8192,D=64,DM=NHEAD*D,OP=2048;
constexpr int NW=8,QBLK=32,QB=QBLK*NW,KVBLK=64,NQB=SEQ/QB;
constexpr int ATTN_PITCH=DM, ATTN_UNIT_ROWS=QB;
__device__ __forceinline__ int crow(int r,int hi){return (r&3)+8*(r>>2)+4*hi;}
#define SBAR() __builtin_amdgcn_sched_barrier(0)
__device__ __forceinline__ void cmask(f32x16&p0,f32x16&p1,int jb,int qrel,int hi){
  const float NEG=-INFINITY; (void)hi;
  if(jb>(qrel>>6)){
  #pragma unroll
  for(int r=0;r<16;++r){p0[r]=NEG;p1[r]=NEG;}}
}

constexpr int NSLOT=3, SLOTB=8192, SLOTV=16384;
constexpr int LDS_K=0, LDS_V=NSLOT*SLOTB, LDS_WS=LDS_V+NSLOT*SLOTV, LDS_OST=LDS_WS+NW*64*4, LDS_BYTES=LDS_OST+NW*4096;
constexpr float C2=0.125f*1.4426950408889634f;
__device__ __forceinline__ void glds16(const void*gsrc,unsigned lds_dst){unsigned keep;
  asm volatile("s_mov_b32 %0, m0\n\ts_mov_b32 m0, %2\n\ts_nop 0\n\tglobal_load_lds_dwordx4 %1, off\n\ts_mov_b32 m0, %0":"=&s"(keep):"v"(gsrc),"s"(lds_dst):"memory");}
__device__ __forceinline__ float max3f(float a,float b,float c){float r;asm("v_max3_f32 %0, %1, %2, %3":"=v"(r):"v"(a),"v"(b),"v"(c));return r;}
__device__ __forceinline__ float max2f(float a,float b){float r;asm("v_max_f32_e32 %0, %1, %2":"=v"(r):"v"(a),"v"(b));return r;}
__device__ __forceinline__ float fadd_s(float a,float b){float r;asm("v_add_f32_e32 %0, %1, %2":"=v"(r):"v"(a),"v"(b));return r;}
__device__ __forceinline__ float fsub_s(float a,float b){float r;asm("v_sub_f32_e32 %0, %1, %2":"=v"(r):"v"(a),"v"(b));return r;}
typedef float f32x2_t __attribute__((ext_vector_type(2))); typedef __bf16 bf16x2_t __attribute__((ext_vector_type(2)));
__device__ __forceinline__ unsigned cvtpk_s(float lo,float hi){f32x2_t v={lo,hi};bf16x2_t b=__builtin_convertvector(v,bf16x2_t);return __builtin_bit_cast(unsigned,b);}
#define WAIT_BAR(N) asm volatile("s_waitcnt vmcnt(" #N ") lgkmcnt(0)\n\ts_barrier":::"memory")

__device__ __forceinline__ void qkt(f32x16&p0,f32x16&p1,const char*Kslot,const bf16x8*qr,int r32,int hi){
  const f32x16 zero16={};
  const char*kb=Kslot+hi*1024+r32*16;
  #pragma unroll
  for(int d0=0;d0<4;++d0){
    const bf16x8 b0=*reinterpret_cast<const bf16x8*>(kb+d0*2048);
    const bf16x8 b1=*reinterpret_cast<const bf16x8*>(kb+d0*2048+512);
    if(d0==0){p0=__builtin_amdgcn_mfma_f32_32x32x16_bf16(b0,qr[0],zero16,0,0,0);p1=__builtin_amdgcn_mfma_f32_32x32x16_bf16(b1,qr[0],zero16,0,0,0);}
    else{p0=__builtin_amdgcn_mfma_f32_32x32x16_bf16(b0,qr[d0],p0,0,0,0);p1=__builtin_amdgcn_mfma_f32_32x32x16_bf16(b1,qr[d0],p1,0,0,0);}}
}
typedef __attribute__((address_space(3))) const char* lds_cptr;
typedef short v4i16_t __attribute__((ext_vector_type(4)));
__device__ __forceinline__ void kload8(bf16x8*kf,lds_cptr kp){
  kf[0]=*(const __attribute__((address_space(3))) bf16x8*)(kp);      kf[1]=*(const __attribute__((address_space(3))) bf16x8*)(kp+512);
  kf[2]=*(const __attribute__((address_space(3))) bf16x8*)(kp+2048); kf[3]=*(const __attribute__((address_space(3))) bf16x8*)(kp+2560);
  kf[4]=*(const __attribute__((address_space(3))) bf16x8*)(kp+4096); kf[5]=*(const __attribute__((address_space(3))) bf16x8*)(kp+4608);
  kf[6]=*(const __attribute__((address_space(3))) bf16x8*)(kp+6144); kf[7]=*(const __attribute__((address_space(3))) bf16x8*)(kp+6656);
}
__device__ __forceinline__ void kload2(bf16x8*kf,lds_cptr kp,int j){ kf[2*j]=*(const __attribute__((address_space(3))) bf16x8*)(kp+j*2048); kf[2*j+1]=*(const __attribute__((address_space(3))) bf16x8*)(kp+j*2048+512); }
__device__ __forceinline__ s16x4 vtr(lds_cptr p){ return __builtin_bit_cast(s16x4,__builtin_amdgcn_ds_read_tr16_b64_v4i16((__attribute__((address_space(3))) v4i16_t*)p)); }
__device__ __forceinline__ float rowmax(const f32x16&p0,const f32x16&p1){
  float a=max3f(p0[0],p0[1],p1[0]),b=max3f(p0[2],p0[3],p1[1]);a=max3f(a,p1[2],p1[3]);
  #pragma unroll
  for(int r=4;r<16;r+=4){a=max3f(a,p0[r],p0[r+1]);b=max3f(b,p0[r+2],p0[r+3]);a=max3f(a,p1[r],p1[r+1]);b=max3f(b,p1[r+2],p1[r+3]);}
  const float m=max2f(a,b);
  auto rr=__builtin_amdgcn_permlane32_swap(__float_as_uint(m),__float_as_uint(m),false,false);
  return max2f(__uint_as_float(rr[0]),__uint_as_float(rr[1]));
}
__device__ __forceinline__ void pv(f32x16*o,int vb,bf16x8 pa0,bf16x8 pa1,bf16x8 pa2,bf16x8 pa3){
  #pragma unroll
  for(int d0=0;d0<4;++d0){s16x4 lo[4],hi[4];
    #pragma unroll
    for(int ks=0;ks<4;++ks){
      asm volatile("ds_read_b64_tr_b16 %0,%1 offset:%c2":"=&v"(lo[ks]):"v"(vb),"i"(d0*4096+ks*1024):"memory");
      asm volatile("ds_read_b64_tr_b16 %0,%1 offset:%c2":"=&v"(hi[ks]):"v"(vb),"i"(d0*4096+ks*1024+512):"memory");}
    asm volatile("s_waitcnt lgkmcnt(0)":::"memory");SBAR();
    #define PK(k) (bf16x8){lo[k][0],lo[k][1],lo[k][2],lo[k][3],hi[k][0],hi[k][1],hi[k][2],hi[k][3]}
    o[d0]=__builtin_amdgcn_mfma_f32_32x32x16_bf16(pa0,PK(0),o[d0],0,0,0);
    o[d0]=__builtin_amdgcn_mfma_f32_32x32x16_bf16(pa1,PK(1),o[d0],0,0,0);
    o[d0]=__builtin_amdgcn_mfma_f32_32x32x16_bf16(pa2,PK(2),o[d0],0,0,0);
    o[d0]=__builtin_amdgcn_mfma_f32_32x32x16_bf16(pa3,PK(3),o[d0],0,0,0);
    #undef PK
  }
}

#ifndef ATTN_STORE16
#define ATTN_STORE16(p,v) (*(u32x4*)(p)=(v))
#endif
template<int THRL> __device__ __forceinline__ void attn_unit(int b,int h,int qb,const bf16*__restrict__ Q,const bf16*__restrict__ K,const bf16*__restrict__ V,bf16* O,const bf16*__restrict__ GA,const float*__restrict__ hg,const float lam,char*shm,const int wid){
  const int lane=lane_id(),r32=lane&31,hi=lane>>5;
  const long rowbase=(long)b*SEQ; const int q0=qb*QB;
  const bf16*Qw=Q+(rowbase+q0+wid*QBLK)*DM+h*D;
  const bf16*Kh=K+rowbase*DM+h*D,*Vh=V+rowbase*DM+(h>>1)*128;
  const unsigned lds0=(unsigned)(uintptr_t)shm;
  float*wsf=(float*)(shm+LDS_WS)+wid*64;
  const bf16*ksrc=Kh+(long)lane*DM+wid*8;
  const bf16*vsrc=Vh+(long)(16*(wid&3)+(lane>>2))*DM+(wid>>2)*32+(lane&3)*8;
  const unsigned kdst=lds0+LDS_K+wid*1024, vdst=lds0+LDS_V+wid*1024;
  #define DMA_K(t,slot) glds16(ksrc+(long)(t)*KVBLK*DM,(unsigned)__builtin_amdgcn_readfirstlane(kdst+(slot)))
  #define DMA_V(t,slot) do{ glds16(vsrc+(long)(t)*KVBLK*DM,(unsigned)__builtin_amdgcn_readfirstlane(vdst+2*(slot))); glds16(vsrc+64+(long)(t)*KVBLK*DM,(unsigned)__builtin_amdgcn_readfirstlane(vdst+8192+2*(slot))); }while(0)
  const int vb0=(int)(lds0+LDS_V)+((lane>>4)&1)*32+(lane&3)*8+(4*hi+((lane&15)>>2))*64;
  const char*Kbase=shm+LDS_K; bf16x8 kf[8];
  const lds_cptr shm3=(lds_cptr)shm; const lds_cptr kp0=shm3+LDS_K+hi*1024+r32*16; const lds_cptr vp0=shm3+LDS_V+((lane>>4)&1)*32+(lane&3)*8+(4*hi+((lane&15)>>2))*64;
  const int NT=(q0+QB)/KVBLK;
  DMA_K(0,0);DMA_V(0,0);DMA_K(1,SLOTB);
  bf16x8 qr[4];
  #pragma unroll
  for(int d0=0;d0<4;++d0)qr[d0]=*reinterpret_cast<const bf16x8*>(&Qw[(long)r32*DM+d0*16+hi*8]);
  float l_reg=0.f;f32x16 o[4];o[0]=f32x16{};o[1]=f32x16{};o[2]=f32x16{};o[3]=f32x16{};const f32x16 zero16={};
  const int qrel=wid*QBLK;
  #define CMASK(P0,P1,t) do{int jb_=(t)-(NT-4); if(jb_>=0)cmask(P0,P1,jb_,qrel,hi);}while(0)
  bool resc=false;
  #define START(P0,P1) do{ resc=false; \
    _Pragma("unroll") for(int r=0;r<16;++r)P0[r]=__builtin_amdgcn_exp2f(P0[r]); }while(0)
  #define RESC() do{ if(resc){ asm volatile("s_waitcnt lgkmcnt(0)":::"memory"); \
      _Pragma("unroll") for(int d_=0;d_<4;++d_) _Pragma("unroll") for(int r=0;r<16;++r)o[d_][r]*=wsf[crow(r,hi)]; } }while(0)
  f32x16 pA0,pA1,pB0,pB1;
  int sl_prev=0,sl_cur=0,sl_next=SLOTB;
  #define ROT() do{sl_prev=sl_cur;sl_cur=sl_next;sl_next=(sl_next==(NSLOT-1)*SLOTB)?0:sl_next+SLOTB;}while(0)
  DMA_K(2,2*SLOTB);
  WAIT_BAR(3);
  qkt(pA0,pA1,Kbase,qr,r32,hi);asm volatile("s_nop 15\n\ts_nop 7":"+v"(pA0),"+v"(pA1));CMASK(pA0,pA1,0);
  START(pA0,pA1);
  _Pragma("unroll") for(int r=0;r<16;++r)pA1[r]=__builtin_amdgcn_exp2f(pA1[r]);
  WAIT_BAR(0);
  DMA_K(3,0);DMA_V(1,SLOTB);
  ROT();
  kload8(kf,kp0+sl_cur);
  WAIT_BAR(3);
  s16x4 vlo[8],vhi[8]; u32x4 pw0,pw1,pw2,pw3;
  #define PKW(P,B) cvtpk_s(P[B],P[B+1])
  #define PAF(k) __builtin_bit_cast(bf16x8,pw##k)
  #define VFR(i) (bf16x8){vlo[i][0],vlo[i][1],vlo[i][2],vlo[i][3],vhi[i][0],vhi[i][1],vhi[i][2],vhi[i][3]}
  #define PIN(x) asm volatile("":"+v"(x))
  #define MX3(a,b,c) __builtin_fmaxf(__builtin_fmaxf((a),(b)),(c))
  #define GAPA(MF,A0,A1,A2,A3,W0,W1,PW) do{ MF; sacc+=A0; sacc+=A1; sacc+=A2; sacc+=A3; PIN(sacc); W0; W1; PIN(PW); SBAR(); }while(0)
  #define EX(v) __builtin_amdgcn_exp2f(v)
  #define GAPB(MF,RL,X,B) do{ MF; RL; X[B]=EX(X[B]); X[B+1]=EX(X[B+1]); PIN(X); SBAR(); }while(0)
  #define VRD(i) do{ vlo[i]=vtr(vp_+(((i)>>2)*4096+((i)&3)*1024)); vhi[i]=vtr(vp_+(((i)>>2)*4096+((i)&3)*1024+512)); }while(0)
  #define VRD2(i) do{ vlo[i]=vtr(vp_+((((i)>>2)+2)*4096+((i)&3)*1024)); vhi[i]=vtr(vp_+((((i)>>2)+2)*4096+((i)&3)*1024+512)); }while(0)
  #define KRD(G,j) do{ if(G){ kload2(kf,kp0+sl_next,j); SBAR(); } }while(0)
  #define STEP(C0,C1,P0,P1,t,GK,GV,GL) do{ SBAR(); \
    const lds_cptr vp_=vp0+2*sl_prev; \
    VRD(0); SBAR(); float sacc=(P0[0]+P0[1]); \
    GAPA(C0=__builtin_amdgcn_mfma_f32_32x32x16_bf16(kf[0],qr[0],zero16,0,0,0), P0[2],P0[3],P0[4],P0[5],     pw0[0]=PKW(P0,0), pw0[1]=PKW(P0,2), pw0); \
    VRD(4); SBAR(); GAPA(C1=__builtin_amdgcn_mfma_f32_32x32x16_bf16(kf[1],qr[0],zero16,0,0,0), P0[6],P0[7],P0[8],P0[9],     pw0[2]=PKW(P0,4), pw0[3]=PKW(P0,6), pw0); \
    VRD(1); SBAR(); GAPA(C0=__builtin_amdgcn_mfma_f32_32x32x16_bf16(kf[2],qr[1],C0,0,0,0),   P0[10],P0[11],P0[12],P0[13], pw1[0]=PKW(P0,8), pw1[1]=PKW(P0,10), pw1); \
    VRD(5); SBAR(); GAPA(C1=__builtin_amdgcn_mfma_f32_32x32x16_bf16(kf[3],qr[1],C1,0,0,0),   P0[14],P0[15],P1[0],P1[1],   pw1[2]=PKW(P0,12),pw1[3]=PKW(P0,14), pw1); \
    VRD(2); SBAR(); GAPA(C0=__builtin_amdgcn_mfma_f32_32x32x16_bf16(kf[4],qr[2],C0,0,0,0),   P1[2],P1[3],P1[4],P1[5],     pw2[0]=PKW(P1,0), pw2[1]=PKW(P1,2), pw2); \
    VRD(6); SBAR(); GAPA(C1=__builtin_amdgcn_mfma_f32_32x32x16_bf16(kf[5],qr[2],C1,0,0,0),   P1[6],P1[7],P1[8],P1[9],     pw2[2]=PKW(P1,4), pw2[3]=PKW(P1,6), pw2); \
    VRD(3); SBAR(); GAPA(C0=__builtin_amdgcn_mfma_f32_32x32x16_bf16(kf[6],qr[3],C0,0,0,0),   P1[10],P1[11],P1[12],P1[13], pw3[0]=PKW(P1,8), pw3[1]=PKW(P1,10), pw3); \
    VRD(7); SBAR(); GAPA(C1=__builtin_amdgcn_mfma_f32_32x32x16_bf16(kf[7],qr[3],C1,0,0,0),   P1[14],P1[15],0.f,0.f,       pw3[2]=PKW(P1,12),pw3[3]=PKW(P1,14), pw3); \
    l_reg+=sacc; \
    if(GK){DMA_K((t)+3,sl_cur);} if(GV){DMA_V((t)+1,sl_next);} \
    CMASK(C0,C1,t); \
    SBAR(); \
    GAPB(o[0]=__builtin_amdgcn_mfma_f32_32x32x16_bf16(PAF(0),VFR(0),o[0],0,0,0), VRD2(0), C0,0); \
    GAPB(o[1]=__builtin_amdgcn_mfma_f32_32x32x16_bf16(PAF(0),VFR(4),o[1],0,0,0), VRD2(4), C0,2); \
    KRD(GL,0); GAPB(o[0]=__builtin_amdgcn_mfma_f32_32x32x16_bf16(PAF(1),VFR(1),o[0],0,0,0), VRD2(1), C0,4); \
    KRD(GL,1); GAPB(o[1]=__builtin_amdgcn_mfma_f32_32x32x16_bf16(PAF(1),VFR(5),o[1],0,0,0), VRD2(5), C0,6); \
    KRD(GL,2); GAPB(o[0]=__builtin_amdgcn_mfma_f32_32x32x16_bf16(PAF(2),VFR(2),o[0],0,0,0), VRD2(2), C0,8); \
    KRD(GL,3); GAPB(o[1]=__builtin_amdgcn_mfma_f32_32x32x16_bf16(PAF(2),VFR(6),o[1],0,0,0), VRD2(6), C0,10); \
    GAPB(o[0]=__builtin_amdgcn_mfma_f32_32x32x16_bf16(PAF(3),VFR(3),o[0],0,0,0), VRD2(3), C0,12); \
    GAPB(o[1]=__builtin_amdgcn_mfma_f32_32x32x16_bf16(PAF(3),VFR(7),o[1],0,0,0), VRD2(7), C0,14); \
    GAPB(o[2]=__builtin_amdgcn_mfma_f32_32x32x16_bf16(PAF(0),VFR(0),o[2],0,0,0), (void)0, C1,0); \
    GAPB(o[3]=__builtin_amdgcn_mfma_f32_32x32x16_bf16(PAF(0),VFR(4),o[3],0,0,0), (void)0, C1,2); \
    GAPB(o[2]=__builtin_amdgcn_mfma_f32_32x32x16_bf16(PAF(1),VFR(1),o[2],0,0,0), (void)0, C1,4); \
    GAPB(o[3]=__builtin_amdgcn_mfma_f32_32x32x16_bf16(PAF(1),VFR(5),o[3],0,0,0), (void)0, C1,6); \
    GAPB(o[2]=__builtin_amdgcn_mfma_f32_32x32x16_bf16(PAF(2),VFR(2),o[2],0,0,0), (void)0, C1,8); \
    GAPB(o[3]=__builtin_amdgcn_mfma_f32_32x32x16_bf16(PAF(2),VFR(6),o[3],0,0,0), (void)0, C1,10); \
    GAPB(o[2]=__builtin_amdgcn_mfma_f32_32x32x16_bf16(PAF(3),VFR(3),o[2],0,0,0), (void)0, C1,12); \
    GAPB(o[3]=__builtin_amdgcn_mfma_f32_32x32x16_bf16(PAF(3),VFR(7),o[3],0,0,0), (void)0, C1,14); \
    }while(0)
  int t=1;
  #undef CMASK
  #define CMASK(P0,P1,t) do{}while(0)
  for(;t+5<NT;t+=2){
    STEP(pB0,pB1,pA0,pA1,t,true,true,true);     WAIT_BAR(3); RESC(); ROT();
    STEP(pA0,pA1,pB0,pB1,t+1,true,true,true);   WAIT_BAR(3); RESC(); ROT();
  }
  #undef CMASK
  #define CMASK(P0,P1,t) do{int jb_=(t)-(NT-4); if(jb_>=0)cmask(P0,P1,jb_,qrel,hi);}while(0)
  #define ENDW(tt) do{ if((tt)+3<NT){WAIT_BAR(3);} else if((tt)+2<NT){WAIT_BAR(2);} else {WAIT_BAR(0);} }while(0)
  for(;t+1<NT;t+=2){
    STEP(pB0,pB1,pA0,pA1,t,(t+3<NT),(t+1<NT),(t+1<NT));       ENDW(t);   RESC(); ROT();
    STEP(pA0,pA1,pB0,pB1,t+1,(t+4<NT),(t+2<NT),(t+2<NT));     ENDW(t+1); RESC(); ROT();
  }
  STEP(pB0,pB1,pA0,pA1,NT-1,false,false,false); RESC();
  { float sacc=pB0[0]+pB0[1]; _Pragma("unroll") for(int r=2;r<16;++r)sacc+=pB0[r]; _Pragma("unroll") for(int r=0;r<16;++r)sacc+=pB1[r]; l_reg+=sacc;
    pw0=(u32x4){PKW(pB0,0),PKW(pB0,2),PKW(pB0,4),PKW(pB0,6)};pw1=(u32x4){PKW(pB0,8),PKW(pB0,10),PKW(pB0,12),PKW(pB0,14)};pw2=(u32x4){PKW(pB1,0),PKW(pB1,2),PKW(pB1,4),PKW(pB1,6)};pw3=(u32x4){PKW(pB1,8),PKW(pB1,10),PKW(pB1,12),PKW(pB1,14)};
    SBAR(); pv(o,vb0+2*sl_cur,PAF(0),PAF(1),PAF(2),PAF(3)); }
  #undef PKW
  #undef PAF
  #undef VFR
  #undef PIN
  #undef MX3
  #undef GAPA
  #undef GAPB
  #undef EX
  #undef VRD
  #undef KRD
  #undef STEP
  #undef ENDW
  {auto rr=__builtin_amdgcn_permlane32_swap(__float_as_uint(l_reg),__float_as_uint(l_reg),false,false);l_reg=__uint_as_float(rr[0])+__uint_as_float(rr[1]);}
  if(hi==0)wsf[32+r32]=l_reg;asm volatile("s_waitcnt lgkmcnt(0)":::"memory");
  float rli[16];
  #pragma unroll
  for(int r=0;r<16;++r)rli[r]=__builtin_amdgcn_rcpf(wsf[32+crow(r,hi)]);
  const long grow0=rowbase+q0+wid*QBLK;
  bf16*Ow=O+grow0*(long)OP+(h>>1)*128;
  { bf16*stg=(bf16*)(shm+LDS_OST)+wid*2048;
    if((h&1)==0){
    #pragma unroll
    for(int ps=0;ps<2;++ps){
      #pragma unroll
      for(int r=0;r<16;++r){const int orow=crow(r,hi);
        #pragma unroll
        for(int d0=0;d0<2;++d0)stg[orow*64+d0*32+r32]=__float2bfloat16(o[2*ps+d0][r]*rli[r]);}
      asm volatile("s_waitcnt lgkmcnt(0)":::"memory");
      #pragma unroll
      for(int i=0;i<4;++i){const int row=i*8+(lane>>3),ch=lane&7; const u32x4 v=*(const u32x4*)(stg+row*64+ch*8); ATTN_STORE16(Ow+(long)row*OP+ps*64+ch*8,v);}
      asm volatile("s_waitcnt lgkmcnt(0)":::"memory");
    }
    }else{
    float dd[2][4][8]; const int ch=lane&7;
    #pragma unroll
    for(int ps=0;ps<2;++ps){
      #pragma unroll
      for(int r=0;r<16;++r){const int orow=crow(r,hi);
        #pragma unroll
        for(int d0=0;d0<2;++d0)stg[orow*64+d0*32+r32]=__float2bfloat16(o[2*ps+d0][r]*rli[r]);}
      asm volatile("s_waitcnt lgkmcnt(0)":::"memory");
      #pragma unroll
      for(int i=0;i<4;++i){const int row=i*8+(lane>>3); const u32x4 v=*(const u32x4*)(stg+row*64+ch*8); const u32x4 z=*(const u32x4*)(Ow+(long)row*OP+ps*64+ch*8);
        #pragma unroll
        for(int q=0;q<4;++q){ dd[ps][i][2*q]=__builtin_bit_cast(float,z[q]<<16)-lam*__builtin_bit_cast(float,v[q]<<16); dd[ps][i][2*q+1]=__builtin_bit_cast(float,z[q]&0xffff0000u)-lam*__builtin_bit_cast(float,v[q]&0xffff0000u); } }
      asm volatile("s_waitcnt lgkmcnt(0)":::"memory");
    }
    float rs[4];
    #pragma unroll
    for(int i=0;i<4;++i){ float ss=0.f;
      #pragma unroll
      for(int ps=0;ps<2;++ps)
        #pragma unroll
        for(int e=0;e<8;++e)ss+=dd[ps][i][e]*dd[ps][i][e];
      ss+=__shfl_xor(ss,1); ss+=__shfl_xor(ss,2); ss+=__shfl_xor(ss,4);
      rs[i]=__builtin_amdgcn_rsqf(ss*(1.0f/128.0f)+1e-6f); }
    #pragma unroll
    for(int ps=0;ps<2;++ps){ float hgv[8];
      #pragma unroll
      for(int e=0;e<8;++e)hgv[e]=hg[ps*64+ch*8+e];
      #pragma unroll
      for(int i=0;i<4;++i){const int row=i*8+(lane>>3); const u32x4 g=*(const u32x4*)(GA+(grow0+row)*(long)DM+(h>>1)*128+ps*64+ch*8); u32x4 w;
        #pragma unroll
        for(int q=0;q<4;++q) w[q]=cvtpk_s(dd[ps][i][2*q]*rs[i]*hgv[2*q]*__builtin_bit_cast(float,g[q]<<16), dd[ps][i][2*q+1]*rs[i]*hgv[2*q+1]*__builtin_bit_cast(float,g[q]&0xffff0000u));
        ATTN_STORE16(Ow+(long)row*OP+ps*64+ch*8,w); } }
    } }
  asm volatile("s_waitcnt lgkmcnt(0)\n\ts_barrier":::"memory");
  #undef DMA_K
  #undef DMA_V
  #undef CMASK
  #undef START
  #undef RESC
  #undef ROT
}
constexpr int ATTN_LDS_BYTES=LDS_BYTES;
struct AttnTensors { const bf16* Q; const bf16* K; const bf16* V; bf16* O; const bf16* GA; const float* hg; float lam; };
struct AttnUnit { int b, hm, qb; };
struct AttnOrder {
  int vcu, G;
  __device__ __forceinline__ AttnOrder(int grid,int v):vcu(v),G(grid){}
  __device__ __forceinline__ bool next(int i,AttnUnit&u)const{
    int head,qb; const int map=i&1,k=i>>1;
    if(G==256){ if(k>=4)return false; head=vcu>>3; const int sq=vcu&7; qb=(k==0)?sq:(k==1)?15-sq:(k==2)?16+sq:31-sq; }
    else{ const int L=k*G+vcu; if(L>=1024)return false; head=L>>5; qb=31-(L&31); }
    u.b=head>>3; u.hm=2*(head&7)+map; u.qb=qb; return true; }
};
template<class Sched,int THRL=8> __device__ __forceinline__ void attn_phase(char*lds,const AttnTensors&T,const Sched&S,const int wid){
  AttnUnit u;
  for(int i=0;S.next(i,u);++i){ attn_unit<THRL>(u.b,u.hm,u.qb,T.Q,T.K,T.V,T.O,T.GA,T.hg,T.lam,lds,wid); }
}
#undef SBAR
#undef WAIT_BAR
}
constexpr int NWAVES = 8;
constexpr int BATCH = 4, SEQ = 8192, DM = 1024, M = BATCH * SEQ, NPROJ = 6144, MIXW = 2048;
constexpr int NGRP = 64;
constexpr float NORM_EPS = 1e-6f;
constexpr float LAM_INIT = 0.2f;

constexpr size_t MiB = 1u << 20;
constexpr size_t WS_MOD = 0;
constexpr size_t WS_A16 = 256 * 1024;
constexpr size_t WS_A128 = 320 * 1024;
constexpr size_t WS_HGS = 384 * 1024;
constexpr size_t WS_MODP = 512 * 1024;
constexpr size_t WS_WIN = 2 * MiB;
constexpr size_t WS_WGLU = 14 * MiB;
constexpr size_t WS_WOUT = 16 * MiB;
constexpr size_t WS_ROPE = 20 * MiB;
constexpr size_t WS_TT = 22 * MiB;
constexpr size_t WS_WS = 30 * MiB;
constexpr size_t WS_WOT = 34 * MiB;
constexpr size_t WS_Q = 40 * MiB, WS_K = 104 * MiB, WS_V = 168 * MiB, WS_GA = 232 * MiB, WS_GS = 296 * MiB, WS_END = 488 * MiB;
constexpr size_t WS_MIX = 360 * MiB;

constexpr int RING_OFF = 0, RING_BYTES = 131072;
constexpr int LDS_BYTES = 147456;

#define GAS __attribute__((address_space(1)))
#define LAS __attribute__((address_space(3)))
typedef unsigned short bf16;
typedef unsigned v4u __attribute__((ext_vector_type(4)));
typedef unsigned v2u __attribute__((ext_vector_type(2)));
typedef float f32x4 __attribute__((ext_vector_type(4)));
typedef float f32x2v __attribute__((ext_vector_type(2)));
typedef float f32x16 __attribute__((ext_vector_type(16)));
typedef short bf16x8 __attribute__((ext_vector_type(8)));
#define LDS_WAIT() asm volatile("s_waitcnt lgkmcnt(0)" ::: "memory")
__device__ __forceinline__ unsigned f2bf(float f) { unsigned u = __builtin_bit_cast(unsigned, f); return (u + 0x7fffu + ((u >> 16) & 1u)) >> 16; }
__device__ __forceinline__ unsigned pk2(float lo, float hi) { return f2bf(lo) | (f2bf(hi) << 16); }
__device__ __forceinline__ float wave_sum(float v) {
#pragma unroll
    for (int o = 1; o < 64; o <<= 1) v += __shfl_xor(v, o);
    return v;
}

typedef GAS unsigned gu32;
#define XB_TMO      128
#define XB_XCNT(j)  (256  + 64 * (j))
#define XB_XSUB(j)  (1280 + 64 * (j))
#define XB_XGEN(j)  (2304 + 64 * (j))
#define XB_TOP      3328
#define XB_TOPGEN   3392
#define XCD_BAR_WORDS 3456
#define XB_SPIN_CAP (1u << 18)

__device__ __forceinline__ unsigned xb_ld(unsigned* p)              { return __hip_atomic_load(p, __ATOMIC_RELAXED, __HIP_MEMORY_SCOPE_AGENT); }
__device__ __forceinline__ unsigned xb_add(unsigned* p, unsigned v) { return __hip_atomic_fetch_add(p, v, __ATOMIC_RELAXED, __HIP_MEMORY_SCOPE_AGENT); }
__device__ __forceinline__ unsigned xb_xcc_id() { return (unsigned)__builtin_amdgcn_s_getreg((3 << 11) | 20) & 0xFu; }
#define XB_SPIN(cond, bar) do { unsigned _sp = 0; while (cond) { __builtin_amdgcn_s_sleep(1); \
    if ((++_sp & 255u) == 0u) { if (xb_ld(&(bar)[XB_TMO])) break; if (_sp > XB_SPIN_CAP) { atomicAdd(&(bar)[XB_TMO], 1u); break; } } } } while (0)

struct XcdBarrier {
    unsigned* bar; unsigned x;
    volatile LAS unsigned* st;
};

__device__ __forceinline__ XcdBarrier xcd_barrier_post(unsigned* bar, volatile LAS unsigned* st) {
    XcdBarrier b; b.bar = bar; b.x = xb_xcc_id(); b.st = st;
    if (threadIdx.x == 0) (void)xb_add(&bar[XB_XCNT(b.x)], 1u);
    return b;
}
__device__ __forceinline__ void xcd_barrier_complete(unsigned* bar, unsigned x, unsigned& nloc, unsigned& nx) {
    const unsigned G = gridDim.x * gridDim.y * gridDim.z;
    unsigned sum, cnt, mine, sp = 0u;
    for (;;) {
        sum = 0u; cnt = 0u; mine = 0u;
#pragma unroll
        for (unsigned j = 0; j < 16; ++j) { const unsigned c = xb_ld(&bar[XB_XCNT(j)]); sum += c; cnt += (c > 0u) ? 1u : 0u; mine = (j == x) ? c : mine; }
        if (sum == G) break;
        __builtin_amdgcn_s_sleep(1);
        if ((++sp & 255u) == 0u) { if (xb_ld(&bar[XB_TMO])) break; if (sp > XB_SPIN_CAP) { atomicAdd(&bar[XB_TMO], 1u); break; } }
    }
    nloc = mine > 0u ? mine : 1u; nx = cnt > 0u ? cnt : 1u;
}

__device__ __forceinline__ void xcd_barrier(const XcdBarrier& b) {
    asm volatile("s_waitcnt vmcnt(0)" ::: "memory");
    __syncthreads();
    if (threadIdx.x == 0) {
        unsigned* bar = b.bar;
        __builtin_amdgcn_s_waitcnt(0);
        unsigned nloc = b.st[0], nx = b.st[1];
        if (nloc == 0u) { xcd_barrier_complete(bar, b.x, nloc, nx); b.st[0] = nloc; b.st[1] = nx; }
        const unsigned old = xb_add(&bar[XB_XSUB(b.x)], 1u);
        const unsigned gen = old / nloc;
        if (old + 1u == (gen + 1u) * nloc) {
            __builtin_amdgcn_fence(__ATOMIC_RELEASE, "agent");
            asm volatile("s_waitcnt vmcnt(0)" ::: "memory");
            const unsigned og = xb_add(&bar[XB_TOP], 1u);
            const unsigned tg = og / nx;
            if (og + 1u == (tg + 1u) * nx) xb_add(&bar[XB_TOPGEN], 1u);
            else XB_SPIN(xb_ld(&bar[XB_TOPGEN]) == tg, bar);
            __builtin_amdgcn_fence(__ATOMIC_ACQUIRE, "agent");
            xb_add(&bar[XB_XGEN(b.x)], 1u);
            asm volatile("s_waitcnt vmcnt(0)" ::: "memory");
        } else {
            XB_SPIN(xb_ld(&bar[XB_XGEN(b.x)]) == gen, bar);
            __builtin_amdgcn_fence(__ATOMIC_ACQUIRE, "agent");
            asm volatile("s_waitcnt vmcnt(0)" ::: "memory");
        }
    }
    __syncthreads();
}

constexpr size_t WS_BAR = 1 * MiB;
constexpr size_t WS_SDONE = WS_BAR + 16384;
constexpr int LDS_BARST = 147456 - 16;

struct Args { const float* in[24]; float* out; unsigned char* ws; int cg_sync; int pad; };

struct Frame {
    LAS unsigned char* lds;
    int wave, vcu, G;
    const float* x; const float* c; const float* w_ada; const float* b_ada; const float* norm_g; const float* w_in; const float* qg; const float* kg;
    const float *lq1, *lk1, *lq2, *lk2; const float* hg;
    const float *a_re, *a_im, *log_dt, *b_re, *b_im, *c_re, *c_im, *dsk; const float* w_glu; const float* b_glu; const float* w_out;
    float* out;
    float* MOD; float* MODP; float* HGS; f32x2v* A16; f32x2v* A128; float* ROPE;
    bf16 *WIN, *WGLU, *WOUT, *TT, *WS, *WOT, *Q, *K, *V, *GA, *GS, *MIX, *XN, *GY, *UC;
};

__device__ __forceinline__ void p0_transpose_item(const float* W, int K, int N, bf16* WT, int k0, int src_n0, int dst_n0, LAS float* scr, int lane) {
#pragma unroll 8
    for (int i = 0; i < 32; ++i) { const int kk = 2 * i + (lane >> 5); scr[kk * 33 + (lane & 31)] = __builtin_nontemporal_load(W + (size_t)(k0 + kk) * N + src_n0 + (lane & 31)); }
    LDS_WAIT(); asm volatile("" ::: "memory");
    const int c = lane & 7;
#pragma unroll
    for (int j = 0; j < 4; ++j) { const int n = (lane >> 3) + 8 * j; const LAS float* s = scr + (8 * c) * 33 + n;
        v4u o; o.x = pk2(s[0 * 33], s[1 * 33]); o.y = pk2(s[2 * 33], s[3 * 33]); o.z = pk2(s[4 * 33], s[5 * 33]); o.w = pk2(s[6 * 33], s[7 * 33]);
        *(v4u*)(WT + (size_t)(dst_n0 + n) * K + k0 + 8 * c) = o; }
    LDS_WAIT(); asm volatile("" ::: "memory");
}
__device__ __forceinline__ int win_src_col(int n) {
    const int tt = n >> 10, w = n & 1023;
    if (tt >= 2) return n;
    const int p4 = w >> 8, bj = (w >> 7) & 1, wc = (w >> 5) & 3, j = w & 31;
    return tt * 1024 + (p4 * 4 + wc) * 64 + bj * 32 + j;
}
__device__ __forceinline__ void cpow_lambda(double ar, double ai, double dt, double j, float& re, float& im) {
    const double mag = exp(ar * dt * j);
    double rev = ai * dt * j * 0.15915494309189535; rev -= rint(rev);
    const float ang = (float)(rev * 6.283185307179586);
    re = (float)mag * cosf(ang); im = (float)mag * sinf(ang);
}

__device__ __forceinline__ void p0_ssm_tables(Frame& F, int g, int pt) {
    LAS float* Apr = (LAS float*)(F.lds);
    LAS float* Api = Apr + 17 * 64;
    LAS float* Bbr = Api + 17 * 64;
    LAS float* Bbi = Bbr + 1024;
    LAS float* Cr = Bbi + 1024;
    LAS float* Ci = Cr + 1024;
    LAS float* Kj = Ci + 1024;
    LAS float* Fr = Kj + 4096;
    LAS float* Fi = Fr + 64;
    const int tid = (F.wave * 64 + lane_id());
    const double dt = exp((double)F.log_dt[g]);
    for (int idx = tid; idx < 17 * 64; idx += 512) { const int p = idx & 63, j = idx >> 6; float re, im;
        cpow_lambda((double)F.a_re[g * 64 + p], (double)F.a_im[g * 64 + p], dt, (double)j, re, im); Apr[idx] = re; Api[idx] = im; }
    if (tid < 64) { const int p = tid; const double ar = (double)F.a_re[g * 64 + p], ai = (double)F.a_im[g * 64 + p];
        const double mag = exp(ar * dt); double rev = ai * dt * 0.15915494309189535; rev -= rint(rev); const double ang = rev * 6.283185307179586;
        const double abr = mag * (double)cosf((float)ang), abi = mag * (double)sinf((float)ang);
        const double nr = abr - 1.0, ni = abi, den = ar * ar + ai * ai;
        Fr[p] = (float)((nr * ar + ni * ai) / den); Fi[p] = (float)((ni * ar - nr * ai) / den);
        float re, im; cpow_lambda(ar, ai, dt, 16.0, re, im); F.A16[g * 64 + p] = (f32x2v){re, im};
        cpow_lambda(ar, ai, dt, 128.0, re, im); F.A128[g * 64 + p] = (f32x2v){re, im}; }
    for (int idx = tid; idx < 1024; idx += 512) { Cr[idx] = F.c_re[g * 1024 + idx]; Ci[idx] = F.c_im[g * 1024 + idx]; }
    __syncthreads();
    for (int idx = tid; idx < 1024; idx += 512) { const int p = idx >> 4; const float br = F.b_re[g * 1024 + idx], bi = F.b_im[g * 1024 + idx];
        Bbr[idx] = Fr[p] * br - Fi[p] * bi; Bbi[idx] = Fr[p] * bi + Fi[p] * br; }
    __syncthreads();
    for (int idx0 = tid; idx0 < 1024; idx0 += 512) { const int j = idx0 >> 6, ho = 4 * pt + ((idx0 >> 4) & 3), hi = idx0 & 15, idx = (j * 16 + ho) * 16 + hi; float s = 0.f;
        for (int p = 0; p < 64; ++p) { const float cr = Cr[ho * 64 + p], ci = Ci[ho * 64 + p], ar = Apr[j * 64 + p], ai = Api[j * 64 + p];
            const float car = cr * ar - ci * ai, cai = cr * ai + ci * ar; s += car * Bbr[p * 16 + hi] - cai * Bbi[p * 16 + hi]; }
        Kj[idx] = s; }
    __syncthreads();
    bf16* TTg = F.TT + (size_t)g * 65536; bf16* WSg = F.WS + (size_t)g * 32768; bf16* WOg = F.WOT + (size_t)g * 32768;
    for (int idx = tid; idx < 64 * 32; idx += 512) { const int ri = idx >> 5, t = ri >> 2, ho = 4 * pt + (ri & 3), n = t * 16 + ho, k0 = (idx & 31) * 8, s = k0 >> 4, hi0 = k0 & 15;
        const float dv = F.dsk[g * 16 + ho]; float v[8];
#pragma unroll
        for (int e = 0; e < 8; ++e) { const int hi = hi0 + e; float xv = (s <= t) ? Kj[((t - s) * 16 + ho) * 16 + hi] : 0.f; if (s == t && hi == ho) xv += dv; v[e] = xv; }
        v4u o; o.x = pk2(v[0], v[1]); o.y = pk2(v[2], v[3]); o.z = pk2(v[4], v[5]); o.w = pk2(v[6], v[7]);
        *(v4u*)(TTg + ((((n >> 5) * 16 + (k0 >> 4)) * 64) + ((k0 >> 3) & 1) * 32 + (n & 31)) * 8) = o; }
    for (int idx = tid; idx < 32 * 32; idx += 512) { const int n = 32 * pt + (idx >> 5), p = n >> 1, c = n & 1, k0 = (idx & 31) * 8, s = k0 >> 4, hi0 = k0 & 15, j = 15 - s;
        const float ar = Apr[j * 64 + p], ai = Api[j * 64 + p]; float v[8];
#pragma unroll
        for (int e = 0; e < 8; ++e) { const float br = Bbr[p * 16 + hi0 + e], bi = Bbi[p * 16 + hi0 + e]; v[e] = (c == 0) ? (ar * br - ai * bi) : (ar * bi + ai * br); }
        v4u o; o.x = pk2(v[0], v[1]); o.y = pk2(v[2], v[3]); o.z = pk2(v[4], v[5]); o.w = pk2(v[6], v[7]);
        *(v4u*)(WSg + ((((n >> 5) * 16 + (k0 >> 4)) * 64) + ((k0 >> 3) & 1) * 32 + (n & 31)) * 8) = o; }
    for (int idx = tid; idx < 64 * 16; idx += 512) { const int ri = idx >> 4, t = ri >> 2, ho = 4 * pt + (ri & 3), n = t * 16 + ho, k0 = (idx & 15) * 8, p0 = k0 >> 1, j = t + 1; float v[8];
#pragma unroll
        for (int q = 0; q < 4; ++q) { const int p = p0 + q; const float cr = Cr[ho * 64 + p], ci = Ci[ho * 64 + p], ar = Apr[j * 64 + p], ai = Api[j * 64 + p];
            v[2 * q] = cr * ar - ci * ai; v[2 * q + 1] = -(cr * ai + ci * ar); }
        v4u o; o.x = pk2(v[0], v[1]); o.y = pk2(v[2], v[3]); o.z = pk2(v[4], v[5]); o.w = pk2(v[6], v[7]);
        *(v4u*)(WOg + ((((n >> 5) * 8 + (k0 >> 4)) * 64) + ((k0 >> 3) & 1) * 32 + (n & 31)) * 8) = o; }
    __syncthreads();
}

__device__ __forceinline__ void p0_gemv(Frame& F) {
    const int gw = F.vcu * NWAVES + F.wave, NGW = F.G * NWAVES;
    for (int it = gw; it < 8 * 48; it += NGW) {
        const int kc = it / 48, cc = it % 48, kq = lane_id() >> 4, col = cc * 64 + (lane_id() & 15) * 4;
        f32x4 a0 = {0.f, 0.f, 0.f, 0.f}, a1 = a0, a2 = a0, a3 = a0;
#pragma unroll 8
        for (int kk = 0; kk < 32; ++kk) { const int k = kc * 128 + kq * 32 + kk; const f32x4 w = __builtin_nontemporal_load((const f32x4*)(F.w_ada + (size_t)k * 3072 + col));
            a0 += w * pg8::silu_f(F.c[k]); a1 += w * pg8::silu_f(F.c[1024 + k]); a2 += w * pg8::silu_f(F.c[2048 + k]); a3 += w * pg8::silu_f(F.c[3072 + k]); }
#pragma unroll
        for (int e = 0; e < 4; ++e) { a0[e] += __shfl_xor(a0[e], 16); a0[e] += __shfl_xor(a0[e], 32); a1[e] += __shfl_xor(a1[e], 16); a1[e] += __shfl_xor(a1[e], 32);
            a2[e] += __shfl_xor(a2[e], 16); a2[e] += __shfl_xor(a2[e], 32); a3[e] += __shfl_xor(a3[e], 16); a3[e] += __shfl_xor(a3[e], 32); }
        if (kq == 0) { float* pp = F.MODP + (size_t)kc * 12288 + col; *(f32x4*)(pp) = a0; *(f32x4*)(pp + 3072) = a1; *(f32x4*)(pp + 6144) = a2; *(f32x4*)(pp + 9216) = a3; }
    }
}
__device__ __forceinline__ void p0_rest(Frame& F) {
    for (int u = F.vcu; u < 4 * NGRP; u += F.G) p0_ssm_tables(F, u >> 2, u & 3);
    __syncthreads();
    LAS float* scr = (LAS float*)(F.lds + RING_OFF + F.wave * 16384);
    const int gw = F.vcu * NWAVES + F.wave, NGW = F.G * NWAVES;
    if (F.vcu == 0 && F.wave == 0) { const int l_ = lane_id(); F.HGS[l_] = F.hg[l_] * (1.0f - LAM_INIT); F.HGS[64 + l_] = F.hg[64 + l_] * (1.0f - LAM_INIT); }
    for (int idx = (F.vcu * NWAVES + F.wave) * 64 + lane_id(); idx < 8192 * 32; idx += F.G * 512) {
        const int pos = idx >> 5, i = idx & 31;
        const float inv = 1.0f / powf(10000.0f, (float)(2 * i) / 64.0f);
        const float angf = (float)pos * inv;
        double rev = (double)angf * 0.15915494309189535; rev -= rint(rev);
        const float a = (float)(rev * 6.283185307179586);
        F.ROPE[idx] = cosf(a); F.ROPE[8192 * 32 + idx] = sinf(a);
    }
    constexpr int I_IN = 16 * 192, I_GLU = 16 * 32, I_OUT = 32 * 32;
    for (int it = gw; it < I_IN + I_GLU + I_OUT; it += NGW) {
        int r = it;
        if (r < I_IN) { const int kb = r / 192, nb = r % 192; p0_transpose_item(F.w_in, 1024, NPROJ, F.WIN, 64 * kb, win_src_col(32 * nb), 32 * nb, scr, lane_id()); continue; } r -= I_IN;
        if (r < I_GLU) { const int kb = r / 32, nb = r % 32; p0_transpose_item(F.w_glu, 1024, 1024, F.WGLU, 64 * kb, 32 * nb, 32 * nb, scr, lane_id()); continue; } r -= I_GLU;
        { const int kb = r / 32, nb = r % 32; p0_transpose_item(F.w_out, 2048, 1024, F.WOUT, 64 * kb, 32 * nb, 32 * nb, scr, lane_id()); }
    }
}

__device__ __forceinline__ void p0b_rows(Frame& F) {
    LAS float* modl = (LAS float*)(F.lds);
    for (int q = (F.wave * 64 + lane_id()); q < 3072; q += 512) { const int b = q / 768, c4 = (q % 768) * 4;
        f32x4 v = *(const f32x4*)(F.b_ada + c4);
#pragma unroll
        for (int kc = 0; kc < 8; ++kc) v += *(const f32x4*)(F.MODP + (size_t)kc * 12288 + b * 3072 + c4);
        *(LAS f32x4*)(modl + b * 3072 + c4) = v;
        if (F.vcu == 0) *(f32x4*)(F.MOD + b * 3072 + c4) = v; }
    __syncthreads();
    const int gw = F.vcu * NWAVES + F.wave, NGW = F.G * NWAVES;
    for (int blk = gw; blk < M / 16; blk += NGW) {
        const int m0 = blk * 16, b = m0 >> 13;
        f32x4 g[4], sh[4], sc[4];
#pragma unroll
        for (int j = 0; j < 4; ++j) { const int col = 4 * lane_id() + 256 * j; g[j] = *(const f32x4*)(F.norm_g + col);
            sh[j] = *(const LAS f32x4*)(modl + b * 3072 + col); sc[j] = *(const LAS f32x4*)(modl + b * 3072 + 1024 + col) + 1.0f; g[j] = g[j] * sc[j]; }
        f32x4 v[4], nx[4];
        { const f32x4* xr = (const f32x4*)(F.x + (size_t)m0 * DM) + lane_id();
#pragma unroll
          for (int j = 0; j < 4; ++j) nx[j] = __builtin_nontemporal_load(xr + 64 * j); }
        for (int i = 0; i < 16; ++i) {
            const int m = m0 + i; float s = 0.f;
#pragma unroll
            for (int j = 0; j < 4; ++j) { v[j] = nx[j]; s += (v[j].x * v[j].x + v[j].y * v[j].y) + (v[j].z * v[j].z + v[j].w * v[j].w); }
            if (i + 1 < 16) { const f32x4* xr = (const f32x4*)(F.x + (size_t)(m + 1) * DM) + lane_id();
#pragma unroll
                for (int j = 0; j < 4; ++j) nx[j] = __builtin_nontemporal_load(xr + 64 * j); }
            const float rstd = __builtin_amdgcn_rsqf(wave_sum(s) * (1.0f / DM) + NORM_EPS);
            unsigned long long* o8 = (unsigned long long*)(F.XN + (size_t)m * DM) + lane_id();
#pragma unroll
            for (int j = 0; j < 4; ++j) { const f32x4 h = v[j] * rstd * g[j] + sh[j];
                o8[64 * j] = (unsigned long long)pk2(h.x, h.y) | ((unsigned long long)pk2(h.z, h.w) << 32); }
        }
    }
    __syncthreads();
}

__device__ __forceinline__ int crow16(int r, int hi) { return (r & 3) + 8 * (r >> 2) + 4 * hi; }
constexpr int SSM_UB = 0, SSM_UBB = 33792, SSM_HL = 67584, SSM_HP = 100352, SSM_EX = 117760;
static_assert(SSM_EX + 4096 <= RING_BYTES, "SSM LDS map");
__device__ __forceinline__ void ssm_unit(Frame& F, int b, int g) {
    LAS float* HL = (LAS float*)(F.lds + SSM_HL);
    LAS bf16* YT = (LAS bf16*)(F.lds + SSM_HL);
    LAS bf16* HP = (LAS bf16*)(F.lds + SSM_HP);
    LAS float* EX = (LAS float*)(F.lds + SSM_EX);
    const bf16* Uc = F.UC + (size_t)(b * 64 + g) * 8192 * 16;
    const bf16* TTg = F.TT + (size_t)g * 65536; const bf16* WSg = F.WS + (size_t)g * 32768; const bf16* WOg = F.WOT + (size_t)g * 32768;
    bf16* GYb = F.GY + (size_t)b * SEQ * DM + g * 16;
    const int tid = (F.wave * 64 + lane_id()), lane = lane_id(), w = F.wave, r = lane & 31, h = lane >> 5;
    const f32x2v a16 = F.A16[g * 64 + lane], a128 = F.A128[g * 64 + lane];
    float car = 0.f, cai = 0.f;
    bf16x8 wsf[16];
    { const bf16* wf0 = WSg + (size_t)((w & 3) * 16) * 512 + lane * 8;
#pragma unroll
      for (int j = 0; j < 16; ++j) wsf[j] = *(const bf16x8*)(wf0 + j * 512); }
    v4u pre[4];
#pragma unroll
    for (int i = 0; i < 4; ++i) pre[i] = *(const v4u*)(Uc + (size_t)(tid + i * 512) * 8);
#pragma unroll
    for (int i = 0; i < 4; ++i) { const int q = tid + i * 512; *(LAS v4u*)(F.lds + SSM_UB + (q >> 5) * 528 + (q & 31) * 16) = pre[i]; }
    for (int seg = 0; seg < 8; ++seg) {
        LAS unsigned char* UB = F.lds + SSM_UB + (seg & 1) * SSM_UBB;
        if (seg + 1 < 8) {
#pragma unroll
            for (int i = 0; i < 4; ++i) pre[i] = *(const v4u*)(Uc + (size_t)(seg + 1) * 16384 + (size_t)(tid + i * 512) * 8);
        }
        __syncthreads();
        {
            const int mb = w >> 2, nb = w & 3;
            f32x16 acc0 = {}, acc1 = {};
            const bf16* wf = WSg + (size_t)(nb * 16) * 512 + lane * 8;
            const LAS unsigned char* ua = UB + (mb * 32 + r) * 528 + h * 16;
#pragma unroll
            for (int j = 0; j < 16; j += 2) {
                const bf16x8 a0 = *(const LAS bf16x8*)(ua + j * 32), a1 = *(const LAS bf16x8*)(ua + j * 32 + 32);
                acc0 = __builtin_amdgcn_mfma_f32_32x32x16_bf16(a0, wsf[j], acc0, 0, 0, 0);
                acc1 = __builtin_amdgcn_mfma_f32_32x32x16_bf16(a1, wsf[j + 1], acc1, 0, 0, 0);
            }
#pragma unroll
            for (int i = 0; i < 16; ++i) HL[(mb * 32 + crow16(i, h)) * 128 + nb * 32 + r] = acc0[i] + acc1[i];
        }
        __syncthreads();
        {
            const int c0 = w * 8; float er = 0.f, ei = 0.f;
#pragma unroll
            for (int i = 0; i < 8; ++i) { const f32x2v hl = *(const LAS f32x2v*)(HL + (c0 + i) * 128 + 2 * lane);
                const float nr = a16.x * er - a16.y * ei + hl.x, ni = a16.x * ei + a16.y * er + hl.y; er = nr; ei = ni; }
            *(LAS f32x2v*)(EX + (w * 64 + lane) * 2) = (f32x2v){er, ei};
            __syncthreads();
            float hr = car, hi_ = cai, ir = 0.f, ii = 0.f;
#pragma unroll
            for (int v = 0; v < 8; ++v) { if (v == w) { ir = hr; ii = hi_; }
                const f32x2v e = *(const LAS f32x2v*)(EX + (v * 64 + lane) * 2);
                const float nr = a128.x * hr - a128.y * hi_ + e.x, ni = a128.x * hi_ + a128.y * hr + e.y; hr = nr; hi_ = ni; }
            car = hr; cai = hi_;
            hr = ir; hi_ = ii;
#pragma unroll
            for (int i = 0; i < 8; ++i) { *(LAS unsigned*)(HP + (c0 + i) * 136 + 2 * lane) = pg8::cvt_pk_bf16(hr, hi_);
                const f32x2v hl = *(const LAS f32x2v*)(HL + (c0 + i) * 128 + 2 * lane);
                const float nr = a16.x * hr - a16.y * hi_ + hl.x, ni = a16.x * hi_ + a16.y * hr + hl.y; hr = nr; hi_ = ni; }
        }
        if (seg + 1 < 8) {
#pragma unroll
            for (int i = 0; i < 4; ++i) { const int q = tid + i * 512; *(LAS v4u*)(F.lds + SSM_UB + ((seg + 1) & 1) * SSM_UBB + (q >> 5) * 528 + (q & 31) * 16) = pre[i]; }
        }
        __syncthreads();
        {
            const bf16* tf = TTg + (size_t)(w * 16) * 512 + lane * 8; const bf16* of = WOg + (size_t)(w * 8) * 512 + lane * 8;
            const LAS unsigned char* ua = UB + r * 528 + h * 16;
            const LAS bf16* hp = HP + r * 136 + 8 * h;
            f32x16 acc0 = {}, acc1 = {};
#pragma unroll
            for (int kb = 0; kb < 16; kb += 8) {
                bf16x8 bq[8];
#pragma unroll
                for (int j = 0; j < 8; ++j) bq[j] = *(const bf16x8*)(tf + (kb + j) * 512);
                asm volatile("" ::: "memory");
#pragma unroll
                for (int j = 0; j < 8; ++j) {
                    const bf16x8 a0 = *(const LAS bf16x8*)(ua + (kb + j) * 32), a1 = *(const LAS bf16x8*)(ua + 32 * 528 + (kb + j) * 32);
                    acc0 = __builtin_amdgcn_mfma_f32_32x32x16_bf16(a0, bq[j], acc0, 0, 0, 0);
                    acc1 = __builtin_amdgcn_mfma_f32_32x32x16_bf16(a1, bq[j], acc1, 0, 0, 0); }
            }
            {
                bf16x8 bq[8];
#pragma unroll
                for (int j = 0; j < 8; ++j) bq[j] = *(const bf16x8*)(of + j * 512);
                asm volatile("" ::: "memory");
#pragma unroll
                for (int j = 0; j < 8; ++j) {
                    const bf16x8 a0 = *(const LAS bf16x8*)(hp + j * 16), a1 = *(const LAS bf16x8*)(hp + 32 * 136 + j * 16);
                    acc0 = __builtin_amdgcn_mfma_f32_32x32x16_bf16(a0, bq[j], acc0, 0, 0, 0);
                    acc1 = __builtin_amdgcn_mfma_f32_32x32x16_bf16(a1, bq[j], acc1, 0, 0, 0); }
            }
#pragma unroll
            for (int i = 0; i < 16; ++i) { const int cl = crow16(i, h);
                const unsigned pk = pg8::cvt_pk_bf16(pg8::gelu_tanh_f(acc0[i]), pg8::gelu_tanh_f(acc1[i]));
                YT[cl * 256 + 32 * w + r] = (bf16)(pk & 0xffffu); YT[(32 + cl) * 256 + 32 * w + r] = (bf16)(pk >> 16); }
        }
        __syncthreads();
#pragma unroll
        for (int i = 0; i < 4; ++i) { const int q = tid + i * 512; const v4u v = *(const LAS v4u*)(F.lds + SSM_HL + q * 16);
            *(v4u*)(GYb + (size_t)(seg * 1024 + (q >> 1)) * DM + (q & 1) * 8) = v; }
    }
    __syncthreads();
}

__global__ void __launch_bounds__(NWAVES * 64, 2) hybrid_fwd(Args args) {
    extern __shared__ __attribute__((aligned(16))) unsigned char lds[];
    cg::grid_group grid = cg::this_grid();
    Frame F;
    F.lds = (LAS unsigned char*)lds;
    F.wave = __builtin_amdgcn_readfirstlane((int)threadIdx.x >> 6);
    F.G = gridDim.x; { const int bx = blockIdx.x; F.vcu = (F.G % 8 == 0) ? (bx % 8) * (F.G / 8) + bx / 8 : bx; }
    unsigned char* ws = args.ws;
    F.x = args.in[0]; F.c = args.in[1]; F.w_ada = args.in[2]; F.b_ada = args.in[3]; F.norm_g = args.in[4]; F.w_in = args.in[5]; F.qg = args.in[6]; F.kg = args.in[7];
    F.lq1 = args.in[8]; F.lk1 = args.in[9]; F.lq2 = args.in[10]; F.lk2 = args.in[11]; F.hg = args.in[12];
    F.a_re = args.in[13]; F.a_im = args.in[14]; F.log_dt = args.in[15]; F.b_re = args.in[16]; F.b_im = args.in[17]; F.c_re = args.in[18]; F.c_im = args.in[19]; F.dsk = args.in[20];
    F.w_glu = args.in[21]; F.b_glu = args.in[22]; F.w_out = args.in[23]; F.out = args.out;
    F.MOD = (float*)(ws + WS_MOD); F.A16 = (f32x2v*)(ws + WS_A16); F.A128 = (f32x2v*)(ws + WS_A128); F.MODP = (float*)(ws + WS_MODP); F.HGS = (float*)(ws + WS_HGS); F.ROPE = (float*)(ws + WS_ROPE);
    F.WIN = (bf16*)(ws + WS_WIN); F.WGLU = (bf16*)(ws + WS_WGLU); F.WOUT = (bf16*)(ws + WS_WOUT); F.TT = (bf16*)(ws + WS_TT); F.WS = (bf16*)(ws + WS_WS); F.WOT = (bf16*)(ws + WS_WOT);
    F.Q = (bf16*)(ws + WS_Q); F.K = (bf16*)(ws + WS_K); F.V = (bf16*)(ws + WS_V); F.GA = (bf16*)(ws + WS_GA); F.GS = (bf16*)(ws + WS_GS); F.MIX = (bf16*)(ws + WS_MIX);
    F.XN = (bf16*)args.out; F.GY = (bf16*)args.out; F.UC = (bf16*)((unsigned char*)args.out + 64 * MiB);

    unsigned* barw = (unsigned*)(ws + WS_BAR);
    if (threadIdx.x < 2) ((volatile LAS unsigned*)(F.lds + LDS_BARST))[threadIdx.x] = 0u;
    __syncthreads();
    const XcdBarrier bar = xcd_barrier_post(barw, (volatile LAS unsigned*)(F.lds + LDS_BARST));
    p0_gemv(F);
    if (args.cg_sync) grid.sync();
    xcd_barrier(bar);
    p0b_rows(F);
    p0_rest(F);
    xcd_barrier(bar);
    {
        pg8::Gemm g{F.XN, F.WIN, M, NPROJ, DM}; pg8::StaticOrder S; S.init(M, NPROJ, F.G, (int)blockIdx.x);
        pg8::EpiProj E{F.Q, F.K, F.V, F.GA, F.GS, F.UC, F.ROPE, F.ROPE + 8192 * 32, F.qg, F.kg};
        pg8::gemm_phase<pg8::EpiProj, pg8::StaticOrder, true, true>(F.lds + RING_OFF, g, S, E, F.wave);
    }
    xcd_barrier(bar);
    unsigned* sdone = (unsigned*)(ws + WS_SDONE);
    for (int u = F.vcu; u < BATCH * NGRP; u += F.G) {
        ssm_unit(F, u & 3, u >> 2);
        asm volatile("s_waitcnt vmcnt(0)" ::: "memory");
        __syncthreads();
        if (threadIdx.x == 0) { __builtin_amdgcn_fence(__ATOMIC_RELEASE, "agent"); asm volatile("s_waitcnt vmcnt(0)" ::: "memory"); (void)xb_add(sdone, 1u); }
    }
    {
        const int ln_ = lane_id();
        const float s1_ = wave_sum(F.lq1[ln_] * F.lk1[ln_]), s2_ = wave_sum(F.lq2[ln_] * F.lk2[ln_]);
        const float lam_ = __expf(s1_) - __expf(s2_) + LAM_INIT;
        const attn_body::AttnTensors AT{(const attn_body::bf16*)F.Q, (const attn_body::bf16*)F.K, (const attn_body::bf16*)F.V, (attn_body::bf16*)F.MIX, (const attn_body::bf16*)F.GA, F.HGS, lam_};
        const attn_body::AttnOrder S((int)F.G, F.vcu);
        attn_body::attn_phase<attn_body::AttnOrder>((char*)lds + RING_OFF, AT, S, F.wave);
    }
    if (threadIdx.x == 0) {
        unsigned sp_ = 0u;
        while (xb_ld(sdone) < (unsigned)(BATCH * NGRP)) { __builtin_amdgcn_s_sleep(2); if (++sp_ > (1u << 22)) break; }
        __builtin_amdgcn_fence(__ATOMIC_ACQUIRE, "agent");
        asm volatile("s_waitcnt vmcnt(0)" ::: "memory");
    }
    __syncthreads();
    {
        pg8::Gemm g{F.GY, F.WGLU, M, DM, DM}; pg8::StaticOrder S; S.init(M, DM, F.G, (int)blockIdx.x);
        pg8::EpiGlu E{F.GY, F.GS, F.b_glu, F.MIX};
        pg8::gemm_phase<pg8::EpiGlu, pg8::StaticOrder, true, true>(F.lds + RING_OFF, g, S, E, F.wave);
    }
    xcd_barrier(bar);
    {
        pg8::Gemm g{F.MIX, F.WOUT, M, DM, MIXW}; pg8::StaticOrder S; S.init(M, DM, F.G, (int)blockIdx.x);
        pg8::EpiOut E{F.x, F.MOD, F.out};
        pg8::gemm_phase<pg8::EpiOut, pg8::StaticOrder, true, true>(F.lds + RING_OFF, g, S, E, F.wave);
    }
}

extern "C" void kernel_launch(void* const* d_in, const int* in_sizes, int n_in, void* d_out, int out_size, void* d_ws, size_t ws_size, hipStream_t stream) {
    static int grid = 0;
    if (grid == 0) {
        if (n_in != 24 || out_size != M * DM || ws_size < WS_END) { fprintf(stderr, "kernel_launch: unexpected shapes (n_in %d out %d ws %zu); nothing launched\n", n_in, out_size, ws_size); grid = -1; return; }
        int dev = 0, cus = 0, per_cu = 0;
        if (hipGetDevice(&dev) != hipSuccess || hipDeviceGetAttribute(&cus, hipDeviceAttributeMultiprocessorCount, dev) != hipSuccess) { grid = -1; return; }
        if (hipFuncSetAttribute((const void*)hybrid_fwd, hipFuncAttributeMaxDynamicSharedMemorySize, LDS_BYTES) != hipSuccess) { fprintf(stderr, "kernel_launch: hipFuncSetAttribute failed\n"); grid = -1; return; }
        if (hipOccupancyMaxActiveBlocksPerMultiprocessor(&per_cu, (const void*)hybrid_fwd, NWAVES * 64, LDS_BYTES) != hipSuccess || per_cu < 1) { fprintf(stderr, "kernel_launch: occupancy query says %d blocks per CU\n", per_cu); per_cu = 1; }
        (void)hipGetLastError();
        grid = cus * 1;
        fprintf(stderr, "kernel_launch: grid %d (per_cu query %d), ws %zu\n", grid, per_cu, ws_size);
    }
    if (grid < 0) return;
    if (hipMemsetAsync((char*)d_ws + WS_BAR, 0, 16384 + 256, stream) != hipSuccess) { fprintf(stderr, "kernel_launch: hipMemsetAsync of the barrier words failed; nothing launched\n"); return; }
    Args a{};
    for (int i = 0; i < 24; ++i) a.in[i] = (const float*)d_in[i];
    a.out = (float*)d_out; a.ws = (unsigned char*)d_ws;
    void* kargs[] = {&a};
    const hipError_t e = hipLaunchCooperativeKernel((const void*)hybrid_fwd, dim3(grid), dim3(NWAVES * 64), kargs, LDS_BYTES, stream);
    if (e != hipSuccess) fprintf(stderr, "kernel_launch: cooperative launch failed: %s (grid %d)\n", hipGetErrorString(e), grid);
}
```

```cpp
#include <hip/hip_runtime.h>
#include <hip/hip_cooperative_groups.h>
#include <cstdio>
#include <cstdint>
namespace cg = cooperative_groups;
__device__ __forceinline__ int lane_id() { int t = (int)threadIdx.x; asm volatile("" : "+v"(t)); return t & 63; }
namespace pg8 {
#define PG8_LAS __attribute__((address_space(3)))
typedef unsigned short bf16_t;
typedef short bf16x8 __attribute__((ext_vector_type(8)));
typedef float f32x4 __attribute__((ext_vector_type(4)));
typedef unsigned u32x4 __attribute__((ext_vector_type(4)));
constexpr int BM = 256, BK = 64, HALF = 128, HTB = HALF * BK * 2  , STAGE_BYTES = 8 * HTB, NXCD = 8, WGM = 8;

__host__ __device__ __forceinline__ int lds_byte(int r, int c) { const int st = (r >> 4) * 2 + (c >> 5), rr = r & 15, cc = c & 31, ob = rr * 64 + cc * 2; return st * 1024 + (ob ^ (((ob >> 9) & 1) << 5)); }
__host__ __device__ __forceinline__ void stage_rc(int b, int& R, int& C) { const int st = b / 1024, sb = b % 1024, swz = sb ^ (((sb >> 9) & 1) << 5); R = (st >> 1) * 16 + swz / 64; C = (st & 1) * 32 + (swz % 64) / 2; }
__host__ __device__ __forceinline__ int perm32(int rho) { const int n = rho >> 4, i = rho & 15; return 8 * (i >> 2) + 4 * n + (i & 3); }

struct Unit { int pm, pn; };
struct Gemm { const bf16_t* A; const bf16_t* Bt; int M, N, K; };

struct StaticOrder {
    int nM, nN, nwg, G, c;
    __host__ __device__ void init(int M, int N, int G_, int c_) { nM = M / BM; nN = N / BM; nwg = nM * nN; G = G_; c = c_; }
    __host__ __device__ bool next(int i, Unit& u) const {
        const long L = (long)i * G + c; if (L >= nwg) return false;
        int wgid = (int)L; { const int q = nwg / NXCD, r = nwg % NXCD, xcd = wgid % NXCD, off = wgid / NXCD; wgid = (xcd < r ? xcd * (q + 1) : r * (q + 1) + (xcd - r) * q) + off; }
        const int nig = WGM * nN, gid = wgid / nig, fm = gid * WGM, gsz = (nM - fm) < WGM ? (nM - fm) : WGM;
        u.pm = fm + ((wgid % nig) % gsz); u.pn = (wgid % nig) / gsz; return true;
    }
    __device__ __forceinline__ void a_ready(const Unit&) const {}
    __device__ __forceinline__ void done(const Unit&) const {}
};

__device__ __forceinline__ unsigned cvt_pk_bf16(float lo, float hi) { unsigned r; asm volatile("v_cvt_pk_bf16_f32 %0, %1, %2" : "=v"(r) : "v"(lo), "v"(hi)); return r; }
typedef float f32x2 __attribute__((ext_vector_type(2)));
__device__ __forceinline__ float sigmoid_f(float x) { return __builtin_amdgcn_rcpf(1.0f + __expf(-x)); }
__device__ __forceinline__ float silu_f(float x) { return x * sigmoid_f(x); }
__device__ __forceinline__ float gelu_tanh_f(float y) { const float t = y * y; const float p = __builtin_fmaf(t, -0.10294324f, -2.3022082f);
    return y * __builtin_amdgcn_rcpf(1.0f + __builtin_amdgcn_exp2f(y * p)); }
__device__ __forceinline__ float bf_lo(unsigned w) { return __builtin_bit_cast(float, w << 16); }
__device__ __forceinline__ float bf_hi(unsigned w) { return __builtin_bit_cast(float, w & 0xffff0000u); }
constexpr float QSCALE = 0.125f * 1.4426950408889634f;

struct EpiProj {
    static constexpr bool PERM = true, AFTER_DRAIN = false;
    bf16_t *Q, *K, *V, *GA, *GS, *UC; const float* rope_cos; const float* rope_sin; const float* qg; const float* kg;
    __device__ __forceinline__ void operator()(const f32x4 (&acc)[2][2][4][2], const Unit& u, int wr, int wc, int fr, int fq) const {
        const int tt = u.pn >> 2, p4 = u.pn & 3;
        const int row0 = u.pm * BM + wr * 64 + fr;
        if (tt < 2) {
            const float* gw = (tt == 0) ? qg : kg; bf16_t* dst = (tt == 0) ? Q : K; const float sc = (tt == 0) ? QSCALE : 1.0f;
            f32x4 gv[2][2];
#pragma unroll
            for (int bj = 0; bj < 2; ++bj)
#pragma unroll
                for (int n = 0; n < 2; ++n) gv[bj][n] = *(const f32x4*)(gw + bj * 32 + 8 * fq + 4 * n) * sc;
            const int hm = p4 * 4 + wc;
#pragma unroll
            for (int ai = 0; ai < 2; ++ai)
#pragma unroll
                for (int m = 0; m < 4; ++m) {
                    const int row = row0 + ai * HALF + m * 16; const int s = row & 8191;
                    f32x4 v[2][2]; float ss = 0.f;
#pragma unroll
                    for (int bj = 0; bj < 2; ++bj)
#pragma unroll
                        for (int n = 0; n < 2; ++n) { v[bj][n] = acc[ai][bj][m][n]; const f32x4 q = v[bj][n] * v[bj][n]; ss += (q[0] + q[1]) + (q[2] + q[3]); }
                    ss += __shfl_xor(ss, 16); ss += __shfl_xor(ss, 32);
                    const float rs = __builtin_amdgcn_rsqf(ss * (1.0f / 64.0f) + 1e-6f);
                    u32x4 w0, w1;
                    {
                        const f32x4 c0 = *(const f32x4*)(rope_cos + s * 32 + 8 * fq), c1 = *(const f32x4*)(rope_cos + s * 32 + 8 * fq + 4);
                        const f32x4 s0 = *(const f32x4*)(rope_sin + s * 32 + 8 * fq), s1 = *(const f32x4*)(rope_sin + s * 32 + 8 * fq + 4);
                        const f32x4 a0 = v[0][0] * rs * gv[0][0], a1 = v[0][1] * rs * gv[0][1], b0 = v[1][0] * rs * gv[1][0], b1 = v[1][1] * rs * gv[1][1];
                        const f32x4 o10 = a0 * c0 - b0 * s0, o11 = a1 * c1 - b1 * s1, o20 = b0 * c0 + a0 * s0, o21 = b1 * c1 + a1 * s1;
                        w0.x = cvt_pk_bf16(o10[0], o10[1]); w0.y = cvt_pk_bf16(o10[2], o10[3]); w0.z = cvt_pk_bf16(o11[0], o11[1]); w0.w = cvt_pk_bf16(o11[2], o11[3]);
                        w1.x = cvt_pk_bf16(o20[0], o20[1]); w1.y = cvt_pk_bf16(o20[2], o20[3]); w1.z = cvt_pk_bf16(o21[0], o21[1]); w1.w = cvt_pk_bf16(o21[2], o21[3]);
                    }
                    bf16_t* rp = dst + (size_t)row * 1024 + hm * 64 + 8 * fq;
                    *(u32x4*)(rp) = w0; *(u32x4*)(rp + 32) = w1;
                }
        } else {
#pragma unroll
            for (int ai = 0; ai < 2; ++ai)
#pragma unroll
                for (int m = 0; m < 4; ++m) {
                    const int row = row0 + ai * HALF + m * 16;
#pragma unroll
                    for (int bj = 0; bj < 2; ++bj) {
                        f32x4 v0 = acc[ai][bj][m][0], v1 = acc[ai][bj][m][1];
                        const int col = p4 * 256 + bj * HALF + wc * 32 + 8 * fq;
                        if (tt == 3 || tt == 5) {
#pragma unroll
                            for (int e = 0; e < 4; ++e) { v0[e] = silu_f(v0[e]); v1[e] = silu_f(v1[e]); }
                        }
                        u32x4 w; w.x = cvt_pk_bf16(v0[0], v0[1]); w.y = cvt_pk_bf16(v0[2], v0[3]); w.z = cvt_pk_bf16(v1[0], v1[1]); w.w = cvt_pk_bf16(v1[2], v1[3]);
                        if (tt == 4) {
                            const int b = row >> 13, s = row & 8191, g = col >> 4;
                            *(u32x4*)(UC + ((size_t)(b * 64 + g) * 8192 + s) * 16 + (col & 15)) = w;
                        } else {
                            if (tt == 2) *(u32x4*)(V + (size_t)row * 1024 + col) = w;
                            else __builtin_nontemporal_store(w, (u32x4*)(((tt == 3) ? GA : GS) + (size_t)row * 1024 + col));
                        }
                    }
                }
        }
    }
};

struct EpiGlu {
    static constexpr bool PERM = true, AFTER_DRAIN = false;
    const bf16_t* GY; const bf16_t* GS; const float* bias; bf16_t* MIX;
    __device__ __forceinline__ void operator()(const f32x4 (&acc)[2][2][4][2], const Unit& u, int wr, int wc, int fr, int fq) const {
        const int row0 = u.pm * BM + wr * 64 + fr, col0 = u.pn * BM + wc * 32 + 8 * fq;
        f32x4 bv[2][2];
#pragma unroll
        for (int bj = 0; bj < 2; ++bj)
#pragma unroll
            for (int n = 0; n < 2; ++n) bv[bj][n] = *(const f32x4*)(bias + col0 + bj * HALF + 4 * n);
#pragma unroll
        for (int ai = 0; ai < 2; ++ai)
#pragma unroll
            for (int m = 0; m < 4; ++m) {
                const int row = row0 + ai * HALF + m * 16;
#pragma unroll
                for (int bj = 0; bj < 2; ++bj) {
                    const int col = col0 + bj * HALF;
                    const u32x4 gy = *(const u32x4*)(GY + (size_t)row * 1024 + col), gs = *(const u32x4*)(GS + (size_t)row * 1024 + col);
                    const f32x4 v0 = acc[ai][bj][m][0] + bv[bj][0], v1 = acc[ai][bj][m][1] + bv[bj][1];
                    u32x4 w;
                    w.x = cvt_pk_bf16(bf_lo(gy.x) * sigmoid_f(v0[0]) * bf_lo(gs.x), bf_hi(gy.x) * sigmoid_f(v0[1]) * bf_hi(gs.x));
                    w.y = cvt_pk_bf16(bf_lo(gy.y) * sigmoid_f(v0[2]) * bf_lo(gs.y), bf_hi(gy.y) * sigmoid_f(v0[3]) * bf_hi(gs.y));
                    w.z = cvt_pk_bf16(bf_lo(gy.z) * sigmoid_f(v1[0]) * bf_lo(gs.z), bf_hi(gy.z) * sigmoid_f(v1[1]) * bf_hi(gs.z));
                    w.w = cvt_pk_bf16(bf_lo(gy.w) * sigmoid_f(v1[2]) * bf_lo(gs.w), bf_hi(gy.w) * sigmoid_f(v1[3]) * bf_hi(gs.w));
                    *(u32x4*)(MIX + (size_t)row * 2048 + 1024 + col) = w;
                }
            }
    }
};

struct EpiOut {
    static constexpr bool PERM = true, AFTER_DRAIN = false;
    const float* x; const float* mod; float* out;
    __device__ __forceinline__ void operator()(const f32x4 (&acc)[2][2][4][2], const Unit& u, int wr, int wc, int fr, int fq) const {
        const int row0 = u.pm * BM + wr * 64 + fr, col0 = u.pn * BM + wc * 32 + 8 * fq;
        const int b = (u.pm * BM) >> 13;
        f32x4 gv[2][2];
#pragma unroll
        for (int bj = 0; bj < 2; ++bj)
#pragma unroll
            for (int n = 0; n < 2; ++n) gv[bj][n] = *(const f32x4*)(mod + b * 3072 + 2048 + col0 + bj * HALF + 4 * n);
#pragma unroll
        for (int ai = 0; ai < 2; ++ai)
#pragma unroll
            for (int mh = 0; mh < 2; ++mh) {
                f32x4 xv[2][2][2];
#pragma unroll
                for (int mm = 0; mm < 2; ++mm) { const size_t off = (size_t)(row0 + ai * HALF + (2 * mh + mm) * 16) * 1024 + col0;
#pragma unroll
                    for (int bj = 0; bj < 2; ++bj)
#pragma unroll
                        for (int n = 0; n < 2; ++n) xv[mm][bj][n] = __builtin_nontemporal_load((const f32x4*)(x + off + bj * HALF + 4 * n)); }
                asm volatile("" ::: "memory");
#pragma unroll
                for (int mm = 0; mm < 2; ++mm) { const size_t off = (size_t)(row0 + ai * HALF + (2 * mh + mm) * 16) * 1024 + col0;
#pragma unroll
                    for (int bj = 0; bj < 2; ++bj)
#pragma unroll
                        for (int n = 0; n < 2; ++n) *(f32x4*)(out + off + bj * HALF + 4 * n) = xv[mm][bj][n] + gv[bj][n] * acc[ai][bj][2 * mh + mm][n]; }
                asm volatile("" ::: "memory");
            }
    }
};
template <class Epi, class Sched, bool ALIGN_EPI = false, bool SP2 = false>
__device__ __forceinline__ void gemm_phase(PG8_LAS unsigned char* lds, const Gemm g, const Sched& S, const Epi& E, const int wid) {
    const int lane = lane_id(), tid = wid * 64 + lane, wr = wid >> 2, wc = wid & 3, fr = lane & 15, fq = lane >> 4;
    const int K = g.K, nt = K / BK;
    unsigned voffA[2], voffB[2];
#pragma unroll
    for (int i = 0; i < 2; ++i) { int R, C; stage_rc(tid * 16 + i * 8192, R, C); const int Rb = Epi::PERM ? ((R & ~31) + perm32(R & 31)) : R;
        voffA[i] = (unsigned)(R * K + C) * 2u; voffB[i] = (unsigned)(Rb * K + C) * 2u; }
    const size_t kstep = (size_t)(BK * 2);
    const size_t hstep = (size_t)HALF * K * 2;
    const size_t tstep = 2 * hstep;
    const unsigned ldsw = (unsigned)wid * 1024u;
    const int aoff = lds_byte(wr * 64 + fr, fq * 8), boff = lds_byte(wc * 32 + fr, fq * 8);
#define PG8_SA(b, h) (((b) * 2 + (h)) * HTB)
#define PG8_SB(b, h) ((4 + (b) * 2 + (h)) * HTB)
#define PG8_STAGE(bufoff, gbase, voff) do { _Pragma("unroll") for (int _i = 0; _i < 2; ++_i) \
        __builtin_amdgcn_global_load_lds((const unsigned*)((const char*)(gbase) + (voff)[_i]), (PG8_LAS unsigned*)(lds + (bufoff) + ldsw + _i * 8192), 16, 0, 0); } while (0)
#define PG8_LDA(dst, b, h) do { _Pragma("unroll") for (int m = 0; m < 4; ++m) _Pragma("unroll") for (int k = 0; k < 2; ++k) dst[m][k] = *(const PG8_LAS bf16x8*)(lds + PG8_SA(b, h) + aoff + m * 2048 + k * 1024); } while (0)
#define PG8_LDB(dst, b, h) do { _Pragma("unroll") for (int n = 0; n < 2; ++n) _Pragma("unroll") for (int k = 0; k < 2; ++k) dst[n][k] = *(const PG8_LAS bf16x8*)(lds + PG8_SB(b, h) + boff + n * 2048 + k * 1024); } while (0)
#define PG8_MMA(ai, bj, At, Bt) do { __builtin_amdgcn_s_setprio(1); _Pragma("unroll") for (int m = 0; m < 4; ++m) _Pragma("unroll") for (int n = 0; n < 2; ++n) _Pragma("unroll") for (int k = 0; k < 2; ++k) \
        acc[ai][bj][m][n] = __builtin_amdgcn_mfma_f32_16x16x32_bf16(Bt[n][k], At[m][k], acc[ai][bj][m][n], 0, 0, 0); __builtin_amdgcn_s_setprio(0); } while (0)
#define PG8_WAIT_V(n) asm volatile("s_waitcnt vmcnt(" #n ")" ::: "memory")
#define PG8_WAIT_L(n) asm volatile("s_waitcnt lgkmcnt(" #n ")" ::: "memory")
#define PG8_BAR __builtin_amdgcn_s_barrier()
#define PG8_SCHED __builtin_amdgcn_sched_barrier(0)
    Unit cur, nxt; int ui = 0;
    if (!S.next(0, cur)) return;
    f32x4 acc[2][2][4][2];
#pragma unroll
    for (int a = 0; a < 2; ++a)
#pragma unroll
        for (int b = 0; b < 2; ++b)
#pragma unroll
            for (int m = 0; m < 4; ++m)
#pragma unroll
                for (int n = 0; n < 2; ++n) acc[a][b][m][n] = (f32x4){0.f, 0.f, 0.f, 0.f};
    bf16x8 At[4][2], B0[2][2], B1[2][2];
    const char* cA = (const char*)g.A + (size_t)cur.pm * tstep; const char* cB = (const char*)g.Bt + (size_t)cur.pn * tstep;
    S.a_ready(cur);
    if constexpr (SP2) {
        PG8_STAGE(PG8_SB(0, 0), cB, voffB); PG8_STAGE(PG8_SB(0, 1), cB + hstep, voffB); PG8_STAGE(PG8_SA(0, 0), cA, voffA); PG8_STAGE(PG8_SA(0, 1), cA + hstep, voffA);
        if (wr == 1) PG8_BAR;
        PG8_WAIT_V(2); PG8_BAR;
        PG8_STAGE(PG8_SB(1, 0), cB + kstep, voffB); PG8_STAGE(PG8_SA(1, 0), cA + kstep, voffA); PG8_STAGE(PG8_SB(1, 1), cB + hstep + kstep, voffB);
        PG8_WAIT_V(6); PG8_BAR;
    } else {
        PG8_STAGE(PG8_SB(0, 0), cB, voffB); PG8_STAGE(PG8_SA(0, 0), cA, voffA); PG8_STAGE(PG8_SB(0, 1), cB + hstep, voffB); PG8_STAGE(PG8_SA(0, 1), cA + hstep, voffA);
        if (wr == 1) PG8_BAR;
        PG8_WAIT_V(4); PG8_BAR;
        PG8_STAGE(PG8_SB(1, 0), cB + kstep, voffB); PG8_STAGE(PG8_SA(1, 0), cA + kstep, voffA); PG8_STAGE(PG8_SB(1, 1), cB + hstep + kstep, voffB);
        PG8_WAIT_V(6); PG8_BAR;
    }
    for (;;) {
        const bool has_next = S.next(ui + 1, nxt);
        const char* nA = has_next ? (const char*)g.A + (size_t)nxt.pm * tstep : cA; const char* nB = has_next ? (const char*)g.Bt + (size_t)nxt.pn * tstep : cB;
        for (int t = 0; t < nt; t += 2) {
            const bool last = (t == nt - 2);
            const char* a1 = cA + (size_t)(t + 1) * kstep;
            const char* a2 = last ? nA : cA + (size_t)(t + 2) * kstep; const char* b2 = last ? nB : cB + (size_t)(t + 2) * kstep;
            const char* a3 = a2 + kstep; const char* b3 = b2 + kstep;
            if (last && has_next) S.a_ready(nxt);
            if constexpr (SP2) {
            PG8_LDB(B0, 0, 0); PG8_LDB(B1, 0, 1); PG8_SCHED; PG8_LDA(At, 0, 0); PG8_STAGE(PG8_SA(1, 1), a1 + hstep, voffA);
            PG8_WAIT_V(8); PG8_WAIT_L(0); PG8_BAR; PG8_MMA(0, 0, At, B0); PG8_MMA(0, 1, At, B1); PG8_BAR; PG8_SCHED;
            PG8_LDA(At, 0, 1); PG8_STAGE(PG8_SB(0, 0), b2, voffB); PG8_STAGE(PG8_SB(0, 1), b2 + hstep, voffB); PG8_STAGE(PG8_SA(0, 0), a2, voffA);
            PG8_WAIT_V(8); PG8_WAIT_L(0); PG8_BAR; PG8_MMA(1, 0, At, B0); PG8_MMA(1, 1, At, B1); PG8_BAR; PG8_SCHED;
            PG8_LDB(B0, 1, 0); PG8_LDB(B1, 1, 1); PG8_SCHED; PG8_LDA(At, 1, 0); PG8_STAGE(PG8_SA(0, 1), a2 + hstep, voffA);
            PG8_WAIT_V(8); PG8_WAIT_L(0); PG8_BAR; PG8_MMA(0, 0, At, B0); PG8_MMA(0, 1, At, B1); PG8_BAR; PG8_SCHED;
            PG8_LDA(At, 1, 1); PG8_STAGE(PG8_SB(1, 0), b3, voffB); PG8_STAGE(PG8_SB(1, 1), b3 + hstep, voffB); PG8_STAGE(PG8_SA(1, 0), a3, voffA);
            PG8_WAIT_V(8); PG8_WAIT_L(0); PG8_BAR; PG8_MMA(1, 0, At, B0); PG8_MMA(1, 1, At, B1); PG8_BAR; PG8_SCHED;
            } else {
            PG8_LDB(B0, 0, 0); PG8_SCHED; PG8_LDA(At, 0, 0); PG8_STAGE(PG8_SA(1, 1), a1 + hstep, voffA);
            PG8_WAIT_L(8); PG8_BAR; PG8_WAIT_L(0); PG8_MMA(0, 0, At, B0); PG8_BAR; PG8_SCHED;
            PG8_LDB(B1, 0, 1); PG8_STAGE(PG8_SB(0, 0), b2, voffB);
            PG8_BAR; PG8_WAIT_L(0); PG8_MMA(0, 1, At, B1); PG8_BAR;
            PG8_LDA(At, 0, 1); PG8_STAGE(PG8_SA(0, 0), a2, voffA);
            PG8_BAR; PG8_WAIT_L(0); PG8_MMA(1, 0, At, B0); PG8_BAR; PG8_SCHED;
            PG8_STAGE(PG8_SB(0, 1), b2 + hstep, voffB);
            PG8_WAIT_V(6); PG8_BAR; PG8_MMA(1, 1, At, B1); PG8_BAR;
            PG8_LDB(B0, 1, 0); PG8_SCHED; PG8_LDA(At, 1, 0); PG8_STAGE(PG8_SA(0, 1), a2 + hstep, voffA);
            PG8_WAIT_L(8); PG8_BAR; PG8_WAIT_L(0); PG8_MMA(0, 0, At, B0); PG8_BAR; PG8_SCHED;
            PG8_LDB(B1, 1, 1); PG8_STAGE(PG8_SB(1, 0), b3, voffB);
            PG8_BAR; PG8_WAIT_L(0); PG8_MMA(0, 1, At, B1); PG8_BAR;
            PG8_LDA(At, 1, 1); PG8_STAGE(PG8_SA(1, 0), a3, voffA);
            PG8_BAR; PG8_WAIT_L(0); PG8_MMA(1, 0, At, B0); PG8_BAR; PG8_SCHED;
            PG8_STAGE(PG8_SB(1, 1), b3 + hstep, voffB);
            PG8_WAIT_V(6); PG8_BAR; PG8_MMA(1, 1, At, B1); PG8_BAR;
            }
        }
        if constexpr (ALIGN_EPI) { if (wr == 0) PG8_BAR; }
        if constexpr (!Epi::AFTER_DRAIN) { E(acc, cur, wr, wc, fr, fq); S.done(cur); }
        if (!has_next) break;
#pragma unroll
        for (int a = 0; a < 2; ++a)
#pragma unroll
            for (int b = 0; b < 2; ++b)
#pragma unroll
                for (int m = 0; m < 4; ++m)
#pragma unroll
                    for (int n = 0; n < 2; ++n) acc[a][b][m][n] = (f32x4){0.f, 0.f, 0.f, 0.f};
        cur = nxt; cA = nA; cB = nB; ++ui;
        if constexpr (ALIGN_EPI) { if (wr == 1) PG8_BAR; }
    }
    PG8_WAIT_V(0);
    if constexpr (!ALIGN_EPI) { if (wr == 0) PG8_BAR; }
    PG8_BAR;
    if constexpr (Epi::AFTER_DRAIN) { E.fused(acc, cur, wr, wc, fr, fq, lds, wid, lane); S.done(cur); }
#undef PG8_SA
#undef PG8_SB
#undef PG8_STAGE
#undef PG8_LDA
#undef PG8_LDB
#undef PG8_MMA
#undef PG8_WAIT_V
#undef PG8_WAIT_L
#undef PG8_BAR
#undef PG8_SCHED
}
}
#include <hip/hip_bf16.h>
#include <cmath>
namespace attn_body {
using bf16=__hip_bfloat16;
using bf16x8=__attribute__((ext_vector_type(8)))short;
using s16x4=__attribute__((ext_vector_type(4)))short;
using f32x16=__attribute__((ext_vector_type(16)))float;
using u32x4=__attribute__((ext_vector_type(4)))unsigned;
constexpr int BATCH=4,NHEAD=16,SEQ=8192,D=64,DM=NHEAD*D,OP=2048;
constexpr int NW=8,QBLK=32,QB=QBLK*NW,KVBLK=64,NQB=SEQ/QB;
constexpr int ATTN_PITCH=DM, ATTN_UNIT_ROWS=QB;
__device__ __forceinline__ int crow(int r,int hi){return (r&3)+8*(r>>2)+4*hi;}
#define SBAR() __builtin_amdgcn_sched_barrier(0)
__device__ __forceinline__ void cmask(f32x16&p0,f32x16&p1,int jb,int qrel,int hi){
  const float NEG=-INFINITY; (void)hi;
  if(jb>(qrel>>6)){
  #pragma unroll
  for(int r=0;r<16;++r){p0[r]=NEG;p1[r]=NEG;}}
}

constexpr int NSLOT=3, SLOTB=8192, SLOTV=16384;
constexpr int LDS_K=0, LDS_V=NSLOT*SLOTB, LDS_WS=LDS_V+NSLOT*SLOTV, LDS_OST=LDS_WS+NW*64*4, LDS_BYTES=LDS_OST+NW*4096;
constexpr float C2=0.125f*1.4426950408889634f;
__device__ __forceinline__ void glds16(const void*gsrc,unsigned lds_dst){unsigned keep;
  asm volatile("s_mov_b32 %0, m0\n\ts_mov_b32 m0, %2\n\ts_nop 0\n\tglobal_load_lds_dwordx4 %1, off\n\ts_mov_b32 m0, %0":"=&s"(keep):"v"(gsrc),"s"(lds_dst):"memory");}
__device__ __forceinline__ float max3f(float a,float b,float c){float r;asm("v_max3_f32 %0, %1, %2, %3":"=v"(r):"v"(a),"v"(b),"v"(c));return r;}
__device__ __forceinline__ float max2f(float a,float b){float r;asm("v_max_f32_e32 %0, %1, %2":"=v"(r):"v"(a),"v"(b));return r;}
__device__ __forceinline__ float fadd_s(float a,float b){float r;asm("v_add_f32_e32 %0, %1, %2":"=v"(r):"v"(a),"v"(b));return r;}
__device__ __forceinline__ float fsub_s(float a,float b){float r;asm("v_sub_f32_e32 %0, %1, %2":"=v"(r):"v"(a),"v"(b));return r;}
typedef float f32x2_t __attribute__((ext_vector_type(2))); typedef __bf16 bf16x2_t __attribute__((ext_vector_type(2)));
__device__ __forceinline__ unsigned cvtpk_s(float lo,float hi){f32x2_t v={lo,hi};bf16x2_t b=__builtin_convertvector(v,bf16x2_t);return __builtin_bit_cast(unsigned,b);}
#define WAIT_BAR(N) asm volatile("s_waitcnt vmcnt(" #N ") lgkmcnt(0)\n\ts_barrier":::"memory")

__device__ __forceinline__ void qkt(f32x16&p0,f32x16&p1,const char*Kslot,const bf16x8*qr,int r32,int hi){
  const f32x16 zero16={};
  const char*kb=Kslot+hi*1024+r32*16;
  #pragma unroll
  for(int d0=0;d0<4;++d0){
    const bf16x8 b0=*reinterpret_cast<const bf16x8*>(kb+d0*2048);
    const bf16x8 b1=*reinterpret_cast<const bf16x8*>(kb+d0*2048+512);
    if(d0==0){p0=__builtin_amdgcn_mfma_f32_32x32x16_bf16(b0,qr[0],zero16,0,0,0);p1=__builtin_amdgcn_mfma_f32_32x32x16_bf16(b1,qr[0],zero16,0,0,0);}
    else{p0=__builtin_amdgcn_mfma_f32_32x32x16_bf16(b0,qr[d0],p0,0,0,0);p1=__builtin_amdgcn_mfma_f32_32x32x16_bf16(b1,qr[d0],p1,0,0,0);}}
}
typedef __attribute__((address_space(3))) const char* lds_cptr;
typedef short v4i16_t __attribute__((ext_vector_type(4)));
__device__ __forceinline__ void kload8(bf16x8*kf,lds_cptr kp){
  kf[0]=*(const __attribute__((address_space(3))) bf16x8*)(kp);      kf[1]=*(const __attribute__((address_space(3))) bf16x8*)(kp+512);
  kf[2]=*(const __attribute__((address_space(3))) bf16x8*)(kp+2048); kf[3]=*(const __attribute__((address_space(3))) bf16x8*)(kp+2560);
  kf[4]=*(const __attribute__((address_space(3))) bf16x8*)(kp+4096); kf[5]=*(const __attribute__((address_space(3))) bf16x8*)(kp+4608);
  kf[6]=*(const __attribute__((address_space(3))) bf16x8*)(kp+6144); kf[7]=*(const __attribute__((address_space(3))) bf16x8*)(kp+6656);
}
__device__ __forceinline__ void kload2(bf16x8*kf,lds_cptr kp,int j){ kf[2*j]=*(const __attribute__((address_space(3))) bf16x8*)(kp+j*2048); kf[2*j+1]=*(const __attribute__((address_space(3))) bf16x8*)(kp+j*2048+512); }
__device__ __forceinline__ s16x4 vtr(lds_cptr p){ return __builtin_bit_cast(s16x4,__builtin_amdgcn_ds_read_tr16_b64_v4i16((__attribute__((address_space(3))) v4i16_t*)p)); }
__device__ __forceinline__ float rowmax(const f32x16&p0,const f32x16&p1){
  float a=max3f(p0[0],p0[1],p1[0]),b=max3f(p0[2],p0[3],p1[1]);a=max3f(a,p1[2],p1[3]);
  #pragma unroll
  for(int r=4;r<16;r+=4){a=max3f(a,p0[r],p0[r+1]);b=max3f(b,p0[r+2],p0[r+3]);a=max3f(a,p1[r],p1[r+1]);b=max3f(b,p1[r+2],p1[r+3]);}
  const float m=max2f(a,b);
  auto rr=__builtin_amdgcn_permlane32_swap(__float_as_uint(m),__float_as_uint(m),false,false);
  return max2f(__uint_as_float(rr[0]),__uint_as_float(rr[1]));
}
__device__ __forceinline__ void pv(f32x16*o,int vb,bf16x8 pa0,bf16x8 pa1,bf16x8 pa2,bf16x8 pa3){
  #pragma unroll
  for(int d0=0;d0<4;++d0){s16x4 lo[4],hi[4];
    #pragma unroll
    for(int ks=0;ks<4;++ks){
      asm volatile("ds_read_b64_tr_b16 %0,%1 offset:%c2":"=&v"(lo[ks]):"v"(vb),"i"(d0*4096+ks*1024):"memory");
      asm volatile("ds_read_b64_tr_b16 %0,%1 offset:%c2":"=&v"(hi[ks]):"v"(vb),"i"(d0*4096+ks*1024+512):"memory");}
    asm volatile("s_waitcnt lgkmcnt(0)":::"memory");SBAR();
    #define PK(k) (bf16x8){lo[k][0],lo[k][1],lo[k][2],lo[k][3],hi[k][0],hi[k][1],hi[k][2],hi[k][3]}
    o[d0]=__builtin_amdgcn_mfma_f32_32x32x16_bf16(pa0,PK(0),o[d0],0,0,0);
    o[d0]=__builtin_amdgcn_mfma_f32_32x32x16_bf16(pa1,PK(1),o[d0],0,0,0);
    o[d0]=__builtin_amdgcn_mfma_f32_32x32x16_bf16(pa2,PK(2),o[d0],0,0,0);
    o[d0]=__builtin_amdgcn_mfma_f32_32x32x16_bf16(pa3,PK(3),o[d0],0,0,0);
    #undef PK
  }
}

#ifndef ATTN_STORE16
#define ATTN_STORE16(p,v) (*(u32x4*)(p)=(v))
#endif
template<int THRL> __device__ __forceinline__ void attn_unit(int b,int h,int qb,const bf16*__restrict__ Q,const bf16*__restrict__ K,const bf16*__restrict__ V,bf16* O,const bf16*__restrict__ GA,const float*__restrict__ hg,const float lam,char*shm,const int wid){
  const int lane=lane_id(),r32=lane&31,hi=lane>>5;
  const long rowbase=(long)b*SEQ; const int q0=qb*QB;
  const bf16*Qw=Q+(rowbase+q0+wid*QBLK)*DM+h*D;
  const bf16*Kh=K+rowbase*DM+h*D,*Vh=V+rowbase*DM+(h>>1)*128;
  const unsigned lds0=(unsigned)(uintptr_t)shm;
  float*wsf=(float*)(shm+LDS_WS)+wid*64;
  const bf16*ksrc=Kh+(long)lane*DM+wid*8;
  const bf16*vsrc=Vh+(long)(16*(wid&3)+(lane>>2))*DM+(wid>>2)*32+(lane&3)*8;
  const unsigned kdst=lds0+LDS_K+wid*1024, vdst=lds0+LDS_V+wid*1024;
  #define DMA_K(t,slot) glds16(ksrc+(long)(t)*KVBLK*DM,(unsigned)__builtin_amdgcn_readfirstlane(kdst+(slot)))
  #define DMA_V(t,slot) do{ glds16(vsrc+(long)(t)*KVBLK*DM,(unsigned)__builtin_amdgcn_readfirstlane(vdst+2*(slot))); glds16(vsrc+64+(long)(t)*KVBLK*DM,(unsigned)__builtin_amdgcn_readfirstlane(vdst+8192+2*(slot))); }while(0)
  const int vb0=(int)(lds0+LDS_V)+((lane>>4)&1)*32+(lane&3)*8+(4*hi+((lane&15)>>2))*64;
  const char*Kbase=shm+LDS_K; bf16x8 kf[8];
  const lds_cptr shm3=(lds_cptr)shm; const lds_cptr kp0=shm3+LDS_K+hi*1024+r32*16; const lds_cptr vp0=shm3+LDS_V+((lane>>4)&1)*32+(lane&3)*8+(4*hi+((lane&15)>>2))*64;
  const int NT=(q0+QB)/KVBLK;
  DMA_K(0,0);DMA_V(0,0);DMA_K(1,SLOTB);
  bf16x8 qr[4];
  #pragma unroll
  for(int d0=0;d0<4;++d0)qr[d0]=*reinterpret_cast<const bf16x8*>(&Qw[(long)r32*DM+d0*16+hi*8]);
  float l_reg=0.f;f32x16 o[4];o[0]=f32x16{};o[1]=f32x16{};o[2]=f32x16{};o[3]=f32x16{};const f32x16 zero16={};
  const int qrel=wid*QBLK;
  #define CMASK(P0,P1,t) do{int jb_=(t)-(NT-4); if(jb_>=0)cmask(P0,P1,jb_,qrel,hi);}while(0)
  bool resc=false;
  #define START(P0,P1) do{ resc=false; \
    _Pragma("unroll") for(int r=0;r<16;++r)P0[r]=__builtin_amdgcn_exp2f(P0[r]); }while(0)
  #define RESC() do{ if(resc){ asm volatile("s_waitcnt lgkmcnt(0)":::"memory"); \
      _Pragma("unroll") for(int d_=0;d_<4;++d_) _Pragma("unroll") for(int r=0;r<16;++r)o[d_][r]*=wsf[crow(r,hi)]; } }while(0)
  f32x16 pA0,pA1,pB0,pB1;
  int sl_prev=0,sl_cur=0,sl_next=SLOTB;
  #define ROT() do{sl_prev=sl_cur;sl_cur=sl_next;sl_next=(sl_next==(NSLOT-1)*SLOTB)?0:sl_next+SLOTB;}while(0)
  DMA_K(2,2*SLOTB);
  WAIT_BAR(3);
  qkt(pA0,pA1,Kbase,qr,r32,hi);asm volatile("s_nop 15\n\ts_nop 7":"+v"(pA0),"+v"(pA1));CMASK(pA0,pA1,0);
  START(pA0,pA1);
  _Pragma("unroll") for(int r=0;r<16;++r)pA1[r]=__builtin_amdgcn_exp2f(pA1[r]);
  WAIT_BAR(0);
  DMA_K(3,0);DMA_V(1,SLOTB);
  ROT();
  kload8(kf,kp0+sl_cur);
  WAIT_BAR(3);
  s16x4 vlo[8],vhi[8]; u32x4 pw0,pw1,pw2,pw3;
  #define PKW(P,B) cvtpk_s(P[B],P[B+1])
  #define PAF(k) __builtin_bit_cast(bf16x8,pw##k)
  #define VFR(i) (bf16x8){vlo[i][0],vlo[i][1],vlo[i][2],vlo[i][3],vhi[i][0],vhi[i][1],vhi[i][2],vhi[i][3]}
  #define PIN(x) asm volatile("":"+v"(x))
  #define MX3(a,b,c) __builtin_fmaxf(__builtin_fmaxf((a),(b)),(c))
  #define GAPA(MF,A0,A1,A2,A3,W0,W1,PW) do{ MF; sacc+=A0; sacc+=A1; sacc+=A2; sacc+=A3; PIN(sacc); W0; W1; PIN(PW); SBAR(); }while(0)
  #define EX(v) __builtin_amdgcn_exp2f(v)
  #define GAPB(MF,RL,X,B) do{ MF; RL; X[B]=EX(X[B]); X[B+1]=EX(X[B+1]); PIN(X); SBAR(); }while(0)
  #define VRD(i) do{ vlo[i]=vtr(vp_+(((i)>>2)*4096+((i)&3)*1024)); vhi[i]=vtr(vp_+(((i)>>2)*4096+((i)&3)*1024+512)); }while(0)
  #define VRD2(i) do{ vlo[i]=vtr(vp_+((((i)>>2)+2)*4096+((i)&3)*1024)); vhi[i]=vtr(vp_+((((i)>>2)+2)*4096+((i)&3)*1024+512)); }while(0)
  #define KRD(G,j) do{ if(G){ kload2(kf,kp0+sl_next,j); SBAR(); } }while(0)
  #define STEP(C0,C1,P0,P1,t,GK,GV,GL) do{ SBAR(); \
    const lds_cptr vp_=vp0+2*sl_prev; \
    VRD(0); SBAR(); float sacc=(P0[0]+P0[1]); \
    GAPA(C0=__builtin_amdgcn_mfma_f32_32x32x16_bf16(kf[0],qr[0],zero16,0,0,0), P0[2],P0[3],P0[4],P0[5],     pw0[0]=PKW(P0,0), pw0[1]=PKW(P0,2), pw0); \
    VRD(4); SBAR(); GAPA(C1=__builtin_amdgcn_mfma_f32_32x32x16_bf16(kf[1],qr[0],zero16,0,0,0), P0[6],P0[7],P0[8],P0[9],     pw0[2]=PKW(P0,4), pw0[3]=PKW(P0,6), pw0); \
    VRD(1); SBAR(); GAPA(C0=__builtin_amdgcn_mfma_f32_32x32x16_bf16(kf[2],qr[1],C0,0,0,0),   P0[10],P0[11],P0[12],P0[13], pw1[0]=PKW(P0,8), pw1[1]=PKW(P0,10), pw1); \
    VRD(5); SBAR(); GAPA(C1=__builtin_amdgcn_mfma_f32_32x32x16_bf16(kf[3],qr[1],C1,0,0,0),   P0[14],P0[15],P1[0],P1[1],   pw1[2]=PKW(P0,12),pw1[3]=PKW(P0,14), pw1); \
    VRD(2); SBAR(); GAPA(C0=__builtin_amdgcn_mfma_f32_32x32x16_bf16(kf[4],qr[2],C0,0,0,0),   P1[2],P1[3],P1[4],P1[5],     pw2[0]=PKW(P1,0), pw2[1]=PKW(P1,2), pw2); \
    VRD(6); SBAR(); GAPA(C1=__builtin_amdgcn_mfma_f32_32x32x16_bf16(kf[5],qr[2],C1,0,0,0),   P1[6],P1[7],P1[8],P1[9],     pw2[2]=PKW(P1,4), pw2[3]=PKW(P1,6), pw2); \
    VRD(3); SBAR(); GAPA(C0=__builtin_amdgcn_mfma_f32_32x32x16_bf16(kf[6],qr[3],C0,0,0,0),   P1[10],P1[11],P1[12],P1[13], pw3[0]=PKW(P1,8), pw3[1]=PKW(P1,10), pw3); \
    VRD(7); SBAR(); GAPA(C1=__builtin_amdgcn_mfma_f32_32x32x16_bf16(kf[7],qr[3],C1,0,0,0),   P1[14],P1[15],0.f,0.f,       pw3[2]=PKW(P1,12),pw3[3]=PKW(P1,14), pw3); \
    l_reg+=sacc; \
    if(GK){DMA_K((t)+3,sl_cur);} if(GV){DMA_V((t)+1,sl_next);} \
    CMASK(C0,C1,t); \
    SBAR(); \
    GAPB(o[0]=__builtin_amdgcn_mfma_f32_32x32x16_bf16(PAF(0),VFR(0),o[0],0,0,0), VRD2(0), C0,0); \
    GAPB(o[1]=__builtin_amdgcn_mfma_f32_32x32x16_bf16(PAF(0),VFR(4),o[1],0,0,0), VRD2(4), C0,2); \
    KRD(GL,0); GAPB(o[0]=__builtin_amdgcn_mfma_f32_32x32x16_bf16(PAF(1),VFR(1),o[0],0,0,0), VRD2(1), C0,4); \
    KRD(GL,1); GAPB(o[1]=__builtin_amdgcn_mfma_f32_32x32x16_bf16(PAF(1),VFR(5),o[1],0,0,0), VRD2(5), C0,6); \
    KRD(GL,2); GAPB(o[0]=__builtin_amdgcn_mfma_f32_32x32x16_bf16(PAF(2),VFR(2),o[0],0,0,0), VRD2(2), C0,8); \
    KRD(GL,3); GAPB(o[1]=__builtin_amdgcn_mfma_f32_32x32x16_bf16(PAF(2),VFR(6),o[1],0,0,0), VRD2(6), C0,10); \
    GAPB(o[0]=__builtin_amdgcn_mfma_f32_32x32x16_bf16(PAF(3),VFR(3),o[0],0,0,0), VRD2(3), C0,12); \
    GAPB(o[1]=__builtin_amdgcn_mfma_f32_32x32x16_bf16(PAF(3),VFR(7),o[1],0,0,0), VRD2(7), C0,14); \
    GAPB(o[2]=__builtin_amdgcn_mfma_f32_32x32x16_bf16(PAF(0),VFR(0),o[2],0,0,0), (void)0, C1,0); \
    GAPB(o[3]=__builtin_amdgcn_mfma_f32_32x32x16_bf16(PAF(0),VFR(4),o[3],0,0,0), (void)0, C1,2); \
    GAPB(o[2]=__builtin_amdgcn_mfma_f32_32x32x16_bf16(PAF(1),VFR(1),o[2],0,0,0), (void)0, C1,4); \
    GAPB(o[3]=__builtin_amdgcn_mfma_f32_32x32x16_bf16(PAF(1),VFR(5),o[3],0,0,0), (void)0, C1,6); \
    GAPB(o[2]=__builtin_amdgcn_mfma_f32_32x32x16_bf16(PAF(2),VFR(2),o[2],0,0,0), (void)0, C1,8); \
    GAPB(o[3]=__builtin_amdgcn_mfma_f32_32x32x16_bf16(PAF(2),VFR(6),o[3],0,0,0), (void)0, C1,10); \
    GAPB(o[2]=__builtin_amdgcn_mfma_f32_32x32x16_bf16(PAF(3),VFR(3),o[2],0,0,0), (void)0, C1,12); \
    GAPB(o[3]=__builtin_amdgcn_mfma_f32_32x32x16_bf16(PAF(3),VFR(7),o[3],0,0,0), (void)0, C1,14); \
    }while(0)
  int t=1;
  #undef CMASK
  #define CMASK(P0,P1,t) do{}while(0)
  for(;t+5<NT;t+=2){
    STEP(pB0,pB1,pA0,pA1,t,true,true,true);     WAIT_BAR(3); RESC(); ROT();
    STEP(pA0,pA1,pB0,pB1,t+1,true,true,true);   WAIT_BAR(3); RESC(); ROT();
  }
  #undef CMASK
  #define CMASK(P0,P1,t) do{int jb_=(t)-(NT-4); if(jb_>=0)cmask(P0,P1,jb_,qrel,hi);}while(0)
  #define ENDW(tt) do{ if((tt)+3<NT){WAIT_BAR(3);} else if((tt)+2<NT){WAIT_BAR(2);} else {WAIT_BAR(0);} }while(0)
  for(;t+1<NT;t+=2){
    STEP(pB0,pB1,pA0,pA1,t,(t+3<NT),(t+1<NT),(t+1<NT));       ENDW(t);   RESC(); ROT();
    STEP(pA0,pA1,pB0,pB1,t+1,(t+4<NT),(t+2<NT),(t+2<NT));     ENDW(t+1); RESC(); ROT();
  }
  STEP(pB0,pB1,pA0,pA1,NT-1,false,false,false); RESC();
  { float sacc=pB0[0]+pB0[1]; _Pragma("unroll") for(int r=2;r<16;++r)sacc+=pB0[r]; _Pragma("unroll") for(int r=0;r<16;++r)sacc+=pB1[r]; l_reg+=sacc;
    pw0=(u32x4){PKW(pB0,0),PKW(pB0,2),PKW(pB0,4),PKW(pB0,6)};pw1=(u32x4){PKW(pB0,8),PKW(pB0,10),PKW(pB0,12),PKW(pB0,14)};pw2=(u32x4){PKW(pB1,0),PKW(pB1,2),PKW(pB1,4),PKW(pB1,6)};pw3=(u32x4){PKW(pB1,8),PKW(pB1,10),PKW(pB1,12),PKW(pB1,14)};
    SBAR(); pv(o,vb0+2*sl_cur,PAF(0),PAF(1),PAF(2),PAF(3)); }
  #undef PKW
  #undef PAF
  #undef VFR
  #undef PIN
  #undef MX3
  #undef GAPA
  #undef GAPB
  #undef EX
  #undef VRD
  #undef KRD
  #undef STEP
  #undef ENDW
  {auto rr=__builtin_amdgcn_permlane32_swap(__float_as_uint(l_reg),__float_as_uint(l_reg),false,false);l_reg=__uint_as_float(rr[0])+__uint_as_float(rr[1]);}
  if(hi==0)wsf[32+r32]=l_reg;asm volatile("s_waitcnt lgkmcnt(0)":::"memory");
  float rli[16];
  #pragma unroll
  for(int r=0;r<16;++r)rli[r]=__builtin_amdgcn_rcpf(wsf[32+crow(r,hi)]);
  const long grow0=rowbase+q0+wid*QBLK;
  bf16*Ow=O+grow0*(long)OP+(h>>1)*128;
  { bf16*stg=(bf16*)(shm+LDS_OST)+wid*2048;
    if((h&1)==0){
    #pragma unroll
    for(int ps=0;ps<2;++ps){
      #pragma unroll
      for(int r=0;r<16;++r){const int orow=crow(r,hi);
        #pragma unroll
        for(int d0=0;d0<2;++d0)stg[orow*64+d0*32+r32]=__float2bfloat16(o[2*ps+d0][r]*rli[r]);}
      asm volatile("s_waitcnt lgkmcnt(0)":::"memory");
      #pragma unroll
      for(int i=0;i<4;++i){const int row=i*8+(lane>>3),ch=lane&7; const u32x4 v=*(const u32x4*)(stg+row*64+ch*8); ATTN_STORE16(Ow+(long)row*OP+ps*64+ch*8,v);}
      asm volatile("s_waitcnt lgkmcnt(0)":::"memory");
    }
    }else{
    float dd[2][4][8]; const int ch=lane&7;
    #pragma unroll
    for(int ps=0;ps<2;++ps){
      #pragma unroll
      for(int r=0;r<16;++r){const int orow=crow(r,hi);
        #pragma unroll
        for(int d0=0;d0<2;++d0)stg[orow*64+d0*32+r32]=__float2bfloat16(o[2*ps+d0][r]*rli[r]);}
      asm volatile("s_waitcnt lgkmcnt(0)":::"memory");
      #pragma unroll
      for(int i=0;i<4;++i){const int row=i*8+(lane>>3); const u32x4 v=*(const u32x4*)(stg+row*64+ch*8); const u32x4 z=*(const u32x4*)(Ow+(long)row*OP+ps*64+ch*8);
        #pragma unroll
        for(int q=0;q<4;++q){ dd[ps][i][2*q]=__builtin_bit_cast(float,z[q]<<16)-lam*__builtin_bit_cast(float,v[q]<<16); dd[ps][i][2*q+1]=__builtin_bit_cast(float,z[q]&0xffff0000u)-lam*__builtin_bit_cast(float,v[q]&0xffff0000u); } }
      asm volatile("s_waitcnt lgkmcnt(0)":::"memory");
    }
    float rs[4];
    #pragma unroll
    for(int i=0;i<4;++i){ float ss=0.f;
      #pragma unroll
      for(int ps=0;ps<2;++ps)
        #pragma unroll
        for(int e=0;e<8;++e)ss+=dd[ps][i][e]*dd[ps][i][e];
      ss+=__shfl_xor(ss,1); ss+=__shfl_xor(ss,2); ss+=__shfl_xor(ss,4);
      rs[i]=__builtin_amdgcn_rsqf(ss*(1.0f/128.0f)+1e-6f); }
    #pragma unroll
    for(int ps=0;ps<2;++ps){ float hgv[8];
      #pragma unroll
      for(int e=0;e<8;++e)hgv[e]=hg[ps*64+ch*8+e];
      #pragma unroll
      for(int i=0;i<4;++i){const int row=i*8+(lane>>3); const u32x4 g=*(const u32x4*)(GA+(grow0+row)*(long)DM+(h>>1)*128+ps*64+ch*8); u32x4 w;
        #pragma unroll
        for(int q=0;q<4;++q) w[q]=cvtpk_s(dd[ps][i][2*q]*rs[i]*hgv[2*q]*__builtin_bit_cast(float,g[q]<<16), dd[ps][i][2*q+1]*rs[i]*hgv[2*q+1]*__builtin_bit_cast(float,g[q]&0xffff0000u));
        ATTN_STORE16(Ow+(long)row*OP+ps*64+ch*8,w); } }
    } }
  asm volatile("s_waitcnt lgkmcnt(0)\n\ts_barrier":::"memory");
  #undef DMA_K
  #undef DMA_V
  #undef CMASK
  #undef START
  #undef RESC
  #undef ROT
}
constexpr int ATTN_LDS_BYTES=LDS_BYTES;
struct AttnTensors { const bf16* Q; const bf16* K; const bf16* V; bf16* O; const bf16* GA; const float* hg; float lam; };
struct AttnUnit { int b, hm, qb; };
struct AttnOrder {
  int vcu, G;
  __device__ __forceinline__ AttnOrder(int grid,int v):vcu(v),G(grid){}
  __device__ __forceinline__ bool next(int i,AttnUnit&u)const{
    int head,qb; const int map=i&1,k=i>>1;
    if(G==256){ if(k>=4)return false; head=vcu>>3; const int sq=vcu&7; qb=(k==0)?sq:(k==1)?15-sq:(k==2)?16+sq:31-sq; }
    else{ const int L=k*G+vcu; if(L>=1024)return false; head=L>>5; qb=31-(L&31); }
    u.b=head>>3; u.hm=2*(head&7)+map; u.qb=qb; return true; }
};
template<class Sched,int THRL=8> __device__ __forceinline__ void attn_phase(char*lds,const AttnTensors&T,const Sched&S,const int wid){
  AttnUnit u;
  for(int i=0;S.next(i,u);++i){ attn_unit<THRL>(u.b,u.hm,u.qb,T.Q,T.K,T.V,T.O,T.GA,T.hg,T.lam,lds,wid); }
}
#undef SBAR
#undef WAIT_BAR
}
constexpr int NWAVES = 8;
constexpr int BATCH = 4, SEQ = 8192, DM = 1024, M = BATCH * SEQ, NPROJ = 6144, MIXW = 2048;
constexpr int NGRP = 64;
constexpr float NORM_EPS = 1e-6f;
constexpr float LAM_INIT = 0.2f;

constexpr size_t MiB = 1u << 20;
constexpr size_t WS_MOD = 0;
constexpr size_t WS_A16 = 256 * 1024;
constexpr size_t WS_A128 = 320 * 1024;
constexpr size_t WS_HGS = 384 * 1024;
constexpr size_t WS_MODP = 512 * 1024;
constexpr size_t WS_WIN = 2 * MiB;
constexpr size_t WS_WGLU = 14 * MiB;
constexpr size_t WS_WOUT = 16 * MiB;
constexpr size_t WS_ROPE = 20 * MiB;
constexpr size_t WS_TT = 22 * MiB;
constexpr size_t WS_WS = 30 * MiB;
constexpr size_t WS_WOT = 34 * MiB;
constexpr size_t WS_Q = 40 * MiB, WS_K = 104 * MiB, WS_V = 168 * MiB, WS_GA = 232 * MiB, WS_GS = 296 * MiB, WS_END = 488 * MiB;
constexpr size_t WS_MIX = 360 * MiB;

constexpr int RING_OFF = 0, RING_BYTES = 131072;
constexpr int LDS_BYTES = 147456;

#define GAS __attribute__((address_space(1)))
#define LAS __attribute__((address_space(3)))
typedef unsigned short bf16;
typedef unsigned v4u __attribute__((ext_vector_type(4)));
typedef unsigned v2u __attribute__((ext_vector_type(2)));
typedef float f32x4 __attribute__((ext_vector_type(4)));
typedef float f32x2v __attribute__((ext_vector_type(2)));
typedef float f32x16 __attribute__((ext_vector_type(16)));
typedef short bf16x8 __attribute__((ext_vector_type(8)));
#define LDS_WAIT() asm volatile("s_waitcnt lgkmcnt(0)" ::: "memory")
__device__ __forceinline__ unsigned f2bf(float f) { unsigned u = __builtin_bit_cast(unsigned, f); return (u + 0x7fffu + ((u >> 16) & 1u)) >> 16; }
__device__ __forceinline__ unsigned pk2(float lo, float hi) { return f2bf(lo) | (f2bf(hi) << 16); }
__device__ __forceinline__ float wave_sum(float v) {
#pragma unroll
    for (int o = 1; o < 64; o <<= 1) v += __shfl_xor(v, o);
    return v;
}

typedef GAS unsigned gu32;
#define XB_TMO      128
#define XB_XCNT(j)  (256  + 64 * (j))
#define XB_XSUB(j)  (1280 + 64 * (j))
#define XB_XGEN(j)  (2304 + 64 * (j))
#define XB_TOP      3328
#define XB_TOPGEN   3392
#define XCD_BAR_WORDS 3456
#define XB_SPIN_CAP (1u << 18)

__device__ __forceinline__ unsigned xb_ld(unsigned* p)              { return __hip_atomic_load(p, __ATOMIC_RELAXED, __HIP_MEMORY_SCOPE_AGENT); }
__device__ __forceinline__ unsigned xb_add(unsigned* p, unsigned v) { return __hip_atomic_fetch_add(p, v, __ATOMIC_RELAXED, __HIP_MEMORY_SCOPE_AGENT); }
__device__ __forceinline__ unsigned xb_xcc_id() { return (unsigned)__builtin_amdgcn_s_getreg((3 << 11) | 20) & 0xFu; }
#define XB_SPIN(cond, bar) do { unsigned _sp = 0; while (cond) { __builtin_amdgcn_s_sleep(1); \
    if ((++_sp & 255u) == 0u) { if (xb_ld(&(bar)[XB_TMO])) break; if (_sp > XB_SPIN_CAP) { atomicAdd(&(bar)[XB_TMO], 1u); break; } } } } while (0)

struct XcdBarrier {
    unsigned* bar; unsigned x;
    volatile LAS unsigned* st;
};

__device__ __forceinline__ XcdBarrier xcd_barrier_post(unsigned* bar, volatile LAS unsigned* st) {
    XcdBarrier b; b.bar = bar; b.x = xb_xcc_id(); b.st = st;
    if (threadIdx.x == 0) (void)xb_add(&bar[XB_XCNT(b.x)], 1u);
    return b;
}
__device__ __forceinline__ void xcd_barrier_complete(unsigned* bar, unsigned x, unsigned& nloc, unsigned& nx) {
    const unsigned G = gridDim.x * gridDim.y * gridDim.z;
    unsigned sum, cnt, mine, sp = 0u;
    for (;;) {
        sum = 0u; cnt = 0u; mine = 0u;
#pragma unroll
        for (unsigned j = 0; j < 16; ++j) { const unsigned c = xb_ld(&bar[XB_XCNT(j)]); sum += c; cnt += (c > 0u) ? 1u : 0u; mine = (j == x) ? c : mine; }
        if (sum == G) break;
        __builtin_amdgcn_s_sleep(1);
        if ((++sp & 255u) == 0u) { if (xb_ld(&bar[XB_TMO])) break; if (sp > XB_SPIN_CAP) { atomicAdd(&bar[XB_TMO], 1u); break; } }
    }
    nloc = mine > 0u ? mine : 1u; nx = cnt > 0u ? cnt : 1u;
}

__device__ __forceinline__ void xcd_barrier(const XcdBarrier& b) {
    asm volatile("s_waitcnt vmcnt(0)" ::: "memory");
    __syncthreads();
    if (threadIdx.x == 0) {
        unsigned* bar = b.bar;
        __builtin_amdgcn_s_waitcnt(0);
        unsigned nloc = b.st[0], nx = b.st[1];
        if (nloc == 0u) { xcd_barrier_complete(bar, b.x, nloc, nx); b.st[0] = nloc; b.st[1] = nx; }
        const unsigned old = xb_add(&bar[XB_XSUB(b.x)], 1u);
        const unsigned gen = old / nloc;
        if (old + 1u == (gen + 1u) * nloc) {
            __builtin_amdgcn_fence(__ATOMIC_RELEASE, "agent");
            asm volatile("s_waitcnt vmcnt(0)" ::: "memory");
            const unsigned og = xb_add(&bar[XB_TOP], 1u);
            const unsigned tg = og / nx;
            if (og + 1u == (tg + 1u) * nx) xb_add(&bar[XB_TOPGEN], 1u);
            else XB_SPIN(xb_ld(&bar[XB_TOPGEN]) == tg, bar);
            __builtin_amdgcn_fence(__ATOMIC_ACQUIRE, "agent");
            xb_add(&bar[XB_XGEN(b.x)], 1u);
            asm volatile("s_waitcnt vmcnt(0)" ::: "memory");
        } else {
            XB_SPIN(xb_ld(&bar[XB_XGEN(b.x)]) == gen, bar);
            __builtin_amdgcn_fence(__ATOMIC_ACQUIRE, "agent");
            asm volatile("s_waitcnt vmcnt(0)" ::: "memory");
        }
    }
    __syncthreads();
}

constexpr size_t WS_BAR = 1 * MiB;
constexpr size_t WS_SDONE = WS_BAR + 16384;
constexpr int LDS_BARST = 147456 - 16;

struct Args { const float* in[24]; float* out; unsigned char* ws; int cg_sync; int pad; };

struct Frame {
    LAS unsigned char* lds;
    int wave, vcu, G;
    const float* x; const float* c; const float* w_ada; const float* b_ada; const float* norm_g; const float* w_in; const float* qg; const float* kg;
    const float *lq1, *lk1, *lq2, *lk2; const float* hg;
    const float *a_re, *a_im, *log_dt, *b_re, *b_im, *c_re, *c_im, *dsk; const float* w_glu; const float* b_glu; const float* w_out;
    float* out;
    float* MOD; float* MODP; float* HGS; f32x2v* A16; f32x2v* A128; float* ROPE;
    bf16 *WIN, *WGLU, *WOUT, *TT, *WS, *WOT, *Q, *K, *V, *GA, *GS, *MIX, *XN, *GY, *UC;
};

__device__ __forceinline__ void p0_transpose_item(const float* W, int K, int N, bf16* WT, int k0, int src_n0, int dst_n0, LAS float* scr, int lane) {
#pragma unroll 8
    for (int i = 0; i < 32; ++i) { const int kk = 2 * i + (lane >> 5); scr[kk * 33 + (lane & 31)] = __builtin_nontemporal_load(W + (size_t)(k0 + kk) * N + src_n0 + (lane & 31)); }
    LDS_WAIT(); asm volatile("" ::: "memory");
    const int c = lane & 7;
#pragma unroll
    for (int j = 0; j < 4; ++j) { const int n = (lane >> 3) + 8 * j; const LAS float* s = scr + (8 * c) * 33 + n;
        v4u o; o.x = pk2(s[0 * 33], s[1 * 33]); o.y = pk2(s[2 * 33], s[3 * 33]); o.z = pk2(s[4 * 33], s[5 * 33]); o.w = pk2(s[6 * 33], s[7 * 33]);
        *(v4u*)(WT + (size_t)(dst_n0 + n) * K + k0 + 8 * c) = o; }
    LDS_WAIT(); asm volatile("" ::: "memory");
}
__device__ __forceinline__ int win_src_col(int n) {
    const int tt = n >> 10, w = n & 1023;
    if (tt >= 2) return n;
    const int p4 = w >> 8, bj = (w >> 7) & 1, wc = (w >> 5) & 3, j = w & 31;
    return tt * 1024 + (p4 * 4 + wc) * 64 + bj * 32 + j;
}
__device__ __forceinline__ void cpow_lambda(double ar, double ai, double dt, double j, float& re, float& im) {
    const double mag = exp(ar * dt * j);
    double rev = ai * dt * j * 0.15915494309189535; rev -= rint(rev);
    const float ang = (float)(rev * 6.283185307179586);
    re = (float)mag * cosf(ang); im = (float)mag * sinf(ang);
}

__device__ __forceinline__ void p0_ssm_tables(Frame& F, int g, int pt) {
    LAS float* Apr = (LAS float*)(F.lds);
    LAS float* Api = Apr + 17 * 64;
    LAS float* Bbr = Api + 17 * 64;
    LAS float* Bbi = Bbr + 1024;
    LAS float* Cr = Bbi + 1024;
    LAS float* Ci = Cr + 1024;
    LAS float* Kj = Ci + 1024;
    LAS float* Fr = Kj + 4096;
    LAS float* Fi = Fr + 64;
    const int tid = (F.wave * 64 + lane_id());
    const double dt = exp((double)F.log_dt[g]);
    for (int idx = tid; idx < 17 * 64; idx += 512) { const int p = idx & 63, j = idx >> 6; float re, im;
        cpow_lambda((double)F.a_re[g * 64 + p], (double)F.a_im[g * 64 + p], dt, (double)j, re, im); Apr[idx] = re; Api[idx] = im; }
    if (tid < 64) { const int p = tid; const double ar = (double)F.a_re[g * 64 + p], ai = (double)F.a_im[g * 64 + p];
        const double mag = exp(ar * dt); double rev = ai * dt * 0.15915494309189535; rev -= rint(rev); const double ang = rev * 6.283185307179586;
        const double abr = mag * (double)cosf((float)ang), abi = mag * (double)sinf((float)ang);
        const double nr = abr - 1.0, ni = abi, den = ar * ar + ai * ai;
        Fr[p] = (float)((nr * ar + ni * ai) / den); Fi[p] = (float)((ni * ar - nr * ai) / den);
        float re, im; cpow_lambda(ar, ai, dt, 16.0, re, im); F.A16[g * 64 + p] = (f32x2v){re, im};
        cpow_lambda(ar, ai, dt, 128.0, re, im); F.A128[g * 64 + p] = (f32x2v){re, im}; }
    for (int idx = tid; idx < 1024; idx += 512) { Cr[idx] = F.c_re[g * 1024 + idx]; Ci[idx] = F.c_im[g * 1024 + idx]; }
    __syncthreads();
    for (int idx = tid; idx < 1024; idx += 512) { const int p = idx >> 4; const float br = F.b_re[g * 1024 + idx], bi = F.b_im[g * 1024 + idx];
        Bbr[idx] = Fr[p] * br - Fi[p] * bi; Bbi[idx] = Fr[p] * bi + Fi[p] * br; }
    __syncthreads();
    for (int idx0 = tid; idx0 < 1024; idx0 += 512) { const int j = idx0 >> 6, ho = 4 * pt + ((idx0 >> 4) & 3), hi = idx0 & 15, idx = (j * 16 + ho) * 16 + hi; float s = 0.f;
        for (int p = 0; p < 64; ++p) { const float cr = Cr[ho * 64 + p], ci = Ci[ho * 64 + p], ar = Apr[j * 64 + p], ai = Api[j * 64 + p];
            const float car = cr * ar - ci * ai, cai = cr * ai + ci * ar; s += car * Bbr[p * 16 + hi] - cai * Bbi[p * 16 + hi]; }
        Kj[idx] = s; }
    __syncthreads();
    bf16* TTg = F.TT + (size_t)g * 65536; bf16* WSg = F.WS + (size_t)g * 32768; bf16* WOg = F.WOT + (size_t)g * 32768;
    for (int idx = tid; idx < 64 * 32; idx += 512) { const int ri = idx >> 5, t = ri >> 2, ho = 4 * pt + (ri & 3), n = t * 16 + ho, k0 = (idx & 31) * 8, s = k0 >> 4, hi0 = k0 & 15;
        const float dv = F.dsk[g * 16 + ho]; float v[8];
#pragma unroll
        for (int e = 0; e < 8; ++e) { const int hi = hi0 + e; float xv = (s <= t) ? Kj[((t - s) * 16 + ho) * 16 + hi] : 0.f; if (s == t && hi == ho) xv += dv; v[e] = xv; }
        v4u o; o.x = pk2(v[0], v[1]); o.y = pk2(v[2], v[3]); o.z = pk2(v[4], v[5]); o.w = pk2(v[6], v[7]);
        *(v4u*)(TTg + ((((n >> 5) * 16 + (k0 >> 4)) * 64) + ((k0 >> 3) & 1) * 32 + (n & 31)) * 8) = o; }
    for (int idx = tid; idx < 32 * 32; idx += 512) { const int n = 32 * pt + (idx >> 5), p = n >> 1, c = n & 1, k0 = (idx & 31) * 8, s = k0 >> 4, hi0 = k0 & 15, j = 15 - s;
        const float ar = Apr[j * 64 + p], ai = Api[j * 64 + p]; float v[8];
#pragma unroll
        for (int e = 0; e < 8; ++e) { const float br = Bbr[p * 16 + hi0 + e], bi = Bbi[p * 16 + hi0 + e]; v[e] = (c == 0) ? (ar * br - ai * bi) : (ar * bi + ai * br); }
        v4u o; o.x = pk2(v[0], v[1]); o.y = pk2(v[2], v[3]); o.z = pk2(v[4], v[5]); o.w = pk2(v[6], v[7]);
        *(v4u*)(WSg + ((((n >> 5) * 16 + (k0 >> 4)) * 64) + ((k0 >> 3) & 1) * 32 + (n & 31)) * 8) = o; }
    for (int idx = tid; idx < 64 * 16; idx += 512) { const int ri = idx >> 4, t = ri >> 2, ho = 4 * pt + (ri & 3), n = t * 16 + ho, k0 = (idx & 15) * 8, p0 = k0 >> 1, j = t + 1; float v[8];
#pragma unroll
        for (int q = 0; q < 4; ++q) { const int p = p0 + q; const float cr = Cr[ho * 64 + p], ci = Ci[ho * 64 + p], ar = Apr[j * 64 + p], ai = Api[j * 64 + p];
            v[2 * q] = cr * ar - ci * ai; v[2 * q + 1] = -(cr * ai + ci * ar); }
        v4u o; o.x = pk2(v[0], v[1]); o.y = pk2(v[2], v[3]); o.z = pk2(v[4], v[5]); o.w = pk2(v[6], v[7]);
        *(v4u*)(WOg + ((((n >> 5) * 8 + (k0 >> 4)) * 64) + ((k0 >> 3) & 1) * 32 + (n & 31)) * 8) = o; }
    __syncthreads();
}

__device__ __forceinline__ void p0_gemv(Frame& F) {
    const int gw = F.vcu * NWAVES + F.wave, NGW = F.G * NWAVES;
    for (int it = gw; it < 8 * 48; it += NGW) {
        const int kc = it / 48, cc = it % 48, kq = lane_id() >> 4, col = cc * 64 + (lane_id() & 15) * 4;
        f32x4 a0 = {0.f, 0.f, 0.f, 0.f}, a1 = a0, a2 = a0, a3 = a0;
#pragma unroll 8
        for (int kk = 0; kk < 32; ++kk) { const int k = kc * 128 + kq * 32 + kk; const f32x4 w = __builtin_nontemporal_load((const f32x4*)(F.w_ada + (size_t)k * 3072 + col));
            a0 += w * pg8::silu_f(F.c[k]); a1 += w * pg8::silu_f(F.c[1024 + k]); a2 += w * pg8::silu_f(F.c[2048 + k]); a3 += w * pg8::silu_f(F.c[3072 + k]); }
#pragma unroll
        for (int e = 0; e < 4; ++e) { a0[e] += __shfl_xor(a0[e], 16); a0[e] += __shfl_xor(a0[e], 32); a1[e] += __shfl_xor(a1[e], 16); a1[e] += __shfl_xor(a1[e], 32);
            a2[e] += __shfl_xor(a2[e], 16); a2[e] += __shfl_xor(a2[e], 32); a3[e] += __shfl_xor(a3[e], 16); a3[e] += __shfl_xor(a3[e], 32); }
        if (kq == 0) { float* pp = F.MODP + (size_t)kc * 12288 + col; *(f32x4*)(pp) = a0; *(f32x4*)(pp + 3072) = a1; *(f32x4*)(pp + 6144) = a2; *(f32x4*)(pp + 9216) = a3; }
    }
}
__device__ __forceinline__ void p0_rest(Frame& F) {
    for (int u = F.vcu; u < 4 * NGRP; u += F.G) p0_ssm_tables(F, u >> 2, u & 3);
    __syncthreads();
    LAS float* scr = (LAS float*)(F.lds + RING_OFF + F.wave * 16384);
    const int gw = F.vcu * NWAVES + F.wave, NGW = F.G * NWAVES;
    if (F.vcu == 0 && F.wave == 0) { const int l_ = lane_id(); F.HGS[l_] = F.hg[l_] * (1.0f - LAM_INIT); F.HGS[64 + l_] = F.hg[64 + l_] * (1.0f - LAM_INIT); }
    for (int idx = (F.vcu * NWAVES + F.wave) * 64 + lane_id(); idx < 8192 * 32; idx += F.G * 512) {
        const int pos = idx >> 5, i = idx & 31;
        const float inv = 1.0f / powf(10000.0f, (float)(2 * i) / 64.0f);
        const float angf = (float)pos * inv;
        double rev = (double)angf * 0.15915494309189535; rev -= rint(rev);
        const float a = (float)(rev * 6.283185307179586);
        F.ROPE[idx] = cosf(a); F.ROPE[8192 * 32 + idx] = sinf(a);
    }
    constexpr int I_IN = 16 * 192, I_GLU = 16 * 32, I_OUT = 32 * 32;
    for (int it = gw; it < I_IN + I_GLU + I_OUT; it += NGW) {
        int r = it;
        if (r < I_IN) { const int kb = r / 192, nb = r % 192; p0_transpose_item(F.w_in, 1024, NPROJ, F.WIN, 64 * kb, win_src_col(32 * nb), 32 * nb, scr, lane_id()); continue; } r -= I_IN;
        if (r < I_GLU) { const int kb = r / 32, nb = r % 32; p0_transpose_item(F.w_glu, 1024, 1024, F.WGLU, 64 * kb, 32 * nb, 32 * nb, scr, lane_id()); continue; } r -= I_GLU;
        { const int kb = r / 32, nb = r % 32; p0_transpose_item(F.w_out, 2048, 1024, F.WOUT, 64 * kb, 32 * nb, 32 * nb, scr, lane_id()); }
    }
}

__device__ __forceinline__ void p0b_rows(Frame& F) {
    LAS float* modl = (LAS float*)(F.lds);
    for (int q = (F.wave * 64 + lane_id()); q < 3072; q += 512) { const int b = q / 768, c4 = (q % 768) * 4;
        f32x4 v = *(const f32x4*)(F.b_ada + c4);
#pragma unroll
        for (int kc = 0; kc < 8; ++kc) v += *(const f32x4*)(F.MODP + (size_t)kc * 12288 + b * 3072 + c4);
        *(LAS f32x4*)(modl + b * 3072 + c4) = v;
        if (F.vcu == 0) *(f32x4*)(F.MOD + b * 3072 + c4) = v; }
    __syncthreads();
    const int gw = F.vcu * NWAVES + F.wave, NGW = F.G * NWAVES;
    for (int blk = gw; blk < M / 16; blk += NGW) {
        const int m0 = blk * 16, b = m0 >> 13;
        f32x4 g[4], sh[4], sc[4];
#pragma unroll
        for (int j = 0; j < 4; ++j) { const int col = 4 * lane_id() + 256 * j; g[j] = *(const f32x4*)(F.norm_g + col);
            sh[j] = *(const LAS f32x4*)(modl + b * 3072 + col); sc[j] = *(const LAS f32x4*)(modl + b * 3072 + 1024 + col) + 1.0f; g[j] = g[j] * sc[j]; }
        f32x4 v[4], nx[4];
        { const f32x4* xr = (const f32x4*)(F.x + (size_t)m0 * DM) + lane_id();
#pragma unroll
          for (int j = 0; j < 4; ++j) nx[j] = __builtin_nontemporal_load(xr + 64 * j); }
        for (int i = 0; i < 16; ++i) {
            const int m = m0 + i; float s = 0.f;
#pragma unroll
            for (int j = 0; j < 4; ++j) { v[j] = nx[j]; s += (v[j].x * v[j].x + v[j].y * v[j].y) + (v[j].z * v[j].z + v[j].w * v[j].w); }
            if (i + 1 < 16) { const f32x4* xr = (const f32x4*)(F.x + (size_t)(m + 1) * DM) + lane_id();
#pragma unroll
                for (int j = 0; j < 4; ++j) nx[j] = __builtin_nontemporal_load(xr + 64 * j); }
            const float rstd = __builtin_amdgcn_rsqf(wave_sum(s) * (1.0f / DM) + NORM_EPS);
            unsigned long long* o8 = (unsigned long long*)(F.XN + (size_t)m * DM) + lane_id();
#pragma unroll
            for (int j = 0; j < 4; ++j) { const f32x4 h = v[j] * rstd * g[j] + sh[j];
                o8[64 * j] = (unsigned long long)pk2(h.x, h.y) | ((unsigned long long)pk2(h.z, h.w) << 32); }
        }
    }
    __syncthreads();
}

__device__ __forceinline__ int crow16(int r, int hi) { return (r & 3) + 8 * (r >> 2) + 4 * hi; }
constexpr int SSM_UB = 0, SSM_UBB = 33792, SSM_HL = 67584, SSM_HP = 100352, SSM_EX = 117760;
static_assert(SSM_EX + 4096 <= RING_BYTES, "SSM LDS map");
__device__ __forceinline__ void ssm_unit(Frame& F, int b, int g) {
    LAS float* HL = (LAS float*)(F.lds + SSM_HL);
    LAS bf16* YT = (LAS bf16*)(F.lds + SSM_HL);
    LAS bf16* HP = (LAS bf16*)(F.lds + SSM_HP);
    LAS float* EX = (LAS float*)(F.lds + SSM_EX);
    const bf16* Uc = F.UC + (size_t)(b * 64 + g) * 8192 * 16;
    const bf16* TTg = F.TT + (size_t)g * 65536; const bf16* WSg = F.WS + (size_t)g * 32768; const bf16* WOg = F.WOT + (size_t)g * 32768;
    bf16* GYb = F.GY + (size_t)b * SEQ * DM + g * 16;
    const int tid = (F.wave * 64 + lane_id()), lane = lane_id(), w = F.wave, r = lane & 31, h = lane >> 5;
    const f32x2v a16 = F.A16[g * 64 + lane], a128 = F.A128[g * 64 + lane];
    float car = 0.f, cai = 0.f;
    bf16x8 wsf[16];
    { const bf16* wf0 = WSg + (size_t)((w & 3) * 16) * 512 + lane * 8;
#pragma unroll
      for (int j = 0; j < 16; ++j) wsf[j] = *(const bf16x8*)(wf0 + j * 512); }
    v4u pre[4];
#pragma unroll
    for (int i = 0; i < 4; ++i) pre[i] = *(const v4u*)(Uc + (size_t)(tid + i * 512) * 8);
#pragma unroll
    for (int i = 0; i < 4; ++i) { const int q = tid + i * 512; *(LAS v4u*)(F.lds + SSM_UB + (q >> 5) * 528 + (q & 31) * 16) = pre[i]; }
    for (int seg = 0; seg < 8; ++seg) {
        LAS unsigned char* UB = F.lds + SSM_UB + (seg & 1) * SSM_UBB;
        if (seg + 1 < 8) {
#pragma unroll
            for (int i = 0; i < 4; ++i) pre[i] = *(const v4u*)(Uc + (size_t)(seg + 1) * 16384 + (size_t)(tid + i * 512) * 8);
        }
        __syncthreads();
        {
            const int mb = w >> 2, nb = w & 3;
            f32x16 acc0 = {}, acc1 = {};
            const bf16* wf = WSg + (size_t)(nb * 16) * 512 + lane * 8;
            const LAS unsigned char* ua = UB + (mb * 32 + r) * 528 + h * 16;
#pragma unroll
            for (int j = 0; j < 16; j += 2) {
                const bf16x8 a0 = *(const LAS bf16x8*)(ua + j * 32), a1 = *(const LAS bf16x8*)(ua + j * 32 + 32);
                acc0 = __builtin_amdgcn_mfma_f32_32x32x16_bf16(a0, wsf[j], acc0, 0, 0, 0);
                acc1 = __builtin_amdgcn_mfma_f32_32x32x16_bf16(a1, wsf[j + 1], acc1, 0, 0, 0);
            }
#pragma unroll
            for (int i = 0; i < 16; ++i) HL[(mb * 32 + crow16(i, h)) * 128 + nb * 32 + r] = acc0[i] + acc1[i];
        }
        __syncthreads();
        {
            const int c0 = w * 8; float er = 0.f, ei = 0.f;
#pragma unroll
            for (int i = 0; i < 8; ++i) { const f32x2v hl = *(const LAS f32x2v*)(HL + (c0 + i) * 128 + 2 * lane);
                const float nr = a16.x * er - a16.y * ei + hl.x, ni = a16.x * ei + a16.y * er + hl.y; er = nr; ei = ni; }
            *(LAS f32x2v*)(EX + (w * 64 + lane) * 2) = (f32x2v){er, ei};
            __syncthreads();
            float hr = car, hi_ = cai, ir = 0.f, ii = 0.f;
#pragma unroll
            for (int v = 0; v < 8; ++v) { if (v == w) { ir = hr; ii = hi_; }
                const f32x2v e = *(const LAS f32x2v*)(EX + (v * 64 + lane) * 2);
                const float nr = a128.x * hr - a128.y * hi_ + e.x, ni = a128.x * hi_ + a128.y * hr + e.y; hr = nr; hi_ = ni; }
            car = hr; cai = hi_;
            hr = ir; hi_ = ii;
#pragma unroll
            for (int i = 0; i < 8; ++i) { *(LAS unsigned*)(HP + (c0 + i) * 136 + 2 * lane) = pg8::cvt_pk_bf16(hr, hi_);
                const f32x2v hl = *(const LAS f32x2v*)(HL + (c0 + i) * 128 + 2 * lane);
                const float nr = a16.x * hr - a16.y * hi_ + hl.x, ni = a16.x * hi_ + a16.y * hr + hl.y; hr = nr; hi_ = ni; }
        }
        if (seg + 1 < 8) {
#pragma unroll
            for (int i = 0; i < 4; ++i) { const int q = tid + i * 512; *(LAS v4u*)(F.lds + SSM_UB + ((seg + 1) & 1) * SSM_UBB + (q >> 5) * 528 + (q & 31) * 16) = pre[i]; }
        }
        __syncthreads();
        {
            const bf16* tf = TTg + (size_t)(w * 16) * 512 + lane * 8; const bf16* of = WOg + (size_t)(w * 8) * 512 + lane * 8;
            const LAS unsigned char* ua = UB + r * 528 + h * 16;
            const LAS bf16* hp = HP + r * 136 + 8 * h;
            f32x16 acc0 = {}, acc1 = {};
#pragma unroll
            for (int kb = 0; kb < 16; kb += 8) {
                bf16x8 bq[8];
#pragma unroll
                for (int j = 0; j < 8; ++j) bq[j] = *(const bf16x8*)(tf + (kb + j) * 512);
                asm volatile("" ::: "memory");
#pragma unroll
                for (int j = 0; j < 8; ++j) {
                    const bf16x8 a0 = *(const LAS bf16x8*)(ua + (kb + j) * 32), a1 = *(const LAS bf16x8*)(ua + 32 * 528 + (kb + j) * 32);
                    acc0 = __builtin_amdgcn_mfma_f32_32x32x16_bf16(a0, bq[j], acc0, 0, 0, 0);
                    acc1 = __builtin_amdgcn_mfma_f32_32x32x16_bf16(a1, bq[j], acc1, 0, 0, 0); }
            }
            {
                bf16x8 bq[8];
#pragma unroll
                for (int j = 0; j < 8; ++j) bq[j] = *(const bf16x8*)(of + j * 512);
                asm volatile("" ::: "memory");
#pragma unroll
                for (int j = 0; j < 8; ++j) {
                    const bf16x8 a0 = *(const LAS bf16x8*)(hp + j * 16), a1 = *(const LAS bf16x8*)(hp + 32 * 136 + j * 16);
                    acc0 = __builtin_amdgcn_mfma_f32_32x32x16_bf16(a0, bq[j], acc0, 0, 0, 0);
                    acc1 = __builtin_amdgcn_mfma_f32_32x32x16_bf16(a1, bq[j], acc1, 0, 0, 0); }
            }
#pragma unroll
            for (int i = 0; i < 16; ++i) { const int cl = crow16(i, h);
                const unsigned pk = pg8::cvt_pk_bf16(pg8::gelu_tanh_f(acc0[i]), pg8::gelu_tanh_f(acc1[i]));
                YT[cl * 256 + 32 * w + r] = (bf16)(pk & 0xffffu); YT[(32 + cl) * 256 + 32 * w + r] = (bf16)(pk >> 16); }
        }
        __syncthreads();
#pragma unroll
        for (int i = 0; i < 4; ++i) { const int q = tid + i * 512; const v4u v = *(const LAS v4u*)(F.lds + SSM_HL + q * 16);
            *(v4u*)(GYb + (size_t)(seg * 1024 + (q >> 1)) * DM + (q & 1) * 8) = v; }
    }
    __syncthreads();
}

__global__ void __launch_bounds__(NWAVES * 64, 2) hybrid_fwd(Args args) {
    extern __shared__ __attribute__((aligned(16))) unsigned char lds[];
    cg::grid_group grid = cg::this_grid();
    Frame F;
    F.lds = (LAS unsigned char*)lds;
    F.wave = __builtin_amdgcn_readfirstlane((int)threadIdx.x >> 6);
    F.G = gridDim.x; { const int bx = blockIdx.x; F.vcu = (F.G % 8 == 0) ? (bx % 8) * (F.G / 8) + bx / 8 : bx; }
    unsigned char* ws = args.ws;
    F.x = args.in[0]; F.c = args.in[1]; F.w_ada = args.in[2]; F.b_ada = args.in[3]; F.norm_g = args.in[4]; F.w_in = args.in[5]; F.qg = args.in[6]; F.kg = args.in[7];
    F.lq1 = args.in[8]; F.lk1 = args.in[9]; F.lq2 = args.in[10]; F.lk2 = args.in[11]; F.hg = args.in[12];
    F.a_re = args.in[13]; F.a_im = args.in[14]; F.log_dt = args.in[15]; F.b_re = args.in[16]; F.b_im = args.in[17]; F.c_re = args.in[18]; F.c_im = args.in[19]; F.dsk = args.in[20];
    F.w_glu = args.in[21]; F.b_glu = args.in[22]; F.w_out = args.in[23]; F.out = args.out;
    F.MOD = (float*)(ws + WS_MOD); F.A16 = (f32x2v*)(ws + WS_A16); F.A128 = (f32x2v*)(ws + WS_A128); F.MODP = (float*)(ws + WS_MODP); F.HGS = (float*)(ws + WS_HGS); F.ROPE = (float*)(ws + WS_ROPE);
    F.WIN = (bf16*)(ws + WS_WIN); F.WGLU = (bf16*)(ws + WS_WGLU); F.WOUT = (bf16*)(ws + WS_WOUT); F.TT = (bf16*)(ws + WS_TT); F.WS = (bf16*)(ws + WS_WS); F.WOT = (bf16*)(ws + WS_WOT);
    F.Q = (bf16*)(ws + WS_Q); F.K = (bf16*)(ws + WS_K); F.V = (bf16*)(ws + WS_V); F.GA = (bf16*)(ws + WS_GA); F.GS = (bf16*)(ws + WS_GS); F.MIX = (bf16*)(ws + WS_MIX);
    F.XN = (bf16*)args.out; F.GY = (bf16*)args.out; F.UC = (bf16*)((unsigned char*)args.out + 64 * MiB);

    unsigned* barw = (unsigned*)(ws + WS_BAR);
    if (threadIdx.x < 2) ((volatile LAS unsigned*)(F.lds + LDS_BARST))[threadIdx.x] = 0u;
    __syncthreads();
    const XcdBarrier bar = xcd_barrier_post(barw, (volatile LAS unsigned*)(F.lds + LDS_BARST));
    p0_gemv(F);
    if (args.cg_sync) grid.sync();
    xcd_barrier(bar);
    p0b_rows(F);
    p0_rest(F);
    xcd_barrier(bar);
    {
        pg8::Gemm g{F.XN, F.WIN, M, NPROJ, DM}; pg8::StaticOrder S; S.init(M, NPROJ, F.G, (int)blockIdx.x);
        pg8::EpiProj E{F.Q, F.K, F.V, F.GA, F.GS, F.UC, F.ROPE, F.ROPE + 8192 * 32, F.qg, F.kg};
        pg8::gemm_phase<pg8::EpiProj, pg8::StaticOrder, true, true>(F.lds + RING_OFF, g, S, E, F.wave);
    }
    xcd_barrier(bar);
    unsigned* sdone = (unsigned*)(ws + WS_SDONE);
    for (int u = F.vcu; u < BATCH * NGRP; u += F.G) {
        ssm_unit(F, u & 3, u >> 2);
        asm volatile("s_waitcnt vmcnt(0)" ::: "memory");
        __syncthreads();
        if (threadIdx.x == 0) { __builtin_amdgcn_fence(__ATOMIC_RELEASE, "agent"); asm volatile("s_waitcnt vmcnt(0)" ::: "memory"); (void)xb_add(sdone, 1u); }
    }
    {
        const int ln_ = lane_id();
        const float s1_ = wave_sum(F.lq1[ln_] * F.lk1[ln_]), s2_ = wave_sum(F.lq2[ln_] * F.lk2[ln_]);
        const float lam_ = __expf(s1_) - __expf(s2_) + LAM_INIT;
        const attn_body::AttnTensors AT{(const attn_body::bf16*)F.Q, (const attn_body::bf16*)F.K, (const attn_body::bf16*)F.V, (attn_body::bf16*)F.MIX, (const attn_body::bf16*)F.GA, F.HGS, lam_};
        const attn_body::AttnOrder S((int)F.G, F.vcu);
        attn_body::attn_phase<attn_body::AttnOrder>((char*)lds + RING_OFF, AT, S, F.wave);
    }
    if (threadIdx.x == 0) {
        unsigned sp_ = 0u;
        while (xb_ld(sdone) < (unsigned)(BATCH * NGRP)) { __builtin_amdgcn_s_sleep(2); if (++sp_ > (1u << 22)) break; }
        __builtin_amdgcn_fence(__ATOMIC_ACQUIRE, "agent");
        asm volatile("s_waitcnt vmcnt(0)" ::: "memory");
    }
    __syncthreads();
    {
        pg8::Gemm g{F.GY, F.WGLU, M, DM, DM}; pg8::StaticOrder S; S.init(M, DM, F.G, (int)blockIdx.x);
        pg8::EpiGlu E{F.GY, F.GS, F.b_glu, F.MIX};
        pg8::gemm_phase<pg8::EpiGlu, pg8::StaticOrder, true, true>(F.lds + RING_OFF, g, S, E, F.wave);
    }
    xcd_barrier(bar);
    {
        pg8::Gemm g{F.MIX, F.WOUT, M, DM, MIXW}; pg8::StaticOrder S; S.init(M, DM, F.G, (int)blockIdx.x);
        pg8::EpiOut E{F.x, F.MOD, F.out};
        pg8::gemm_phase<pg8::EpiOut, pg8::StaticOrder, true, true>(F.lds + RING_OFF, g, S, E, F.wave);
    }
}

extern "C" void kernel_launch(void* const* d_in, const int* in_sizes, int n_in, void* d_out, int out_size, void* d_ws, size_t ws_size, hipStream_t stream) {
    static int grid = 0;
    if (grid == 0) {
        if (n_in != 24 || out_size != M * DM || ws_size < WS_END) { fprintf(stderr, "kernel_launch: unexpected shapes (n_in %d out %d ws %zu); nothing launched\n", n_in, out_size, ws_size); grid = -1; return; }
        int dev = 0, cus = 0, per_cu = 0;
        if (hipGetDevice(&dev) != hipSuccess || hipDeviceGetAttribute(&cus, hipDeviceAttributeMultiprocessorCount, dev) != hipSuccess) { grid = -1; return; }
        if (hipFuncSetAttribute((const void*)hybrid_fwd, hipFuncAttributeMaxDynamicSharedMemorySize, LDS_BYTES) != hipSuccess) { fprintf(stderr, "kernel_launch: hipFuncSetAttribute failed\n"); grid = -1; return; }
        if (hipOccupancyMaxActiveBlocksPerMultiprocessor(&per_cu, (const void*)hybrid_fwd, NWAVES * 64, LDS_BYTES) != hipSuccess || per_cu < 1) { fprintf(stderr, "kernel_launch: occupancy query says %d blocks per CU\n", per_cu); per_cu = 1; }
        (void)hipGetLastError();
        grid = cus * 1;
        fprintf(stderr, "kernel_launch: grid %d (per_cu query %d), ws %zu\n", grid, per_cu, ws_size);
    }
    if (grid < 0) return;
    if (hipMemsetAsync((char*)d_ws + WS_BAR, 0, 16384 + 256, stream) != hipSuccess) { fprintf(stderr, "kernel_launch: hipMemsetAsync of the barrier words failed; nothing launched\n"); return; }
    Args a{};
    for (int i = 0; i < 24; ++i) a.in[i] = (const float*)d_in[i];
    a.out = (float*)d_out; a.ws = (unsigned char*)d_ws;
    void* kargs[] = {&a};
    const hipError_t e = hipLaunchCooperativeKernel((const void*)hybrid_fwd, dim3(grid), dim3(NWAVES * 64), kargs, LDS_BYTES, stream);
    if (e != hipSuccess) fprintf(stderr, "kernel_launch: cooperative launch failed: %s (grid %d)\n", hipGetErrorString(e), grid);
}
```

```cpp
#include <hip/hip_runtime.h>
#include <hip/hip_cooperative_groups.h>
#include <cstdio>
#include <cstdint>
namespace cg = cooperative_groups;
__device__ __forceinline__ int lane_id() { int t = (int)threadIdx.x; asm volatile("" : "+v"(t)); return t & 63; }
namespace pg8 {
#define PG8_LAS __attribute__((address_space(3)))
typedef unsigned short bf16_t;
typedef short bf16x8 __attribute__((ext_vector_type(8)));
typedef float f32x4 __attribute__((ext_vector_type(4)));
typedef unsigned u32x4 __attribute__((ext_vector_type(4)));
constexpr int BM = 256, BK = 64, HALF = 128, HTB = HALF * BK * 2  , STAGE_BYTES = 8 * HTB, NXCD = 8, WGM = 8;

__host__ __device__ __forceinline__ int lds_byte(int r, int c) { const int st = (r >> 4) * 2 + (c >> 5), rr = r & 15, cc = c & 31, ob = rr * 64 + cc * 2; return st * 1024 + (ob ^ (((ob >> 9) & 1) << 5)); }
__host__ __device__ __forceinline__ void stage_rc(int b, int& R, int& C) { const int st = b / 1024, sb = b % 1024, swz = sb ^ (((sb >> 9) & 1) << 5); R = (st >> 1) * 16 + swz / 64; C = (st & 1) * 32 + (swz % 64) / 2; }
__host__ __device__ __forceinline__ int perm32(int rho) { const int n = rho >> 4, i = rho & 15; return 8 * (i >> 2) + 4 * n + (i & 3); }

struct Unit { int pm, pn; };
struct Gemm { const bf16_t* A; const bf16_t* Bt; int M, N, K; };

struct StaticOrder {
    int nM, nN, nwg, G, c;
    __host__ __device__ void init(int M, int N, int G_, int c_) { nM = M / BM; nN = N / BM; nwg = nM * nN; G = G_; c = c_; }
    __host__ __device__ bool next(int i, Unit& u) const {
        const long L = (long)i * G + c; if (L >= nwg) return false;
        int wgid = (int)L; { const int q = nwg / NXCD, r = nwg % NXCD, xcd = wgid % NXCD, off = wgid / NXCD; wgid = (xcd < r ? xcd * (q + 1) : r * (q + 1) + (xcd - r) * q) + off; }
        const int nig = WGM * nN, gid = wgid / nig, fm = gid * WGM, gsz = (nM - fm) < WGM ? (nM - fm) : WGM;
        u.pm = fm + ((wgid % nig) % gsz); u.pn = (wgid % nig) / gsz; return true;
    }
    __device__ __forceinline__ void a_ready(const Unit&) const {}
    __device__ __forceinline__ void done(const Unit&) const {}
};

__device__ __forceinline__ unsigned cvt_pk_bf16(float lo, float hi) { unsigned r; asm volatile("v_cvt_pk_bf16_f32 %0, %1, %2" : "=v"(r) : "v"(lo), "v"(hi)); return r; }
typedef float f32x2 __attribute__((ext_vector_type(2)));
__device__ __forceinline__ float sigmoid_f(float x) { return __builtin_amdgcn_rcpf(1.0f + __expf(-x)); }
__device__ __forceinline__ float silu_f(float x) { return x * sigmoid_f(x); }
__device__ __forceinline__ float gelu_tanh_f(float y) { const float t = y * y; const float p = __builtin_fmaf(t, -0.10294324f, -2.3022082f);
    return y * __builtin_amdgcn_rcpf(1.0f + __builtin_amdgcn_exp2f(y * p)); }
__device__ __forceinline__ float bf_lo(unsigned w) { return __builtin_bit_cast(float, w << 16); }
__device__ __forceinline__ float bf_hi(unsigned w) { return __builtin_bit_cast(float, w & 0xffff0000u); }
constexpr float QSCALE = 0.125f * 1.4426950408889634f;

struct EpiProj {
    static constexpr bool PERM = true, AFTER_DRAIN = false;
    bf16_t *Q, *K, *V, *GA, *GS, *UC; const float* rope_cos; const float* rope_sin; const float* qg; const float* kg;
    __device__ __forceinline__ void operator()(const f32x4 (&acc)[2][2][4][2], const Unit& u, int wr, int wc, int fr, int fq) const {
        const int tt = u.pn >> 2, p4 = u.pn & 3;
        const int row0 = u.pm * BM + wr * 64 + fr;
        if (tt < 2) {
            const float* gw = (tt == 0) ? qg : kg; bf16_t* dst = (tt == 0) ? Q : K; const float sc = (tt == 0) ? QSCALE : 1.0f;
            f32x4 gv[2][2];
#pragma unroll
            for (int bj = 0; bj < 2; ++bj)
#pragma unroll
                for (int n = 0; n < 2; ++n) gv[bj][n] = *(const f32x4*)(gw + bj * 32 + 8 * fq + 4 * n) * sc;
            const int hm = p4 * 4 + wc;
#pragma unroll
            for (int ai = 0; ai < 2; ++ai)
#pragma unroll
                for (int m = 0; m < 4; ++m) {
                    const int row = row0 + ai * HALF + m * 16; const int s = row & 8191;
                    f32x4 v[2][2]; float ss = 0.f;
#pragma unroll
                    for (int bj = 0; bj < 2; ++bj)
#pragma unroll
                        for (int n = 0; n < 2; ++n) { v[bj][n] = acc[ai][bj][m][n]; const f32x4 q = v[bj][n] * v[bj][n]; ss += (q[0] + q[1]) + (q[2] + q[3]); }
                    ss += __shfl_xor(ss, 16); ss += __shfl_xor(ss, 32);
                    const float rs = __builtin_amdgcn_rsqf(ss * (1.0f / 64.0f) + 1e-6f);
                    u32x4 w0, w1;
                    {
                        const f32x4 c0 = *(const f32x4*)(rope_cos + s * 32 + 8 * fq), c1 = *(const f32x4*)(rope_cos + s * 32 + 8 * fq + 4);
                        const f32x4 s0 = *(const f32x4*)(rope_sin + s * 32 + 8 * fq), s1 = *(const f32x4*)(rope_sin + s * 32 + 8 * fq + 4);
                        const f32x4 a0 = v[0][0] * rs * gv[0][0], a1 = v[0][1] * rs * gv[0][1], b0 = v[1][0] * rs * gv[1][0], b1 = v[1][1] * rs * gv[1][1];
                        const f32x4 o10 = a0 * c0 - b0 * s0, o11 = a1 * c1 - b1 * s1, o20 = b0 * c0 + a0 * s0, o21 = b1 * c1 + a1 * s1;
                        w0.x = cvt_pk_bf16(o10[0], o10[1]); w0.y = cvt_pk_bf16(o10[2], o10[3]); w0.z = cvt_pk_bf16(o11[0], o11[1]); w0.w = cvt_pk_bf16(o11[2], o11[3]);
                        w1.x = cvt_pk_bf16(o20[0], o20[1]); w1.y = cvt_pk_bf16(o20[2], o20[3]); w1.z = cvt_pk_bf16(o21[0], o21[1]); w1.w = cvt_pk_bf16(o21[2], o21[3]);
                    }
                    bf16_t* rp = dst + (size_t)row * 1024 + hm * 64 + 8 * fq;
                    if (tt == 0) { __builtin_nontemporal_store(w0, (u32x4*)(rp)); __builtin_nontemporal_store(w1, (u32x4*)(rp + 32)); }
                    else { *(u32x4*)(rp) = w0; *(u32x4*)(rp + 32) = w1; }
                }
        } else {
#pragma unroll
            for (int ai = 0; ai < 2; ++ai)
#pragma unroll
                for (int m = 0; m < 4; ++m) {
                    const int row = row0 + ai * HALF + m * 16;
#pragma unroll
                    for (int bj = 0; bj < 2; ++bj) {
                        f32x4 v0 = acc[ai][bj][m][0], v1 = acc[ai][bj][m][1];
                        const int col = p4 * 256 + bj * HALF + wc * 32 + 8 * fq;
                        if (tt == 3 || tt == 5) {
#pragma unroll
                            for (int e = 0; e < 4; ++e) { v0[e] = silu_f(v0[e]); v1[e] = silu_f(v1[e]); }
                        }
                        u32x4 w; w.x = cvt_pk_bf16(v0[0], v0[1]); w.y = cvt_pk_bf16(v0[2], v0[3]); w.z = cvt_pk_bf16(v1[0], v1[1]); w.w = cvt_pk_bf16(v1[2], v1[3]);
                        if (tt == 4) {
                            const int b = row >> 13, s = row & 8191, g = col >> 4;
                            *(u32x4*)(UC + ((size_t)(b * 64 + g) * 8192 + s) * 16 + (col & 15)) = w;
                        } else {
                            if (tt == 2) *(u32x4*)(V + (size_t)row * 1024 + col) = w;
                            else __builtin_nontemporal_store(w, (u32x4*)(((tt == 3) ? GA : GS) + (size_t)row * 1024 + col));
                        }
                    }
                }
        }
    }
};

struct EpiGlu {
    static constexpr bool PERM = true, AFTER_DRAIN = false;
    const bf16_t* GY; const bf16_t* GS; const float* bias; bf16_t* MIX;
    __device__ __forceinline__ void operator()(const f32x4 (&acc)[2][2][4][2], const Unit& u, int wr, int wc, int fr, int fq) const {
        const int row0 = u.pm * BM + wr * 64 + fr, col0 = u.pn * BM + wc * 32 + 8 * fq;
        f32x4 bv[2][2];
#pragma unroll
        for (int bj = 0; bj < 2; ++bj)
#pragma unroll
            for (int n = 0; n < 2; ++n) bv[bj][n] = *(const f32x4*)(bias + col0 + bj * HALF + 4 * n);
#pragma unroll
        for (int ai = 0; ai < 2; ++ai)
#pragma unroll
            for (int m = 0; m < 4; ++m) {
                const int row = row0 + ai * HALF + m * 16;
#pragma unroll
                for (int bj = 0; bj < 2; ++bj) {
                    const int col = col0 + bj * HALF;
                    const u32x4 gy = *(const u32x4*)(GY + (size_t)row * 1024 + col), gs = *(const u32x4*)(GS + (size_t)row * 1024 + col);
                    const f32x4 v0 = acc[ai][bj][m][0] + bv[bj][0], v1 = acc[ai][bj][m][1] + bv[bj][1];
                    u32x4 w;
                    w.x = cvt_pk_bf16(bf_lo(gy.x) * sigmoid_f(v0[0]) * bf_lo(gs.x), bf_hi(gy.x) * sigmoid_f(v0[1]) * bf_hi(gs.x));
                    w.y = cvt_pk_bf16(bf_lo(gy.y) * sigmoid_f(v0[2]) * bf_lo(gs.y), bf_hi(gy.y) * sigmoid_f(v0[3]) * bf_hi(gs.y));
                    w.z = cvt_pk_bf16(bf_lo(gy.z) * sigmoid_f(v1[0]) * bf_lo(gs.z), bf_hi(gy.z) * sigmoid_f(v1[1]) * bf_hi(gs.z));
                    w.w = cvt_pk_bf16(bf_lo(gy.w) * sigmoid_f(v1[2]) * bf_lo(gs.w), bf_hi(gy.w) * sigmoid_f(v1[3]) * bf_hi(gs.w));
                    *(u32x4*)(MIX + (size_t)row * 2048 + 1024 + col) = w;
                }
            }
    }
};

struct EpiOut {
    static constexpr bool PERM = true, AFTER_DRAIN = false;
    const float* x; const float* mod; float* out;
    __device__ __forceinline__ void operator()(const f32x4 (&acc)[2][2][4][2], const Unit& u, int wr, int wc, int fr, int fq) const {
        const int row0 = u.pm * BM + wr * 64 + fr, col0 = u.pn * BM + wc * 32 + 8 * fq;
        const int b = (u.pm * BM) >> 13;
        f32x4 gv[2][2];
#pragma unroll
        for (int bj = 0; bj < 2; ++bj)
#pragma unroll
            for (int n = 0; n < 2; ++n) gv[bj][n] = *(const f32x4*)(mod + b * 3072 + 2048 + col0 + bj * HALF + 4 * n);
#pragma unroll
        for (int ai = 0; ai < 2; ++ai)
#pragma unroll
            for (int mh = 0; mh < 2; ++mh) {
                f32x4 xv[2][2][2];
#pragma unroll
                for (int mm = 0; mm < 2; ++mm) { const size_t off = (size_t)(row0 + ai * HALF + (2 * mh + mm) * 16) * 1024 + col0;
#pragma unroll
                    for (int bj = 0; bj < 2; ++bj)
#pragma unroll
                        for (int n = 0; n < 2; ++n) xv[mm][bj][n] = __builtin_nontemporal_load((const f32x4*)(x + off + bj * HALF + 4 * n)); }
                asm volatile("" ::: "memory");
#pragma unroll
                for (int mm = 0; mm < 2; ++mm) { const size_t off = (size_t)(row0 + ai * HALF + (2 * mh + mm) * 16) * 1024 + col0;
#pragma unroll
                    for (int bj = 0; bj < 2; ++bj)
#pragma unroll
                        for (int n = 0; n < 2; ++n) *(f32x4*)(out + off + bj * HALF + 4 * n) = xv[mm][bj][n] + gv[bj][n] * acc[ai][bj][2 * mh + mm][n]; }
                asm volatile("" ::: "memory");
            }
    }
};
template <class Epi, class Sched, bool ALIGN_EPI = false, bool SP2 = false>
__device__ __forceinline__ void gemm_phase(PG8_LAS unsigned char* lds, const Gemm g, const Sched& S, const Epi& E, const int wid) {
    const int lane = lane_id(), tid = wid * 64 + lane, wr = wid >> 2, wc = wid & 3, fr = lane & 15, fq = lane >> 4;
    const int K = g.K, nt = K / BK;
    unsigned voffA[2], voffB[2];
#pragma unroll
    for (int i = 0; i < 2; ++i) { int R, C; stage_rc(tid * 16 + i * 8192, R, C); const int Rb = Epi::PERM ? ((R & ~31) + perm32(R & 31)) : R;
        voffA[i] = (unsigned)(R * K + C) * 2u; voffB[i] = (unsigned)(Rb * K + C) * 2u; }
    const size_t kstep = (size_t)(BK * 2);
    const size_t hstep = (size_t)HALF * K * 2;
    const size_t tstep = 2 * hstep;
    const unsigned ldsw = (unsigned)wid * 1024u;
    const int aoff = lds_byte(wr * 64 + fr, fq * 8), boff = lds_byte(wc * 32 + fr, fq * 8);
#define PG8_SA(b, h) (((b) * 2 + (h)) * HTB)
#define PG8_SB(b, h) ((4 + (b) * 2 + (h)) * HTB)
#define PG8_STAGE(bufoff, gbase, voff) do { _Pragma("unroll") for (int _i = 0; _i < 2; ++_i) \
        __builtin_amdgcn_global_load_lds((const unsigned*)((const char*)(gbase) + (voff)[_i]), (PG8_LAS unsigned*)(lds + (bufoff) + ldsw + _i * 8192), 16, 0, 0); } while (0)
#define PG8_LDA(dst, b, h) do { _Pragma("unroll") for (int m = 0; m < 4; ++m) _Pragma("unroll") for (int k = 0; k < 2; ++k) dst[m][k] = *(const PG8_LAS bf16x8*)(lds + PG8_SA(b, h) + aoff + m * 2048 + k * 1024); } while (0)
#define PG8_LDB(dst, b, h) do { _Pragma("unroll") for (int n = 0; n < 2; ++n) _Pragma("unroll") for (int k = 0; k < 2; ++k) dst[n][k] = *(const PG8_LAS bf16x8*)(lds + PG8_SB(b, h) + boff + n * 2048 + k * 1024); } while (0)
#define PG8_MMA(ai, bj, At, Bt) do { __builtin_amdgcn_s_setprio(1); _Pragma("unroll") for (int m = 0; m < 4; ++m) _Pragma("unroll") for (int n = 0; n < 2; ++n) _Pragma("unroll") for (int k = 0; k < 2; ++k) \
        acc[ai][bj][m][n] = __builtin_amdgcn_mfma_f32_16x16x32_bf16(Bt[n][k], At[m][k], acc[ai][bj][m][n], 0, 0, 0); __builtin_amdgcn_s_setprio(0); } while (0)
#define PG8_WAIT_V(n) asm volatile("s_waitcnt vmcnt(" #n ")" ::: "memory")
#define PG8_WAIT_L(n) asm volatile("s_waitcnt lgkmcnt(" #n ")" ::: "memory")
#define PG8_BAR __builtin_amdgcn_s_barrier()
#define PG8_SCHED __builtin_amdgcn_sched_barrier(0)
    Unit cur, nxt; int ui = 0;
    if (!S.next(0, cur)) return;
    f32x4 acc[2][2][4][2];
#pragma unroll
    for (int a = 0; a < 2; ++a)
#pragma unroll
        for (int b = 0; b < 2; ++b)
#pragma unroll
            for (int m = 0; m < 4; ++m)
#pragma unroll
                for (int n = 0; n < 2; ++n) acc[a][b][m][n] = (f32x4){0.f, 0.f, 0.f, 0.f};
    bf16x8 At[4][2], B0[2][2], B1[2][2];
    const char* cA = (const char*)g.A + (size_t)cur.pm * tstep; const char* cB = (const char*)g.Bt + (size_t)cur.pn * tstep;
    S.a_ready(cur);
    if constexpr (SP2) {
        PG8_STAGE(PG8_SB(0, 0), cB, voffB); PG8_STAGE(PG8_SB(0, 1), cB + hstep, voffB); PG8_STAGE(PG8_SA(0, 0), cA, voffA); PG8_STAGE(PG8_SA(0, 1), cA + hstep, voffA);
        if (wr == 1) PG8_BAR;
        PG8_WAIT_V(2); PG8_BAR;
        PG8_STAGE(PG8_SB(1, 0), cB + kstep, voffB); PG8_STAGE(PG8_SA(1, 0), cA + kstep, voffA); PG8_STAGE(PG8_SB(1, 1), cB + hstep + kstep, voffB);
        PG8_WAIT_V(6); PG8_BAR;
    } else {
        PG8_STAGE(PG8_SB(0, 0), cB, voffB); PG8_STAGE(PG8_SA(0, 0), cA, voffA); PG8_STAGE(PG8_SB(0, 1), cB + hstep, voffB); PG8_STAGE(PG8_SA(0, 1), cA + hstep, voffA);
        if (wr == 1) PG8_BAR;
        PG8_WAIT_V(4); PG8_BAR;
        PG8_STAGE(PG8_SB(1, 0), cB + kstep, voffB); PG8_STAGE(PG8_SA(1, 0), cA + kstep, voffA); PG8_STAGE(PG8_SB(1, 1), cB + hstep + kstep, voffB);
        PG8_WAIT_V(6); PG8_BAR;
    }
    for (;;) {
        const bool has_next = S.next(ui + 1, nxt);
        const char* nA = has_next ? (const char*)g.A + (size_t)nxt.pm * tstep : cA; const char* nB = has_next ? (const char*)g.Bt + (size_t)nxt.pn * tstep : cB;
        for (int t = 0; t < nt; t += 2) {
            const bool last = (t == nt - 2);
            const char* a1 = cA + (size_t)(t + 1) * kstep;
            const char* a2 = last ? nA : cA + (size_t)(t + 2) * kstep; const char* b2 = last ? nB : cB + (size_t)(t + 2) * kstep;
            const char* a3 = a2 + kstep; const char* b3 = b2 + kstep;
            if (last && has_next) S.a_ready(nxt);
            if constexpr (SP2) {
            PG8_LDB(B0, 0, 0); PG8_LDB(B1, 0, 1); PG8_SCHED; PG8_LDA(At, 0, 0); PG8_STAGE(PG8_SA(1, 1), a1 + hstep, voffA);
            PG8_WAIT_V(8); PG8_WAIT_L(0); PG8_BAR; PG8_MMA(0, 0, At, B0); PG8_MMA(0, 1, At, B1); PG8_BAR; PG8_SCHED;
            PG8_LDA(At, 0, 1); PG8_STAGE(PG8_SB(0, 0), b2, voffB); PG8_STAGE(PG8_SB(0, 1), b2 + hstep, voffB); PG8_STAGE(PG8_SA(0, 0), a2, voffA);
            PG8_WAIT_V(8); PG8_WAIT_L(0); PG8_BAR; PG8_MMA(1, 0, At, B0); PG8_MMA(1, 1, At, B1); PG8_BAR; PG8_SCHED;
            PG8_LDB(B0, 1, 0); PG8_LDB(B1, 1, 1); PG8_SCHED; PG8_LDA(At, 1, 0); PG8_STAGE(PG8_SA(0, 1), a2 + hstep, voffA);
            PG8_WAIT_V(8); PG8_WAIT_L(0); PG8_BAR; PG8_MMA(0, 0, At, B0); PG8_MMA(0, 1, At, B1); PG8_BAR; PG8_SCHED;
            PG8_LDA(At, 1, 1); PG8_STAGE(PG8_SB(1, 0), b3, voffB); PG8_STAGE(PG8_SB(1, 1), b3 + hstep, voffB); PG8_STAGE(PG8_SA(1, 0), a3, voffA);
            PG8_WAIT_V(8); PG8_WAIT_L(0); PG8_BAR; PG8_MMA(1, 0, At, B0); PG8_MMA(1, 1, At, B1); PG8_BAR; PG8_SCHED;
            } else {
            PG8_LDB(B0, 0, 0); PG8_SCHED; PG8_LDA(At, 0, 0); PG8_STAGE(PG8_SA(1, 1), a1 + hstep, voffA);
            PG8_WAIT_L(8); PG8_BAR; PG8_WAIT_L(0); PG8_MMA(0, 0, At, B0); PG8_BAR; PG8_SCHED;
            PG8_LDB(B1, 0, 1); PG8_STAGE(PG8_SB(0, 0), b2, voffB);
            PG8_BAR; PG8_WAIT_L(0); PG8_MMA(0, 1, At, B1); PG8_BAR;
            PG8_LDA(At, 0, 1); PG8_STAGE(PG8_SA(0, 0), a2, voffA);
            PG8_BAR; PG8_WAIT_L(0); PG8_MMA(1, 0, At, B0); PG8_BAR; PG8_SCHED;
            PG8_STAGE(PG8_SB(0, 1), b2 + hstep, voffB);
            PG8_WAIT_V(6); PG8_BAR; PG8_MMA(1, 1, At, B1); PG8_BAR;
            PG8_LDB(B0, 1, 0); PG8_SCHED; PG8_LDA(At, 1, 0); PG8_STAGE(PG8_SA(0, 1), a2 + hstep, voffA);
            PG8_WAIT_L(8); PG8_BAR; PG8_WAIT_L(0); PG8_MMA(0, 0, At, B0); PG8_BAR; PG8_SCHED;
            PG8_LDB(B1, 1, 1); PG8_STAGE(PG8_SB(1, 0), b3, voffB);
            PG8_BAR; PG8_WAIT_L(0); PG8_MMA(0, 1, At, B1); PG8_BAR;
            PG8_LDA(At, 1, 1); PG8_STAGE(PG8_SA(1, 0), a3, voffA);
            PG8_BAR; PG8_WAIT_L(0); PG8_MMA(1, 0, At, B0); PG8_BAR; PG8_SCHED;
            PG8_STAGE(PG8_SB(1, 1), b3 + hstep, voffB);
            PG8_WAIT_V(6); PG8_BAR; PG8_MMA(1, 1, At, B1); PG8_BAR;
            }
        }
        if constexpr (ALIGN_EPI) { if (wr == 0) PG8_BAR; }
        if constexpr (!Epi::AFTER_DRAIN) { E(acc, cur, wr, wc, fr, fq); S.done(cur); }
        if (!has_next) break;
#pragma unroll
        for (int a = 0; a < 2; ++a)
#pragma unroll
            for (int b = 0; b < 2; ++b)
#pragma unroll
                for (int m = 0; m < 4; ++m)
#pragma unroll
                    for (int n = 0; n < 2; ++n) acc[a][b][m][n] = (f32x4){0.f, 0.f, 0.f, 0.f};
        cur = nxt; cA = nA; cB = nB; ++ui;
        if constexpr (ALIGN_EPI) { if (wr == 1) PG8_BAR; }
    }
    PG8_WAIT_V(0);
    if constexpr (!ALIGN_EPI) { if (wr == 0) PG8_BAR; }
    PG8_BAR;
    if constexpr (Epi::AFTER_DRAIN) { E.fused(acc, cur, wr, wc, fr, fq, lds, wid, lane); S.done(cur); }
#undef PG8_SA
#undef PG8_SB
#undef PG8_STAGE
#undef PG8_LDA
#undef PG8_LDB
#undef PG8_MMA
#undef PG8_WAIT_V
#undef PG8_WAIT_L
#undef PG8_BAR
#undef PG8_SCHED
}
}
#include <hip/hip_bf16.h>
#include <cmath>
namespace attn_body {
using bf16=__hip_bfloat16;
using bf16x8=__attribute__((ext_vector_type(8)))short;
using s16x4=__attribute__((ext_vector_type(4)))short;
using f32x16=__attribute__((ext_vector_type(16)))float;
using u32x4=__attribute__((ext_vector_type(4)))unsigned;
constexpr int BATCH=4,NHEAD=16,SEQ=8192,D=64,DM=NHEAD*D,OP=2048;
constexpr int NW=8,QBLK=32,QB=QBLK*NW,KVBLK=64,NQB=SEQ/QB;
constexpr int ATTN_PITCH=DM, ATTN_UNIT_ROWS=QB;
__device__ __forceinline__ int crow(int r,int hi){return (r&3)+8*(r>>2)+4*hi;}
#define SBAR() __builtin_amdgcn_sched_barrier(0)
__device__ __forceinline__ void cmask(f32x16&p0,f32x16&p1,int jb,int qrel,int hi){
  const float NEG=-INFINITY; (void)hi;
  if(jb>(qrel>>6)){
  #pragma unroll
  for(int r=0;r<16;++r){p0[r]=NEG;p1[r]=NEG;}}
}

constexpr int NSLOT=3, SLOTB=8192, SLOTV=16384;
constexpr int LDS_K=0, LDS_V=NSLOT*SLOTB, LDS_WS=LDS_V+NSLOT*SLOTV, LDS_OST=LDS_WS+NW*64*4, LDS_BYTES=LDS_OST+NW*4096;
constexpr float C2=0.125f*1.4426950408889634f;
__device__ __forceinline__ void glds16(const void*gsrc,unsigned lds_dst){unsigned keep;
  asm volatile("s_mov_b32 %0, m0\n\ts_mov_b32 m0, %2\n\ts_nop 0\n\tglobal_load_lds_dwordx4 %1, off\n\ts_mov_b32 m0, %0":"=&s"(keep):"v"(gsrc),"s"(lds_dst):"memory");}
__device__ __forceinline__ float max3f(float a,float b,float c){float r;asm("v_max3_f32 %0, %1, %2, %3":"=v"(r):"v"(a),"v"(b),"v"(c));return r;}
__device__ __forceinline__ float max2f(float a,float b){float r;asm("v_max_f32_e32 %0, %1, %2":"=v"(r):"v"(a),"v"(b));return r;}
__device__ __forceinline__ float fadd_s(float a,float b){float r;asm("v_add_f32_e32 %0, %1, %2":"=v"(r):"v"(a),"v"(b));return r;}
__device__ __forceinline__ float fsub_s(float a,float b){float r;asm("v_sub_f32_e32 %0, %1, %2":"=v"(r):"v"(a),"v"(b));return r;}
typedef float f32x2_t __attribute__((ext_vector_type(2))); typedef __bf16 bf16x2_t __attribute__((ext_vector_type(2)));
__device__ __forceinline__ unsigned cvtpk_s(float lo,float hi){f32x2_t v={lo,hi};bf16x2_t b=__builtin_convertvector(v,bf16x2_t);return __builtin_bit_cast(unsigned,b);}
#define WAIT_BAR(N) asm volatile("s_waitcnt vmcnt(" #N ") lgkmcnt(0)\n\ts_barrier":::"memory")

__device__ __forceinline__ void qkt(f32x16&p0,f32x16&p1,const char*Kslot,const bf16x8*qr,int r32,int hi){
  const f32x16 zero16={};
  const char*kb=Kslot+hi*1024+r32*16;
  #pragma unroll
  for(int d0=0;d0<4;++d0){
    const bf16x8 b0=*reinterpret_cast<const bf16x8*>(kb+d0*2048);
    const bf16x8 b1=*reinterpret_cast<const bf16x8*>(kb+d0*2048+512);
    if(d0==0){p0=__builtin_amdgcn_mfma_f32_32x32x16_bf16(b0,qr[0],zero16,0,0,0);p1=__builtin_amdgcn_mfma_f32_32x32x16_bf16(b1,qr[0],zero16,0,0,0);}
    else{p0=__builtin_amdgcn_mfma_f32_32x32x16_bf16(b0,qr[d0],p0,0,0,0);p1=__builtin_amdgcn_mfma_f32_32x32x16_bf16(b1,qr[d0],p1,0,0,0);}}
}
typedef __attribute__((address_space(3))) const char* lds_cptr;
typedef short v4i16_t __attribute__((ext_vector_type(4)));
__device__ __forceinline__ void kload8(bf16x8*kf,lds_cptr kp){
  kf[0]=*(const __attribute__((address_space(3))) bf16x8*)(kp);      kf[1]=*(const __attribute__((address_space(3))) bf16x8*)(kp+512);
  kf[2]=*(const __attribute__((address_space(3))) bf16x8*)(kp+2048); kf[3]=*(const __attribute__((address_space(3))) bf16x8*)(kp+2560);
  kf[4]=*(const __attribute__((address_space(3))) bf16x8*)(kp+4096); kf[5]=*(const __attribute__((address_space(3))) bf16x8*)(kp+4608);
  kf[6]=*(const __attribute__((address_space(3))) bf16x8*)(kp+6144); kf[7]=*(const __attribute__((address_space(3))) bf16x8*)(kp+6656);
}
__device__ __forceinline__ void kload2(bf16x8*kf,lds_cptr kp,int j){ kf[2*j]=*(const __attribute__((address_space(3))) bf16x8*)(kp+j*2048); kf[2*j+1]=*(const __attribute__((address_space(3))) bf16x8*)(kp+j*2048+512); }
__device__ __forceinline__ s16x4 vtr(lds_cptr p){ return __builtin_bit_cast(s16x4,__builtin_amdgcn_ds_read_tr16_b64_v4i16((__attribute__((address_space(3))) v4i16_t*)p)); }
__device__ __forceinline__ float rowmax(const f32x16&p0,const f32x16&p1){
  float a=max3f(p0[0],p0[1],p1[0]),b=max3f(p0[2],p0[3],p1[1]);a=max3f(a,p1[2],p1[3]);
  #pragma unroll
  for(int r=4;r<16;r+=4){a=max3f(a,p0[r],p0[r+1]);b=max3f(b,p0[r+2],p0[r+3]);a=max3f(a,p1[r],p1[r+1]);b=max3f(b,p1[r+2],p1[r+3]);}
  const float m=max2f(a,b);
  auto rr=__builtin_amdgcn_permlane32_swap(__float_as_uint(m),__float_as_uint(m),false,false);
  return max2f(__uint_as_float(rr[0]),__uint_as_float(rr[1]));
}
__device__ __forceinline__ void pv(f32x16*o,int vb,bf16x8 pa0,bf16x8 pa1,bf16x8 pa2,bf16x8 pa3){
  #pragma unroll
  for(int d0=0;d0<4;++d0){s16x4 lo[4],hi[4];
    #pragma unroll
    for(int ks=0;ks<4;++ks){
      asm volatile("ds_read_b64_tr_b16 %0,%1 offset:%c2":"=&v"(lo[ks]):"v"(vb),"i"(d0*4096+ks*1024):"memory");
      asm volatile("ds_read_b64_tr_b16 %0,%1 offset:%c2":"=&v"(hi[ks]):"v"(vb),"i"(d0*4096+ks*1024+512):"memory");}
    asm volatile("s_waitcnt lgkmcnt(0)":::"memory");SBAR();
    #define PK(k) (bf16x8){lo[k][0],lo[k][1],lo[k][2],lo[k][3],hi[k][0],hi[k][1],hi[k][2],hi[k][3]}
    o[d0]=__builtin_amdgcn_mfma_f32_32x32x16_bf16(pa0,PK(0),o[d0],0,0,0);
    o[d0]=__builtin_amdgcn_mfma_f32_32x32x16_bf16(pa1,PK(1),o[d0],0,0,0);
    o[d0]=__builtin_amdgcn_mfma_f32_32x32x16_bf16(pa2,PK(2),o[d0],0,0,0);
    o[d0]=__builtin_amdgcn_mfma_f32_32x32x16_bf16(pa3,PK(3),o[d0],0,0,0);
    #undef PK
  }
}

#ifndef ATTN_STORE16
#define ATTN_STORE16(p,v) (*(u32x4*)(p)=(v))
#endif
template<int THRL> __device__ __forceinline__ void attn_unit(int b,int h,int qb,const bf16*__restrict__ Q,const bf16*__restrict__ K,const bf16*__restrict__ V,bf16* O,const bf16*__restrict__ GA,const float*__restrict__ hg,const float lam,char*shm,const int wid){
  const int lane=lane_id(),r32=lane&31,hi=lane>>5;
  const long rowbase=(long)b*SEQ; const int q0=qb*QB;
  const bf16*Qw=Q+(rowbase+q0+wid*QBLK)*DM+h*D;
  const bf16*Kh=K+rowbase*DM+h*D,*Vh=V+rowbase*DM+(h>>1)*128;
  const unsigned lds0=(unsigned)(uintptr_t)shm;
  float*wsf=(float*)(shm+LDS_WS)+wid*64;
  const bf16*ksrc=Kh+(long)lane*DM+wid*8;
  const bf16*vsrc=Vh+(long)(16*(wid&3)+(lane>>2))*DM+(wid>>2)*32+(lane&3)*8;
  const unsigned kdst=lds0+LDS_K+wid*1024, vdst=lds0+LDS_V+wid*1024;
  #define DMA_K(t,slot) glds16(ksrc+(long)(t)*KVBLK*DM,(unsigned)__builtin_amdgcn_readfirstlane(kdst+(slot)))
  #define DMA_V(t,slot) do{ glds16(vsrc+(long)(t)*KVBLK*DM,(unsigned)__builtin_amdgcn_readfirstlane(vdst+2*(slot))); glds16(vsrc+64+(long)(t)*KVBLK*DM,(unsigned)__builtin_amdgcn_readfirstlane(vdst+8192+2*(slot))); }while(0)
  const int vb0=(int)(lds0+LDS_V)+((lane>>4)&1)*32+(lane&3)*8+(4*hi+((lane&15)>>2))*64;
  const char*Kbase=shm+LDS_K; bf16x8 kf[8];
  const lds_cptr shm3=(lds_cptr)shm; const lds_cptr kp0=shm3+LDS_K+hi*1024+r32*16; const lds_cptr vp0=shm3+LDS_V+((lane>>4)&1)*32+(lane&3)*8+(4*hi+((lane&15)>>2))*64;
  const int NT=(q0+QB)/KVBLK;
  DMA_K(0,0);DMA_V(0,0);DMA_K(1,SLOTB);
  bf16x8 qr[4];
  #pragma unroll
  for(int d0=0;d0<4;++d0)qr[d0]=*reinterpret_cast<const bf16x8*>(&Qw[(long)r32*DM+d0*16+hi*8]);
  float l_reg=0.f;f32x16 o[4];o[0]=f32x16{};o[1]=f32x16{};o[2]=f32x16{};o[3]=f32x16{};const f32x16 zero16={};
  const int qrel=wid*QBLK;
  #define CMASK(P0,P1,t) do{int jb_=(t)-(NT-4); if(jb_>=0)cmask(P0,P1,jb_,qrel,hi);}while(0)
  bool resc=false;
  #define START(P0,P1) do{ resc=false; \
    _Pragma("unroll") for(int r=0;r<16;++r)P0[r]=__builtin_amdgcn_exp2f(P0[r]); }while(0)
  #define RESC() do{ if(resc){ asm volatile("s_waitcnt lgkmcnt(0)":::"memory"); \
      _Pragma("unroll") for(int d_=0;d_<4;++d_) _Pragma("unroll") for(int r=0;r<16;++r)o[d_][r]*=wsf[crow(r,hi)]; } }while(0)
  f32x16 pA0,pA1,pB0,pB1;
  int sl_prev=0,sl_cur=0,sl_next=SLOTB;
  #define ROT() do{sl_prev=sl_cur;sl_cur=sl_next;sl_next=(sl_next==(NSLOT-1)*SLOTB)?0:sl_next+SLOTB;}while(0)
  DMA_K(2,2*SLOTB);
  WAIT_BAR(3);
  qkt(pA0,pA1,Kbase,qr,r32,hi);asm volatile("s_nop 15\n\ts_nop 7":"+v"(pA0),"+v"(pA1));CMASK(pA0,pA1,0);
  START(pA0,pA1);
  _Pragma("unroll") for(int r=0;r<16;++r)pA1[r]=__builtin_amdgcn_exp2f(pA1[r]);
  WAIT_BAR(0);
  DMA_K(3,0);DMA_V(1,SLOTB);
  ROT();
  kload8(kf,kp0+sl_cur);
  WAIT_BAR(3);
  s16x4 vlo[8],vhi[8]; u32x4 pw0,pw1,pw2,pw3;
  #define PKW(P,B) cvtpk_s(P[B],P[B+1])
  #define PAF(k) __builtin_bit_cast(bf16x8,pw##k)
  #define VFR(i) (bf16x8){vlo[i][0],vlo[i][1],vlo[i][2],vlo[i][3],vhi[i][0],vhi[i][1],vhi[i][2],vhi[i][3]}
  #define PIN(x) asm volatile("":"+v"(x))
  #define MX3(a,b,c) __builtin_fmaxf(__builtin_fmaxf((a),(b)),(c))
  #define GAPA(MF,A0,A1,A2,A3,W0,W1,PW) do{ MF; sacc+=A0; sacc+=A1; sacc+=A2; sacc+=A3; PIN(sacc); W0; W1; PIN(PW); SBAR(); }while(0)
  #define EX(v) __builtin_amdgcn_exp2f(v)
  #define GAPB(MF,RL,X,B) do{ MF; RL; X[B]=EX(X[B]); X[B+1]=EX(X[B+1]); PIN(X); SBAR(); }while(0)
  #define VRD(i) do{ vlo[i]=vtr(vp_+(((i)>>2)*4096+((i)&3)*1024)); vhi[i]=vtr(vp_+(((i)>>2)*4096+((i)&3)*1024+512)); }while(0)
  #define VRD2(i) do{ vlo[i]=vtr(vp_+((((i)>>2)+2)*4096+((i)&3)*1024)); vhi[i]=vtr(vp_+((((i)>>2)+2)*4096+((i)&3)*1024+512)); }while(0)
  #define KRD(G,j) do{ if(G){ kload2(kf,kp0+sl_next,j); SBAR(); } }while(0)
  #define STEP(C0,C1,P0,P1,t,GK,GV,GL) do{ SBAR(); \
    const lds_cptr vp_=vp0+2*sl_prev; \
    VRD(0); SBAR(); float sacc=(P0[0]+P0[1]); \
    GAPA(C0=__builtin_amdgcn_mfma_f32_32x32x16_bf16(kf[0],qr[0],zero16,0,0,0), P0[2],P0[3],P0[4],P0[5],     pw0[0]=PKW(P0,0), pw0[1]=PKW(P0,2), pw0); \
    VRD(4); SBAR(); GAPA(C1=__builtin_amdgcn_mfma_f32_32x32x16_bf16(kf[1],qr[0],zero16,0,0,0), P0[6],P0[7],P0[8],P0[9],     pw0[2]=PKW(P0,4), pw0[3]=PKW(P0,6), pw0); \
    VRD(1); SBAR(); GAPA(C0=__builtin_amdgcn_mfma_f32_32x32x16_bf16(kf[2],qr[1],C0,0,0,0),   P0[10],P0[11],P0[12],P0[13], pw1[0]=PKW(P0,8), pw1[1]=PKW(P0,10), pw1); \
    VRD(5); SBAR(); GAPA(C1=__builtin_amdgcn_mfma_f32_32x32x16_bf16(kf[3],qr[1],C1,0,0,0),   P0[14],P0[15],P1[0],P1[1],   pw1[2]=PKW(P0,12),pw1[3]=PKW(P0,14), pw1); \
    VRD(2); SBAR(); GAPA(C0=__builtin_amdgcn_mfma_f32_32x32x16_bf16(kf[4],qr[2],C0,0,0,0),   P1[2],P1[3],P1[4],P1[5],     pw2[0]=PKW(P1,0), pw2[1]=PKW(P1,2), pw2); \
    VRD(6); SBAR(); GAPA(C1=__builtin_amdgcn_mfma_f32_32x32x16_bf16(kf[5],qr[2],C1,0,0,0),   P1[6],P1[7],P1[8],P1[9],     pw2[2]=PKW(P1,4), pw2[3]=PKW(P1,6), pw2); \
    VRD(3); SBAR(); GAPA(C0=__builtin_amdgcn_mfma_f32_32x32x16_bf16(kf[6],qr[3],C0,0,0,0),   P1[10],P1[11],P1[12],P1[13], pw3[0]=PKW(P1,8), pw3[1]=PKW(P1,10), pw3); \
    VRD(7); SBAR(); GAPA(C1=__builtin_amdgcn_mfma_f32_32x32x16_bf16(kf[7],qr[3],C1,0,0,0),   P1[14],P1[15],0.f,0.f,       pw3[2]=PKW(P1,12),pw3[3]=PKW(P1,14), pw3); \
    l_reg+=sacc; \
    if(GK){DMA_K((t)+3,sl_cur);} if(GV){DMA_V((t)+1,sl_next);} \
    CMASK(C0,C1,t); \
    SBAR(); \
    GAPB(o[0]=__builtin_amdgcn_mfma_f32_32x32x16_bf16(PAF(0),VFR(0),o[0],0,0,0), VRD2(0), C0,0); \
    GAPB(o[1]=__builtin_amdgcn_mfma_f32_32x32x16_bf16(PAF(0),VFR(4),o[1],0,0,0), VRD2(4), C0,2); \
    KRD(GL,0); GAPB(o[0]=__builtin_amdgcn_mfma_f32_32x32x16_bf16(PAF(1),VFR(1),o[0],0,0,0), VRD2(1), C0,4); \
    KRD(GL,1); GAPB(o[1]=__builtin_amdgcn_mfma_f32_32x32x16_bf16(PAF(1),VFR(5),o[1],0,0,0), VRD2(5), C0,6); \
    KRD(GL,2); GAPB(o[0]=__builtin_amdgcn_mfma_f32_32x32x16_bf16(PAF(2),VFR(2),o[0],0,0,0), VRD2(2), C0,8); \
    KRD(GL,3); GAPB(o[1]=__builtin_amdgcn_mfma_f32_32x32x16_bf16(PAF(2),VFR(6),o[1],0,0,0), VRD2(6), C0,10); \
    GAPB(o[0]=__builtin_amdgcn_mfma_f32_32x32x16_bf16(PAF(3),VFR(3),o[0],0,0,0), VRD2(3), C0,12); \
    GAPB(o[1]=__builtin_amdgcn_mfma_f32_32x32x16_bf16(PAF(3),VFR(7),o[1],0,0,0), VRD2(7), C0,14); \
    GAPB(o[2]=__builtin_amdgcn_mfma_f32_32x32x16_bf16(PAF(0),VFR(0),o[2],0,0,0), (void)0, C1,0); \
    GAPB(o[3]=__builtin_amdgcn_mfma_f32_32x32x16_bf16(PAF(0),VFR(4),o[3],0,0,0), (void)0, C1,2); \
    GAPB(o[2]=__builtin_amdgcn_mfma_f32_32x32x16_bf16(PAF(1),VFR(1),o[2],0,0,0), (void)0, C1,4); \
    GAPB(o[3]=__builtin_amdgcn_mfma_f32_32x32x16_bf16(PAF(1),VFR(5),o[3],0,0,0), (void)0, C1,6); \
    GAPB(o[2]=__builtin_amdgcn_mfma_f32_32x32x16_bf16(PAF(2),VFR(2),o[2],0,0,0), (void)0, C1,8); \
    GAPB(o[3]=__builtin_amdgcn_mfma_f32_32x32x16_bf16(PAF(2),VFR(6),o[3],0,0,0), (void)0, C1,10); \
    GAPB(o[2]=__builtin_amdgcn_mfma_f32_32x32x16_bf16(PAF(3),VFR(3),o[2],0,0,0), (void)0, C1,12); \
    GAPB(o[3]=__builtin_amdgcn_mfma_f32_32x32x16_bf16(PAF(3),VFR(7),o[3],0,0,0), (void)0, C1,14); \
    }while(0)
  int t=1;
  #undef CMASK
  #define CMASK(P0,P1,t) do{}while(0)
  for(;t+5<NT;t+=2){
    STEP(pB0,pB1,pA0,pA1,t,true,true,true);     WAIT_BAR(3); RESC(); ROT();
    STEP(pA0,pA1,pB0,pB1,t+1,true,true,true);   WAIT_BAR(3); RESC(); ROT();
  }
  #undef CMASK
  #define CMASK(P0,P1,t) do{int jb_=(t)-(NT-4); if(jb_>=0)cmask(P0,P1,jb_,qrel,hi);}while(0)
  #define ENDW(tt) do{ if((tt)+3<NT){WAIT_BAR(3);} else if((tt)+2<NT){WAIT_BAR(2);} else {WAIT_BAR(0);} }while(0)
  for(;t+1<NT;t+=2){
    STEP(pB0,pB1,pA0,pA1,t,(t+3<NT),(t+1<NT),(t+1<NT));       ENDW(t);   RESC(); ROT();
    STEP(pA0,pA1,pB0,pB1,t+1,(t+4<NT),(t+2<NT),(t+2<NT));     ENDW(t+1); RESC(); ROT();
  }
  STEP(pB0,pB1,pA0,pA1,NT-1,false,false,false); RESC();
  { float sacc=pB0[0]+pB0[1]; _Pragma("unroll") for(int r=2;r<16;++r)sacc+=pB0[r]; _Pragma("unroll") for(int r=0;r<16;++r)sacc+=pB1[r]; l_reg+=sacc;
    pw0=(u32x4){PKW(pB0,0),PKW(pB0,2),PKW(pB0,4),PKW(pB0,6)};pw1=(u32x4){PKW(pB0,8),PKW(pB0,10),PKW(pB0,12),PKW(pB0,14)};pw2=(u32x4){PKW(pB1,0),PKW(pB1,2),PKW(pB1,4),PKW(pB1,6)};pw3=(u32x4){PKW(pB1,8),PKW(pB1,10),PKW(pB1,12),PKW(pB1,14)};
    SBAR(); pv(o,vb0+2*sl_cur,PAF(0),PAF(1),PAF(2),PAF(3)); }
  #undef PKW
  #undef PAF
  #undef VFR
  #undef PIN
  #undef MX3
  #undef GAPA
  #undef GAPB
  #undef EX
  #undef VRD
  #undef KRD
  #undef STEP
  #undef ENDW
  {auto rr=__builtin_amdgcn_permlane32_swap(__float_as_uint(l_reg),__float_as_uint(l_reg),false,false);l_reg=__uint_as_float(rr[0])+__uint_as_float(rr[1]);}
  if(hi==0)wsf[32+r32]=l_reg;asm volatile("s_waitcnt lgkmcnt(0)":::"memory");
  float rli[16];
  #pragma unroll
  for(int r=0;r<16;++r)rli[r]=__builtin_amdgcn_rcpf(wsf[32+crow(r,hi)]);
  const long grow0=rowbase+q0+wid*QBLK;
  bf16*Ow=O+grow0*(long)OP+(h>>1)*128;
  { bf16*stg=(bf16*)(shm+LDS_OST)+wid*2048;
    if((h&1)==0){
    #pragma unroll
    for(int ps=0;ps<2;++ps){
      #pragma unroll
      for(int r=0;r<16;++r){const int orow=crow(r,hi);
        #pragma unroll
        for(int d0=0;d0<2;++d0)stg[orow*64+d0*32+r32]=__float2bfloat16(o[2*ps+d0][r]*rli[r]);}
      asm volatile("s_waitcnt lgkmcnt(0)":::"memory");
      #pragma unroll
      for(int i=0;i<4;++i){const int row=i*8+(lane>>3),ch=lane&7; const u32x4 v=*(const u32x4*)(stg+row*64+ch*8); ATTN_STORE16(Ow+(long)row*OP+ps*64+ch*8,v);}
      asm volatile("s_waitcnt lgkmcnt(0)":::"memory");
    }
    }else{
    float dd[2][4][8]; const int ch=lane&7;
    #pragma unroll
    for(int ps=0;ps<2;++ps){
      #pragma unroll
      for(int r=0;r<16;++r){const int orow=crow(r,hi);
        #pragma unroll
        for(int d0=0;d0<2;++d0)stg[orow*64+d0*32+r32]=__float2bfloat16(o[2*ps+d0][r]*rli[r]);}
      asm volatile("s_waitcnt lgkmcnt(0)":::"memory");
      #pragma unroll
      for(int i=0;i<4;++i){const int row=i*8+(lane>>3); const u32x4 v=*(const u32x4*)(stg+row*64+ch*8); const u32x4 z=*(const u32x4*)(Ow+(long)row*OP+ps*64+ch*8);
        #pragma unroll
        for(int q=0;q<4;++q){ dd[ps][i][2*q]=__builtin_bit_cast(float,z[q]<<16)-lam*__builtin_bit_cast(float,v[q]<<16); dd[ps][i][2*q+1]=__builtin_bit_cast(float,z[q]&0xffff0000u)-lam*__builtin_bit_cast(float,v[q]&0xffff0000u); } }
      asm volatile("s_waitcnt lgkmcnt(0)":::"memory");
    }
    float rs[4];
    #pragma unroll
    for(int i=0;i<4;++i){ float ss=0.f;
      #pragma unroll
      for(int ps=0;ps<2;++ps)
        #pragma unroll
        for(int e=0;e<8;++e)ss+=dd[ps][i][e]*dd[ps][i][e];
      ss+=__shfl_xor(ss,1); ss+=__shfl_xor(ss,2); ss+=__shfl_xor(ss,4);
      rs[i]=__builtin_amdgcn_rsqf(ss*(1.0f/128.0f)+1e-6f); }
    #pragma unroll
    for(int ps=0;ps<2;++ps){ float hgv[8];
      #pragma unroll
      for(int e=0;e<8;++e)hgv[e]=hg[ps*64+ch*8+e];
      #pragma unroll
      for(int i=0;i<4;++i){const int row=i*8+(lane>>3); const u32x4 g=*(const u32x4*)(GA+(grow0+row)*(long)DM+(h>>1)*128+ps*64+ch*8); u32x4 w;
        #pragma unroll
        for(int q=0;q<4;++q) w[q]=cvtpk_s(dd[ps][i][2*q]*rs[i]*hgv[2*q]*__builtin_bit_cast(float,g[q]<<16), dd[ps][i][2*q+1]*rs[i]*hgv[2*q+1]*__builtin_bit_cast(float,g[q]&0xffff0000u));
        ATTN_STORE16(Ow+(long)row*OP+ps*64+ch*8,w); } }
    } }
  asm volatile("s_waitcnt lgkmcnt(0)\n\ts_barrier":::"memory");
  #undef DMA_K
  #undef DMA_V
  #undef CMASK
  #undef START
  #undef RESC
  #undef ROT
}
constexpr int ATTN_LDS_BYTES=LDS_BYTES;
struct AttnTensors { const bf16* Q; const bf16* K; const bf16* V; bf16* O; const bf16* GA; const float* hg; float lam; };
struct AttnUnit { int b, hm, qb; };
struct AttnOrder {
  int vcu, G;
  __device__ __forceinline__ AttnOrder(int grid,int v):vcu(v),G(grid){}
  __device__ __forceinline__ bool next(int i,AttnUnit&u)const{
    int head,qb; const int map=i&1,k=i>>1;
    if(G==256){ if(k>=4)return false; head=vcu>>3; const int sq=vcu&7; qb=(k==0)?sq:(k==1)?15-sq:(k==2)?16+sq:31-sq; }
    else{ const int L=k*G+vcu; if(L>=1024)return false; head=L>>5; qb=31-(L&31); }
    u.b=head>>3; u.hm=2*(head&7)+map; u.qb=qb; return true; }
};
template<class Sched,int THRL=8> __device__ __forceinline__ void attn_phase(char*lds,const AttnTensors&T,const Sched&S,const int wid){
  AttnUnit u;
  for(int i=0;S.next(i,u);++i){ attn_unit<THRL>(u.b,u.hm,u.qb,T.Q,T.K,T.V,T.O,T.GA,T.hg,T.lam,lds,wid); }
}
#undef SBAR
#undef WAIT_BAR
}
constexpr int NWAVES = 8;
constexpr int BATCH = 4, SEQ = 8192, DM = 1024, M = BATCH * SEQ, NPROJ = 6144, MIXW = 2048;
constexpr int NGRP = 64;
constexpr float NORM_EPS = 1e-6f;
constexpr float LAM_INIT = 0.2f;

constexpr size_t MiB = 1u << 20;
constexpr size_t WS_MOD = 0;
constexpr size_t WS_A16 = 256 * 1024;
constexpr size_t WS_A128 = 320 * 1024;
constexpr size_t WS_HGS = 384 * 1024;
constexpr size_t WS_MODP = 512 * 1024;
constexpr size_t WS_WIN = 2 * MiB;
constexpr size_t WS_WGLU = 14 * MiB;
constexpr size_t WS_WOUT = 16 * MiB;
constexpr size_t WS_ROPE = 20 * MiB;
constexpr size_t WS_TT = 22 * MiB;
constexpr size_t WS_WS = 30 * MiB;
constexpr size_t WS_WOT = 34 * MiB;
constexpr size_t WS_Q = 40 * MiB, WS_K = 104 * MiB, WS_V = 168 * MiB, WS_GA = 232 * MiB, WS_GS = 296 * MiB, WS_END = 488 * MiB;
constexpr size_t WS_MIX = 360 * MiB;

constexpr int RING_OFF = 0, RING_BYTES = 131072;
constexpr int LDS_BYTES = 147456;

#define GAS __attribute__((address_space(1)))
#define LAS __attribute__((address_space(3)))
typedef unsigned short bf16;
typedef unsigned v4u __attribute__((ext_vector_type(4)));
typedef unsigned v2u __attribute__((ext_vector_type(2)));
typedef float f32x4 __attribute__((ext_vector_type(4)));
typedef float f32x2v __attribute__((ext_vector_type(2)));
typedef float f32x16 __attribute__((ext_vector_type(16)));
typedef short bf16x8 __attribute__((ext_vector_type(8)));
#define LDS_WAIT() asm volatile("s_waitcnt lgkmcnt(0)" ::: "memory")
__device__ __forceinline__ unsigned f2bf(float f) { unsigned u = __builtin_bit_cast(unsigned, f); return (u + 0x7fffu + ((u >> 16) & 1u)) >> 16; }
__device__ __forceinline__ unsigned pk2(float lo, float hi) { return f2bf(lo) | (f2bf(hi) << 16); }
__device__ __forceinline__ float wave_sum(float v) {
#pragma unroll
    for (int o = 1; o < 64; o <<= 1) v += __shfl_xor(v, o);
    return v;
}

typedef GAS unsigned gu32;
#define XB_TMO      128
#define XB_XCNT(j)  (256  + 64 * (j))
#define XB_XSUB(j)  (1280 + 64 * (j))
#define XB_XGEN(j)  (2304 + 64 * (j))
#define XB_TOP      3328
#define XB_TOPGEN   3392
#define XCD_BAR_WORDS 3456
#define XB_SPIN_CAP (1u << 18)

__device__ __forceinline__ unsigned xb_ld(unsigned* p)              { return __hip_atomic_load(p, __ATOMIC_RELAXED, __HIP_MEMORY_SCOPE_AGENT); }
__device__ __forceinline__ unsigned xb_add(unsigned* p, unsigned v) { return __hip_atomic_fetch_add(p, v, __ATOMIC_RELAXED, __HIP_MEMORY_SCOPE_AGENT); }
__device__ __forceinline__ unsigned xb_xcc_id() { return (unsigned)__builtin_amdgcn_s_getreg((3 << 11) | 20) & 0xFu; }
#define XB_SPIN(cond, bar) do { unsigned _sp = 0; while (cond) { __builtin_amdgcn_s_sleep(1); \
    if ((++_sp & 255u) == 0u) { if (xb_ld(&(bar)[XB_TMO])) break; if (_sp > XB_SPIN_CAP) { atomicAdd(&(bar)[XB_TMO], 1u); break; } } } } while (0)

struct XcdBarrier {
    unsigned* bar; unsigned x;
    volatile LAS unsigned* st;
};

__device__ __forceinline__ XcdBarrier xcd_barrier_post(unsigned* bar, volatile LAS unsigned* st) {
    XcdBarrier b; b.bar = bar; b.x = xb_xcc_id(); b.st = st;
    if (threadIdx.x == 0) (void)xb_add(&bar[XB_XCNT(b.x)], 1u);
    return b;
}
__device__ __forceinline__ void xcd_barrier_complete(unsigned* bar, unsigned x, unsigned& nloc, unsigned& nx) {
    const unsigned G = gridDim.x * gridDim.y * gridDim.z;
    unsigned sum, cnt, mine, sp = 0u;
    for (;;) {
        sum = 0u; cnt = 0u; mine = 0u;
#pragma unroll
        for (unsigned j = 0; j < 16; ++j) { const unsigned c = xb_ld(&bar[XB_XCNT(j)]); sum += c; cnt += (c > 0u) ? 1u : 0u; mine = (j == x) ? c : mine; }
        if (sum == G) break;
        __builtin_amdgcn_s_sleep(1);
        if ((++sp & 255u) == 0u) { if (xb_ld(&bar[XB_TMO])) break; if (sp > XB_SPIN_CAP) { atomicAdd(&bar[XB_TMO], 1u); break; } }
    }
    nloc = mine > 0u ? mine : 1u; nx = cnt > 0u ? cnt : 1u;
}

__device__ __forceinline__ void xcd_barrier(const XcdBarrier& b) {
    asm volatile("s_waitcnt vmcnt(0)" ::: "memory");
    __syncthreads();
    if (threadIdx.x == 0) {
        unsigned* bar = b.bar;
        __builtin_amdgcn_s_waitcnt(0);
        unsigned nloc = b.st[0], nx = b.st[1];
        if (nloc == 0u) { xcd_barrier_complete(bar, b.x, nloc, nx); b.st[0] = nloc; b.st[1] = nx; }
        const unsigned old = xb_add(&bar[XB_XSUB(b.x)], 1u);
        const unsigned gen = old / nloc;
        if (old + 1u == (gen + 1u) * nloc) {
            __builtin_amdgcn_fence(__ATOMIC_RELEASE, "agent");
            asm volatile("s_waitcnt vmcnt(0)" ::: "memory");
            const unsigned og = xb_add(&bar[XB_TOP], 1u);
            const unsigned tg = og / nx;
            if (og + 1u == (tg + 1u) * nx) xb_add(&bar[XB_TOPGEN], 1u);
            else XB_SPIN(xb_ld(&bar[XB_TOPGEN]) == tg, bar);
            __builtin_amdgcn_fence(__ATOMIC_ACQUIRE, "agent");
            xb_add(&bar[XB_XGEN(b.x)], 1u);
            asm volatile("s_waitcnt vmcnt(0)" ::: "memory");
        } else {
            XB_SPIN(xb_ld(&bar[XB_XGEN(b.x)]) == gen, bar);
            __builtin_amdgcn_fence(__ATOMIC_ACQUIRE, "agent");
            asm volatile("s_waitcnt vmcnt(0)" ::: "memory");
        }
    }
    __syncthreads();
}

constexpr size_t WS_BAR = 1 * MiB;
constexpr size_t WS_SDONE = WS_BAR + 16384;
constexpr int LDS_BARST = 147456 - 16;

struct Args { const float* in[24]; float* out; unsigned char* ws; int cg_sync; int pad; };

struct Frame {
    LAS unsigned char* lds;
    int wave, vcu, G;
    const float* x; const float* c; const float* w_ada; const float* b_ada; const float* norm_g; const float* w_in; const float* qg; const float* kg;
    const float *lq1, *lk1, *lq2, *lk2; const float* hg;
    const float *a_re, *a_im, *log_dt, *b_re, *b_im, *c_re, *c_im, *dsk; const float* w_glu; const float* b_glu; const float* w_out;
    float* out;
    float* MOD; float* MODP; float* HGS; f32x2v* A16; f32x2v* A128; float* ROPE;
    bf16 *WIN, *WGLU, *WOUT, *TT, *WS, *WOT, *Q, *K, *V, *GA, *GS, *MIX, *XN, *GY, *UC;
};

__device__ __forceinline__ void p0_transpose_item(const float* W, int K, int N, bf16* WT, int k0, int src_n0, int dst_n0, LAS float* scr, int lane) {
#pragma unroll 8
    for (int i = 0; i < 32; ++i) { const int kk = 2 * i + (lane >> 5); scr[kk * 33 + (lane & 31)] = __builtin_nontemporal_load(W + (size_t)(k0 + kk) * N + src_n0 + (lane & 31)); }
    LDS_WAIT(); asm volatile("" ::: "memory");
    const int c = lane & 7;
#pragma unroll
    for (int j = 0; j < 4; ++j) { const int n = (lane >> 3) + 8 * j; const LAS float* s = scr + (8 * c) * 33 + n;
        v4u o; o.x = pk2(s[0 * 33], s[1 * 33]); o.y = pk2(s[2 * 33], s[3 * 33]); o.z = pk2(s[4 * 33], s[5 * 33]); o.w = pk2(s[6 * 33], s[7 * 33]);
        *(v4u*)(WT + (size_t)(dst_n0 + n) * K + k0 + 8 * c) = o; }
    LDS_WAIT(); asm volatile("" ::: "memory");
}
__device__ __forceinline__ int win_src_col(int n) {
    const int tt = n >> 10, w = n & 1023;
    if (tt >= 2) return n;
    const int p4 = w >> 8, bj = (w >> 7) & 1, wc = (w >> 5) & 3, j = w & 31;
    return tt * 1024 + (p4 * 4 + wc) * 64 + bj * 32 + j;
}
__device__ __forceinline__ void cpow_lambda(double ar, double ai, double dt, double j, float& re, float& im) {
    const double mag = exp(ar * dt * j);
    double rev = ai * dt * j * 0.15915494309189535; rev -= rint(rev);
    const float ang = (float)(rev * 6.283185307179586);
    re = (float)mag * cosf(ang); im = (float)mag * sinf(ang);
}

__device__ __forceinline__ void p0_ssm_tables(Frame& F, int g, int pt) {
    LAS float* Apr = (LAS float*)(F.lds);
    LAS float* Api = Apr + 17 * 64;
    LAS float* Bbr = Api + 17 * 64;
    LAS float* Bbi = Bbr + 1024;
    LAS float* Cr = Bbi + 1024;
    LAS float* Ci = Cr + 1024;
    LAS float* Kj = Ci + 1024;
    LAS float* Fr = Kj + 4096;
    LAS float* Fi = Fr + 64;
    const int tid = (F.wave * 64 + lane_id());
    const double dt = exp((double)F.log_dt[g]);
    for (int idx = tid; idx < 17 * 64; idx += 512) { const int p = idx & 63, j = idx >> 6; float re, im;
        cpow_lambda((double)F.a_re[g * 64 + p], (double)F.a_im[g * 64 + p], dt, (double)j, re, im); Apr[idx] = re; Api[idx] = im; }
    if (tid < 64) { const int p = tid; const double ar = (double)F.a_re[g * 64 + p], ai = (double)F.a_im[g * 64 + p];
        const double mag = exp(ar * dt); double rev = ai * dt * 0.15915494309189535; rev -= rint(rev); const double ang = rev * 6.283185307179586;
        const double abr = mag * (double)cosf((float)ang), abi = mag * (double)sinf((float)ang);
        const double nr = abr - 1.0, ni = abi, den = ar * ar + ai * ai;
        Fr[p] = (float)((nr * ar + ni * ai) / den); Fi[p] = (float)((ni * ar - nr * ai) / den);
        float re, im; cpow_lambda(ar, ai, dt, 16.0, re, im); F.A16[g * 64 + p] = (f32x2v){re, im};
        cpow_lambda(ar, ai, dt, 128.0, re, im); F.A128[g * 64 + p] = (f32x2v){re, im}; }
    for (int idx = tid; idx < 1024; idx += 512) { Cr[idx] = F.c_re[g * 1024 + idx]; Ci[idx] = F.c_im[g * 1024 + idx]; }
    __syncthreads();
    for (int idx = tid; idx < 1024; idx += 512) { const int p = idx >> 4; const float br = F.b_re[g * 1024 + idx], bi = F.b_im[g * 1024 + idx];
        Bbr[idx] = Fr[p] * br - Fi[p] * bi; Bbi[idx] = Fr[p] * bi + Fi[p] * br; }
    __syncthreads();
    for (int idx0 = tid; idx0 < 1024; idx0 += 512) { const int j = idx0 >> 6, ho = 4 * pt + ((idx0 >> 4) & 3), hi = idx0 & 15, idx = (j * 16 + ho) * 16 + hi; float s = 0.f;
        for (int p = 0; p < 64; ++p) { const float cr = Cr[ho * 64 + p], ci = Ci[ho * 64 + p], ar = Apr[j * 64 + p], ai = Api[j * 64 + p];
            const float car = cr * ar - ci * ai, cai = cr * ai + ci * ar; s += car * Bbr[p * 16 + hi] - cai * Bbi[p * 16 + hi]; }
        Kj[idx] = s; }
    __syncthreads();
    bf16* TTg = F.TT + (size_t)g * 65536; bf16* WSg = F.WS + (size_t)g * 32768; bf16* WOg = F.WOT + (size_t)g * 32768;
    for (int idx = tid; idx < 64 * 32; idx += 512) { const int ri = idx >> 5, t = ri >> 2, ho = 4 * pt + (ri & 3), n = t * 16 + ho, k0 = (idx & 31) * 8, s = k0 >> 4, hi0 = k0 & 15;
        const float dv = F.dsk[g * 16 + ho]; float v[8];
#pragma unroll
        for (int e = 0; e < 8; ++e) { const int hi = hi0 + e; float xv = (s <= t) ? Kj[((t - s) * 16 + ho) * 16 + hi] : 0.f; if (s == t && hi == ho) xv += dv; v[e] = xv; }
        v4u o; o.x = pk2(v[0], v[1]); o.y = pk2(v[2], v[3]); o.z = pk2(v[4], v[5]); o.w = pk2(v[6], v[7]);
        *(v4u*)(TTg + ((((n >> 5) * 16 + (k0 >> 4)) * 64) + ((k0 >> 3) & 1) * 32 + (n & 31)) * 8) = o; }
    for (int idx = tid; idx < 32 * 32; idx += 512) { const int n = 32 * pt + (idx >> 5), p = n >> 1, c = n & 1, k0 = (idx & 31) * 8, s = k0 >> 4, hi0 = k0 & 15, j = 15 - s;
        const float ar = Apr[j * 64 + p], ai = Api[j * 64 + p]; float v[8];
#pragma unroll
        for (int e = 0; e < 8; ++e) { const float br = Bbr[p * 16 + hi0 + e], bi = Bbi[p * 16 + hi0 + e]; v[e] = (c == 0) ? (ar * br - ai * bi) : (ar * bi + ai * br); }
        v4u o; o.x = pk2(v[0], v[1]); o.y = pk2(v[2], v[3]); o.z = pk2(v[4], v[5]); o.w = pk2(v[6], v[7]);
        *(v4u*)(WSg + ((((n >> 5) * 16 + (k0 >> 4)) * 64) + ((k0 >> 3) & 1) * 32 + (n & 31)) * 8) = o; }
    for (int idx = tid; idx < 64 * 16; idx += 512) { const int ri = idx >> 4, t = ri >> 2, ho = 4 * pt + (ri & 3), n = t * 16 + ho, k0 = (idx & 15) * 8, p0 = k0 >> 1, j = t + 1; float v[8];
#pragma unroll
        for (int q = 0; q < 4; ++q) { const int p = p0 + q; const float cr = Cr[ho * 64 + p], ci = Ci[ho * 64 + p], ar = Apr[j * 64 + p], ai = Api[j * 64 + p];
            v[2 * q] = cr * ar - ci * ai; v[2 * q + 1] = -(cr * ai + ci * ar); }
        v4u o; o.x = pk2(v[0], v[1]); o.y = pk2(v[2], v[3]); o.z = pk2(v[4], v[5]); o.w = pk2(v[6], v[7]);
        *(v4u*)(WOg + ((((n >> 5) * 8 + (k0 >> 4)) * 64) + ((k0 >> 3) & 1) * 32 + (n & 31)) * 8) = o; }
    __syncthreads();
}

__device__ __forceinline__ void p0_gemv(Frame& F) {
    const int gw = F.vcu * NWAVES + F.wave, NGW = F.G * NWAVES;
    for (int it = gw; it < 8 * 48; it += NGW) {
        const int kc = it / 48, cc = it % 48, kq = lane_id() >> 4, col = cc * 64 + (lane_id() & 15) * 4;
        f32x4 a0 = {0.f, 0.f, 0.f, 0.f}, a1 = a0, a2 = a0, a3 = a0;
#pragma unroll 8
        for (int kk = 0; kk < 32; ++kk) { const int k = kc * 128 + kq * 32 + kk; const f32x4 w = __builtin_nontemporal_load((const f32x4*)(F.w_ada + (size_t)k * 3072 + col));
            a0 += w * pg8::silu_f(F.c[k]); a1 += w * pg8::silu_f(F.c[1024 + k]); a2 += w * pg8::silu_f(F.c[2048 + k]); a3 += w * pg8::silu_f(F.c[3072 + k]); }
#pragma unroll
        for (int e = 0; e < 4; ++e) { a0[e] += __shfl_xor(a0[e], 16); a0[e] += __shfl_xor(a0[e], 32); a1[e] += __shfl_xor(a1[e], 16); a1[e] += __shfl_xor(a1[e], 32);
            a2[e] += __shfl_xor(a2[e], 16); a2[e] += __shfl_xor(a2[e], 32); a3[e] += __shfl_xor(a3[e], 16); a3[e] += __shfl_xor(a3[e], 32); }
        if (kq == 0) { float* pp = F.MODP + (size_t)kc * 12288 + col; *(f32x4*)(pp) = a0; *(f32x4*)(pp + 3072) = a1; *(f32x4*)(pp + 6144) = a2; *(f32x4*)(pp + 9216) = a3; }
    }
}
__device__ __forceinline__ void p0_rest(Frame& F) {
    for (int u = F.vcu; u < 4 * NGRP; u += F.G) p0_ssm_tables(F, u >> 2, u & 3);
    __syncthreads();
    LAS float* scr = (LAS float*)(F.lds + RING_OFF + F.wave * 16384);
    const int gw = F.vcu * NWAVES + F.wave, NGW = F.G * NWAVES;
    if (F.vcu == 0 && F.wave == 0) { const int l_ = lane_id(); F.HGS[l_] = F.hg[l_] * (1.0f - LAM_INIT); F.HGS[64 + l_] = F.hg[64 + l_] * (1.0f - LAM_INIT); }
    for (int idx = (F.vcu * NWAVES + F.wave) * 64 + lane_id(); idx < 8192 * 32; idx += F.G * 512) {
        const int pos = idx >> 5, i = idx & 31;
        const float inv = 1.0f / powf(10000.0f, (float)(2 * i) / 64.0f);
        const float angf = (float)pos * inv;
        double rev = (double)angf * 0.15915494309189535; rev -= rint(rev);
        const float a = (float)(rev * 6.283185307179586);
        F.ROPE[idx] = cosf(a); F.ROPE[8192 * 32 + idx] = sinf(a);
    }
    constexpr int I_IN = 16 * 192, I_GLU = 16 * 32, I_OUT = 32 * 32;
    for (int it = gw; it < I_IN + I_GLU + I_OUT; it += NGW) {
        int r = it;
        if (r < I_IN) { const int kb = r / 192, nb = r % 192; p0_transpose_item(F.w_in, 1024, NPROJ, F.WIN, 64 * kb, win_src_col(32 * nb), 32 * nb, scr, lane_id()); continue; } r -= I_IN;
        if (r < I_GLU) { const int kb = r / 32, nb = r % 32; p0_transpose_item(F.w_glu, 1024, 1024, F.WGLU, 64 * kb, 32 * nb, 32 * nb, scr, lane_id()); continue; } r -= I_GLU;
        { const int kb = r / 32, nb = r % 32; p0_transpose_item(F.w_out, 2048, 1024, F.WOUT, 64 * kb, 32 * nb, 32 * nb, scr, lane_id()); }
    }
}

__device__ __forceinline__ void p0b_rows(Frame& F) {
    LAS float* modl = (LAS float*)(F.lds);
    for (int q = (F.wave * 64 + lane_id()); q < 3072; q += 512) { const int b = q / 768, c4 = (q % 768) * 4;
        f32x4 v = *(const f32x4*)(F.b_ada + c4);
#pragma unroll
        for (int kc = 0; kc < 8; ++kc) v += *(const f32x4*)(F.MODP + (size_t)kc * 12288 + b * 3072 + c4);
        *(LAS f32x4*)(modl + b * 3072 + c4) = v;
        if (F.vcu == 0) *(f32x4*)(F.MOD + b * 3072 + c4) = v; }
    __syncthreads();
    const int gw = F.vcu * NWAVES + F.wave, NGW = F.G * NWAVES;
    for (int blk = gw; blk < M / 16; blk += NGW) {
        const int m0 = blk * 16, b = m0 >> 13;
        f32x4 g[4], sh[4], sc[4];
#pragma unroll
        for (int j = 0; j < 4; ++j) { const int col = 4 * lane_id() + 256 * j; g[j] = *(const f32x4*)(F.norm_g + col);
            sh[j] = *(const LAS f32x4*)(modl + b * 3072 + col); sc[j] = *(const LAS f32x4*)(modl + b * 3072 + 1024 + col) + 1.0f; g[j] = g[j] * sc[j]; }
        f32x4 v[4], nx[4];
        { const f32x4* xr = (const f32x4*)(F.x + (size_t)m0 * DM) + lane_id();
#pragma unroll
          for (int j = 0; j < 4; ++j) nx[j] = __builtin_nontemporal_load(xr + 64 * j); }
        for (int i = 0; i < 16; ++i) {
            const int m = m0 + i; float s = 0.f;
#pragma unroll
            for (int j = 0; j < 4; ++j) { v[j] = nx[j]; s += (v[j].x * v[j].x + v[j].y * v[j].y) + (v[j].z * v[j].z + v[j].w * v[j].w); }
            if (i + 1 < 16) { const f32x4* xr = (const f32x4*)(F.x + (size_t)(m + 1) * DM) + lane_id();
#pragma unroll
                for (int j = 0; j < 4; ++j) nx[j] = __builtin_nontemporal_load(xr + 64 * j); }
            const float rstd = __builtin_amdgcn_rsqf(wave_sum(s) * (1.0f / DM) + NORM_EPS);
            unsigned long long* o8 = (unsigned long long*)(F.XN + (size_t)m * DM) + lane_id();
#pragma unroll
            for (int j = 0; j < 4; ++j) { const f32x4 h = v[j] * rstd * g[j] + sh[j];
                o8[64 * j] = (unsigned long long)pk2(h.x, h.y) | ((unsigned long long)pk2(h.z, h.w) << 32); }
        }
    }
    __syncthreads();
}

__device__ __forceinline__ int crow16(int r, int hi) { return (r & 3) + 8 * (r >> 2) + 4 * hi; }
constexpr int SSM_UB = 0, SSM_UBB = 33792, SSM_HL = 67584, SSM_HP = 100352, SSM_EX = 117760;
static_assert(SSM_EX + 4096 <= RING_BYTES, "SSM LDS map");
__device__ __forceinline__ void ssm_unit(Frame& F, int b, int g) {
    LAS float* HL = (LAS float*)(F.lds + SSM_HL);
    LAS bf16* YT = (LAS bf16*)(F.lds + SSM_HL);
    LAS bf16* HP = (LAS bf16*)(F.lds + SSM_HP);
    LAS float* EX = (LAS float*)(F.lds + SSM_EX);
    const bf16* Uc = F.UC + (size_t)(b * 64 + g) * 8192 * 16;
    const bf16* TTg = F.TT + (size_t)g * 65536; const bf16* WSg = F.WS + (size_t)g * 32768; const bf16* WOg = F.WOT + (size_t)g * 32768;
    bf16* GYb = F.GY + (size_t)b * SEQ * DM + g * 16;
    const int tid = (F.wave * 64 + lane_id()), lane = lane_id(), w = F.wave, r = lane & 31, h = lane >> 5;
    const f32x2v a16 = F.A16[g * 64 + lane], a128 = F.A128[g * 64 + lane];
    float car = 0.f, cai = 0.f;
    bf16x8 wsf[16];
    { const bf16* wf0 = WSg + (size_t)((w & 3) * 16) * 512 + lane * 8;
#pragma unroll
      for (int j = 0; j < 16; ++j) wsf[j] = *(const bf16x8*)(wf0 + j * 512); }
    v4u pre[4];
#pragma unroll
    for (int i = 0; i < 4; ++i) pre[i] = *(const v4u*)(Uc + (size_t)(tid + i * 512) * 8);
#pragma unroll
    for (int i = 0; i < 4; ++i) { const int q = tid + i * 512; *(LAS v4u*)(F.lds + SSM_UB + (q >> 5) * 528 + (q & 31) * 16) = pre[i]; }
    for (int seg = 0; seg < 8; ++seg) {
        LAS unsigned char* UB = F.lds + SSM_UB + (seg & 1) * SSM_UBB;
        if (seg + 1 < 8) {
#pragma unroll
            for (int i = 0; i < 4; ++i) pre[i] = *(const v4u*)(Uc + (size_t)(seg + 1) * 16384 + (size_t)(tid + i * 512) * 8);
        }
        __syncthreads();
        {
            const int mb = w >> 2, nb = w & 3;
            f32x16 acc0 = {}, acc1 = {};
            const bf16* wf = WSg + (size_t)(nb * 16) * 512 + lane * 8;
            const LAS unsigned char* ua = UB + (mb * 32 + r) * 528 + h * 16;
#pragma unroll
            for (int j = 0; j < 16; j += 2) {
                const bf16x8 a0 = *(const LAS bf16x8*)(ua + j * 32), a1 = *(const LAS bf16x8*)(ua + j * 32 + 32);
                acc0 = __builtin_amdgcn_mfma_f32_32x32x16_bf16(a0, wsf[j], acc0, 0, 0, 0);
                acc1 = __builtin_amdgcn_mfma_f32_32x32x16_bf16(a1, wsf[j + 1], acc1, 0, 0, 0);
            }
#pragma unroll
            for (int i = 0; i < 16; ++i) HL[(mb * 32 + crow16(i, h)) * 128 + nb * 32 + r] = acc0[i] + acc1[i];
        }
        __syncthreads();
        {
            const int c0 = w * 8; float er = 0.f, ei = 0.f;
#pragma unroll
            for (int i = 0; i < 8; ++i) { const f32x2v hl = *(const LAS f32x2v*)(HL + (c0 + i) * 128 + 2 * lane);
                const float nr = a16.x * er - a16.y * ei + hl.x, ni = a16.x * ei + a16.y * er + hl.y; er = nr; ei = ni; }
            *(LAS f32x2v*)(EX + (w * 64 + lane) * 2) = (f32x2v){er, ei};
            __syncthreads();
            float hr = car, hi_ = cai, ir = 0.f, ii = 0.f;
#pragma unroll
            for (int v = 0; v < 8; ++v) { if (v == w) { ir = hr; ii = hi_; }
                const f32x2v e = *(const LAS f32x2v*)(EX + (v * 64 + lane) * 2);
                const float nr = a128.x * hr - a128.y * hi_ + e.x, ni = a128.x * hi_ + a128.y * hr + e.y; hr = nr; hi_ = ni; }
            car = hr; cai = hi_;
            hr = ir; hi_ = ii;
#pragma unroll
            for (int i = 0; i < 8; ++i) { *(LAS unsigned*)(HP + (c0 + i) * 136 + 2 * lane) = pg8::cvt_pk_bf16(hr, hi_);
                const f32x2v hl = *(const LAS f32x2v*)(HL + (c0 + i) * 128 + 2 * lane);
                const float nr = a16.x * hr - a16.y * hi_ + hl.x, ni = a16.x * hi_ + a16.y * hr + hl.y; hr = nr; hi_ = ni; }
        }
        if (seg + 1 < 8) {
#pragma unroll
            for (int i = 0; i < 4; ++i) { const int q = tid + i * 512; *(LAS v4u*)(F.lds + SSM_UB + ((seg + 1) & 1) * SSM_UBB + (q >> 5) * 528 + (q & 31) * 16) = pre[i]; }
        }
        __syncthreads();
        {
            const bf16* tf = TTg + (size_t)(w * 16) * 512 + lane * 8; const bf16* of = WOg + (size_t)(w * 8) * 512 + lane * 8;
            const LAS unsigned char* ua = UB + r * 528 + h * 16;
            const LAS bf16* hp = HP + r * 136 + 8 * h;
            f32x16 acc0 = {}, acc1 = {};
#pragma unroll
            for (int kb = 0; kb < 16; kb += 8) {
                bf16x8 bq[8];
#pragma unroll
                for (int j = 0; j < 8; ++j) bq[j] = *(const bf16x8*)(tf + (kb + j) * 512);
                asm volatile("" ::: "memory");
#pragma unroll
                for (int j = 0; j < 8; ++j) {
                    const bf16x8 a0 = *(const LAS bf16x8*)(ua + (kb + j) * 32), a1 = *(const LAS bf16x8*)(ua + 32 * 528 + (kb + j) * 32);
                    acc0 = __builtin_amdgcn_mfma_f32_32x32x16_bf16(a0, bq[j], acc0, 0, 0, 0);
                    acc1 = __builtin_amdgcn_mfma_f32_32x32x16_bf16(a1, bq[j], acc1, 0, 0, 0); }
            }
            {
                bf16x8 bq[8];
#pragma unroll
                for (int j = 0; j < 8; ++j) bq[j] = *(const bf16x8*)(of + j * 512);
                asm volatile("" ::: "memory");
#pragma unroll
                for (int j = 0; j < 8; ++j) {
                    const bf16x8 a0 = *(const LAS bf16x8*)(hp + j * 16), a1 = *(const LAS bf16x8*)(hp + 32 * 136 + j * 16);
                    acc0 = __builtin_amdgcn_mfma_f32_32x32x16_bf16(a0, bq[j], acc0, 0, 0, 0);
                    acc1 = __builtin_amdgcn_mfma_f32_32x32x16_bf16(a1, bq[j], acc1, 0, 0, 0); }
            }
#pragma unroll
            for (int i = 0; i < 16; ++i) { const int cl = crow16(i, h);
                const unsigned pk = pg8::cvt_pk_bf16(pg8::gelu_tanh_f(acc0[i]), pg8::gelu_tanh_f(acc1[i]));
                YT[cl * 256 + 32 * w + r] = (bf16)(pk & 0xffffu); YT[(32 + cl) * 256 + 32 * w + r] = (bf16)(pk >> 16); }
        }
        __syncthreads();
#pragma unroll
        for (int i = 0; i < 4; ++i) { const int q = tid + i * 512; const v4u v = *(const LAS v4u*)(F.lds + SSM_HL + q * 16);
            *(v4u*)(GYb + (size_t)(seg * 1024 + (q >> 1)) * DM + (q & 1) * 8) = v; }
    }
    __syncthreads();
}

__global__ void __launch_bounds__(NWAVES * 64, 2) hybrid_fwd(Args args) {
    extern __shared__ __attribute__((aligned(16))) unsigned char lds[];
    cg::grid_group grid = cg::this_grid();
    Frame F;
    F.lds = (LAS unsigned char*)lds;
    F.wave = __builtin_amdgcn_readfirstlane((int)threadIdx.x >> 6);
    F.G = gridDim.x; { const int bx = blockIdx.x; F.vcu = (F.G % 8 == 0) ? (bx % 8) * (F.G / 8) + bx / 8 : bx; }
    unsigned char* ws = args.ws;
    F.x = args.in[0]; F.c = args.in[1]; F.w_ada = args.in[2]; F.b_ada = args.in[3]; F.norm_g = args.in[4]; F.w_in = args.in[5]; F.qg = args.in[6]; F.kg = args.in[7];
    F.lq1 = args.in[8]; F.lk1 = args.in[9]; F.lq2 = args.in[10]; F.lk2 = args.in[11]; F.hg = args.in[12];
    F.a_re = args.in[13]; F.a_im = args.in[14]; F.log_dt = args.in[15]; F.b_re = args.in[16]; F.b_im = args.in[17]; F.c_re = args.in[18]; F.c_im = args.in[19]; F.dsk = args.in[20];
    F.w_glu = args.in[21]; F.b_glu = args.in[22]; F.w_out = args.in[23]; F.out = args.out;
    F.MOD = (float*)(ws + WS_MOD); F.A16 = (f32x2v*)(ws + WS_A16); F.A128 = (f32x2v*)(ws + WS_A128); F.MODP = (float*)(ws + WS_MODP); F.HGS = (float*)(ws + WS_HGS); F.ROPE = (float*)(ws + WS_ROPE);
    F.WIN = (bf16*)(ws + WS_WIN); F.WGLU = (bf16*)(ws + WS_WGLU); F.WOUT = (bf16*)(ws + WS_WOUT); F.TT = (bf16*)(ws + WS_TT); F.WS = (bf16*)(ws + WS_WS); F.WOT = (bf16*)(ws + WS_WOT);
    F.Q = (bf16*)(ws + WS_Q); F.K = (bf16*)(ws + WS_K); F.V = (bf16*)(ws + WS_V); F.GA = (bf16*)(ws + WS_GA); F.GS = (bf16*)(ws + WS_GS); F.MIX = (bf16*)(ws + WS_MIX);
    F.XN = (bf16*)args.out; F.GY = (bf16*)args.out; F.UC = (bf16*)((unsigned char*)args.out + 64 * MiB);

    unsigned* barw = (unsigned*)(ws + WS_BAR);
    if (threadIdx.x < 2) ((volatile LAS unsigned*)(F.lds + LDS_BARST))[threadIdx.x] = 0u;
    __syncthreads();
    const XcdBarrier bar = xcd_barrier_post(barw, (volatile LAS unsigned*)(F.lds + LDS_BARST));
    p0_gemv(F);
    if (args.cg_sync) grid.sync();
    xcd_barrier(bar);
    p0b_rows(F);
    p0_rest(F);
    xcd_barrier(bar);
    {
        pg8::Gemm g{F.XN, F.WIN, M, NPROJ, DM}; pg8::StaticOrder S; S.init(M, NPROJ, F.G, (int)blockIdx.x);
        pg8::EpiProj E{F.Q, F.K, F.V, F.GA, F.GS, F.UC, F.ROPE, F.ROPE + 8192 * 32, F.qg, F.kg};
        pg8::gemm_phase<pg8::EpiProj, pg8::StaticOrder, true, true>(F.lds + RING_OFF, g, S, E, F.wave);
    }
    xcd_barrier(bar);
    unsigned* sdone = (unsigned*)(ws + WS_SDONE);
    for (int u = F.vcu; u < BATCH * NGRP; u += F.G) {
        ssm_unit(F, u & 3, u >> 2);
        asm volatile("s_waitcnt vmcnt(0)" ::: "memory");
        __syncthreads();
        if (threadIdx.x == 0) { __builtin_amdgcn_fence(__ATOMIC_RELEASE, "agent"); asm volatile("s_waitcnt vmcnt(0)" ::: "memory"); (void)xb_add(sdone, 1u); }
    }
    {
        const int ln_ = lane_id();
        const float s1_ = wave_sum(F.lq1[ln_] * F.lk1[ln_]), s2_ = wave_sum(F.lq2[ln_] * F.lk2[ln_]);
        const float lam_ = __expf(s1_) - __expf(s2_) + LAM_INIT;
        const attn_body::AttnTensors AT{(const attn_body::bf16*)F.Q, (const attn_body::bf16*)F.K, (const attn_body::bf16*)F.V, (attn_body::bf16*)F.MIX, (const attn_body::bf16*)F.GA, F.HGS, lam_};
        const attn_body::AttnOrder S((int)F.G, F.vcu);
        attn_body::attn_phase<attn_body::AttnOrder>((char*)lds + RING_OFF, AT, S, F.wave);
    }
    if (threadIdx.x == 0) {
        unsigned sp_ = 0u;
        while (xb_ld(sdone) < (unsigned)(BATCH * NGRP)) { __builtin_amdgcn_s_sleep(2); if (++sp_ > (1u << 22)) break; }
        __builtin_amdgcn_fence(__ATOMIC_ACQUIRE, "agent");
        asm volatile("s_waitcnt vmcnt(0)" ::: "memory");
    }
    __syncthreads();
    {
        pg8::Gemm g{F.GY, F.WGLU, M, DM, DM}; pg8::StaticOrder S; S.init(M, DM, F.G, (int)blockIdx.x);
        pg8::EpiGlu E{F.GY, F.GS, F.b_glu, F.MIX};
        pg8::gemm_phase<pg8::EpiGlu, pg8::StaticOrder, true, true>(F.lds + RING_OFF, g, S, E, F.wave);
    }
    xcd_barrier(bar);
    {
        pg8::Gemm g{F.MIX, F.WOUT, M, DM, MIXW}; pg8::StaticOrder S; S.init(M, DM, F.G, (int)blockIdx.x);
        pg8::EpiOut E{F.x, F.MOD, F.out};
        pg8::gemm_phase<pg8::EpiOut, pg8::StaticOrder, true, true>(F.lds + RING_OFF, g, S, E, F.wave);
    }
}

extern "C" void kernel_launch(void* const* d_in, const int* in_sizes, int n_in, void* d_out, int out_size, void* d_ws, size_t ws_size, hipStream_t stream) {
    static int grid = 0;
    if (grid == 0) {
        if (n_in != 24 || out_size != M * DM || ws_size < WS_END) { fprintf(stderr, "kernel_launch: unexpected shapes (n_in %d out %d ws %zu); nothing launched\n", n_in, out_size, ws_size); grid = -1; return; }
        int dev = 0, cus = 0, per_cu = 0;
        if (hipGetDevice(&dev) != hipSuccess || hipDeviceGetAttribute(&cus, hipDeviceAttributeMultiprocessorCount, dev) != hipSuccess) { grid = -1; return; }
        if (hipFuncSetAttribute((const void*)hybrid_fwd, hipFuncAttributeMaxDynamicSharedMemorySize, LDS_BYTES) != hipSuccess) { fprintf(stderr, "kernel_launch: hipFuncSetAttribute failed\n"); grid = -1; return; }
        if (hipOccupancyMaxActiveBlocksPerMultiprocessor(&per_cu, (const void*)hybrid_fwd, NWAVES * 64, LDS_BYTES) != hipSuccess || per_cu < 1) { fprintf(stderr, "kernel_launch: occupancy query says %d blocks per CU\n", per_cu); per_cu = 1; }
        (void)hipGetLastError();
        grid = cus * 1;
        fprintf(stderr, "kernel_launch: grid %d (per_cu query %d), ws %zu\n", grid, per_cu, ws_size);
    }
    if (grid < 0) return;
    if (hipMemsetAsync((char*)d_ws + WS_BAR, 0, 16384 + 256, stream) != hipSuccess) { fprintf(stderr, "kernel_launch: hipMemsetAsync of the barrier words failed; nothing launched\n"); return; }
    Args a{};
    for (int i = 0; i < 24; ++i) a.in[i] = (const float*)d_in[i];
    a.out = (float*)d_out; a.ws = (unsigned char*)d_ws;
    void* kargs[] = {&a};
    const hipError_t e = hipLaunchCooperativeKernel((const void*)hybrid_fwd, dim3(grid), dim3(NWAVES * 64), kargs, LDS_BYTES, stream);
    if (e != hipSuccess) fprintf(stderr, "kernel_launch: cooperative launch failed: %s (grid %d)\n", hipGetErrorString(e), grid);
}
```
